# Optimizing an MI355X kernel written in HIP

```python
import math
import jax, jax.numpy as jnp
from jax import lax
import numpy as np

D_MODEL = 1024
BATCH = 8
SEQ = 2048
DEPTH = 2
DEC_BATCH = 128
DEC_SEQ = 4
PAST_LEN = 8192
PAGE_SIZE = 128

N_AB = (DEPTH + 1) // 2
N_C = DEPTH // 2
MLA_HEADS = 8
Q_LORA = 384
KV_LORA = 256
NOPE_DIM = 64
ROPE_DIM = 32
QK_DIM = NOPE_DIM + ROPE_DIM
V_DIM = 64
ROPE_THETA = 10000.0
Q_BLOCK = 128
GLA_HEADS = 4
GLA_DK = 128
GLA_DV = 128
GLA_GATE_RANK = 16
GLA_TAU = 16.0
GLA_CHUNK = 64
S5_GROUP = 16
S5_GROUPS = D_MODEL // S5_GROUP
S5_STATE = 64
DT_MIN = 0.001
DT_MAX = 0.1
D_FF = 4 * D_MODEL
PLE_DIM = 256
EPS = 1e-6

IN_SPLITS = (Q_LORA, KV_LORA, ROPE_DIM, GLA_HEADS * GLA_DK, GLA_HEADS * GLA_DK,
             GLA_HEADS * GLA_DV, GLA_GATE_RANK, GLA_HEADS * GLA_DV)
IN_AB = sum(IN_SPLITS)
MIX_AB = MLA_HEADS * V_DIM + GLA_HEADS * GLA_DV

kernel_name = 'mla_gla_s5_hybrid_step'


def rmsnorm(x, g):
    xf = x.astype(jnp.float32)
    y = xf * lax.rsqrt(jnp.mean(xf * xf, axis=-1, keepdims=True) + EPS)
    return (y * g.astype(jnp.float32)).astype(x.dtype)


def rope_tail(x, pos):
    half = ROPE_DIM // 2
    freqs = ROPE_THETA ** (-jnp.arange(half, dtype=jnp.float32) / half)
    ang = pos.astype(jnp.float32)[:, None] * freqs[None, :]
    cos = jnp.cos(ang)[:, None, :]
    sin = jnp.sin(ang)[:, None, :]
    xr = x[..., NOPE_DIM:].astype(jnp.float32)
    x1, x2 = xr[..., :half], xr[..., half:]
    rot = jnp.concatenate([x1 * cos - x2 * sin, x2 * cos + x1 * sin], axis=-1).astype(x.dtype)
    return jnp.concatenate([x[..., :NOPE_DIM], rot], axis=-1)


def mla_queries(c_q, pos, g_qlat, w_uq, g_qh):
    bt, l = c_q.shape[:2]
    q = jnp.einsum('blr,rz->blz', rmsnorm(c_q, g_qlat), w_uq).reshape(bt, l, MLA_HEADS, QK_DIM)
    return rope_tail(rmsnorm(q, g_qh), pos)


def mla_keys_values(c_kv, k_pe, pos, w_ukv, g_kh):
    bt, l = c_kv.shape[:2]
    kv = jnp.einsum('blr,rz->blz', c_kv, w_ukv).reshape(bt, l, MLA_HEADS, NOPE_DIM + V_DIM)
    k_nope, v = kv[..., :NOPE_DIM], kv[..., NOPE_DIM:]
    k_rot = jnp.broadcast_to(k_pe[:, :, None, :], (bt, l, MLA_HEADS, ROPE_DIM)).astype(k_nope.dtype)
    k = jnp.concatenate([k_nope, k_rot], axis=-1)
    return rope_tail(rmsnorm(k, g_kh), pos), v


def mla_prompt_attention(q, k, v):
    bt, s = q.shape[:2]
    nb = s // Q_BLOCK
    scale = QK_DIM ** -0.5
    qb = q.reshape(bt, nb, Q_BLOCK, MLA_HEADS, QK_DIM).swapaxes(0, 1)
    kpos = jnp.arange(s)

    def block(args):
        qi, bi = args
        sc = jnp.einsum('bqhd,bkhd->bhqk', qi, k).astype(jnp.float32) * scale
        qpos = bi * Q_BLOCK + jnp.arange(Q_BLOCK)
        sc = jnp.where(kpos[None, :] <= qpos[:, None], sc, -jnp.inf)
        p = jax.nn.softmax(sc, axis=-1).astype(v.dtype)
        return jnp.einsum('bhqk,bkhv->bqhv', p, v)

    o = lax.map(block, (qb, jnp.arange(nb)))
    return o.swapaxes(0, 1).reshape(bt, s, MLA_HEADS * V_DIM)


def mla_sample_attention(q, k_new, v_new, cache_ckv_l, cache_kpe_l, page_table, w_ukv, g_kh):
    bd, t = q.shape[:2]
    scale = QK_DIM ** -0.5
    n_pages = page_table.shape[1]

    def page_step(carry, xs):
        m, l, acc = carry
        phys, j = xs
        kpos = j * PAGE_SIZE + jnp.arange(PAGE_SIZE)
        k, v = mla_keys_values(cache_ckv_l[phys], cache_kpe_l[phys], kpos, w_ukv, g_kh)
        sc = jnp.einsum('bthd,bkhd->bhtk', q, k).astype(jnp.float32) * scale
        m_new = jnp.maximum(m, sc.max(axis=-1))
        corr = jnp.exp(m - m_new)
        p = jnp.exp(sc - m_new[..., None])
        l = l * corr + p.sum(axis=-1)
        acc = acc * corr[..., None] + jnp.einsum('bhtk,bkhv->bhtv', p, v.astype(jnp.float32))
        return (m_new, l, acc), None

    init = (jnp.full((bd, MLA_HEADS, t), -jnp.inf, jnp.float32),
            jnp.zeros((bd, MLA_HEADS, t), jnp.float32),
            jnp.zeros((bd, MLA_HEADS, t, V_DIM), jnp.float32))
    (m, l, acc), _ = lax.scan(page_step, init, (page_table.T, jnp.arange(n_pages)))
    sc = jnp.einsum('bthd,bkhd->bhtk', q, k_new).astype(jnp.float32) * scale
    causal = jnp.tril(jnp.ones((t, t), dtype=bool))
    sc = jnp.where(causal, sc, -jnp.inf)
    m_new = jnp.maximum(m, sc.max(axis=-1))
    corr = jnp.exp(m - m_new)
    p = jnp.exp(sc - m_new[..., None])
    l = l * corr + p.sum(axis=-1)
    acc = acc * corr[..., None] + jnp.einsum('bhtk,bkhv->bhtv', p, v_new.astype(jnp.float32))
    o = acc / l[..., None]
    return o.transpose(0, 2, 1, 3).reshape(bd, t, MLA_HEADS * V_DIM).astype(q.dtype)


def gla_recurrence(q, k, v, lg, s0):
    bt, l = q.shape[:2]
    c = GLA_CHUNK if l % GLA_CHUNK == 0 else l
    n = l // c

    def chunks(a):
        return a.reshape(bt, n, c, *a.shape[2:]).swapaxes(0, 1)

    causal = jnp.tril(jnp.ones((c, c), dtype=bool))[None, :, :, None, None]

    def step(s, inp):
        qc, kc, vc, gc = inp
        b = jnp.cumsum(gc, axis=1)
        inter = jnp.einsum('bthk,bhkv->bthv', qc * jnp.exp(b), s)
        decay = jnp.exp(jnp.where(causal, b[:, :, None] - b[:, None, :], -jnp.inf))
        att = jnp.einsum('btshk,bshk->bhts', qc[:, :, None] * decay, kc)
        o = inter + jnp.einsum('bhts,bshv->bthv', att, vc)
        bl = b[:, -1]
        s = jnp.exp(bl)[..., None] * s + jnp.einsum('bshk,bshv->bhkv', kc * jnp.exp(bl[:, None] - b), vc)
        return s, o

    s, o = lax.scan(step, s0, (chunks(q), chunks(k), chunks(v), chunks(lg)))
    return o.swapaxes(0, 1).reshape(bt, l, GLA_HEADS, GLA_DV), s


def ab_mixer(n, pos, s0, past, w_in, g_qlat, w_uq, g_kvlat, w_ukv, g_qh, g_kh, w_a2, b_a, g_o, w_out):
    f32 = jnp.float32
    bt, l, _ = n.shape
    z = jnp.einsum('bld,dz->blz', n, w_in)
    idx = [int(i) for i in np.cumsum(IN_SPLITS)[:-1]]
    c_q, c_kv, k_pe, gq, gk, gv, ga, gr = jnp.split(z, idx, axis=-1)
    q = mla_queries(c_q, pos, g_qlat, w_uq, g_qh)
    c_kv = rmsnorm(c_kv, g_kvlat)
    k, v = mla_keys_values(c_kv, k_pe, pos, w_ukv, g_kh)
    if past is None:
        attn = mla_prompt_attention(q, k, v)
    else:
        cache_ckv_l, cache_kpe_l, page_table = past
        attn = mla_sample_attention(q, k, v, cache_ckv_l, cache_kpe_l, page_table, w_ukv, g_kh)
    gq = gq.reshape(bt, l, GLA_HEADS, GLA_DK).astype(f32) * (GLA_DK ** -0.5)
    gk = gk.reshape(bt, l, GLA_HEADS, GLA_DK).astype(f32)
    gv = gv.reshape(bt, l, GLA_HEADS, GLA_DV).astype(f32)
    logit = (jnp.einsum('blr,rz->blz', ga, w_a2) + b_a).astype(f32)
    lg = jax.nn.log_sigmoid(logit).reshape(bt, l, GLA_HEADS, GLA_DK) / GLA_TAU
    o, s = gla_recurrence(gq, gk, gv, lg, s0.astype(f32))
    o = rmsnorm(o, g_o).astype(n.dtype).reshape(bt, l, GLA_HEADS * GLA_DV) * jax.nn.silu(gr)
    y = jnp.einsum('blz,zd->bld', jnp.concatenate([attn, o], axis=-1), w_out)
    return y, c_kv, k_pe, s.astype(s0.dtype)


def s5_combine(e1, e2):
    a1r, a1i, b1r, b1i = e1
    a2r, a2i, b2r, b2i = e2
    return (a2r * a1r - a2i * a1i, a2r * a1i + a2i * a1r,
            a2r * b1r - a2i * b1i + b2r, a2r * b1i + a2i * b1r + b2i)


def s5_mixer(n, x0_re, x0_im, a_re, a_im, log_dt, b_re, b_im, c_re, c_im, d, w_glu):
    f32 = jnp.float32
    bt, l, _ = n.shape
    u = n.astype(f32).reshape(bt, l, S5_GROUPS, S5_GROUP)
    a_re = a_re.astype(f32)
    a_im = a_im.astype(f32)
    dt = jnp.exp(log_dt.astype(f32))[:, None]
    mag = jnp.exp(a_re * dt)
    lr = mag * jnp.cos(a_im * dt)
    li = mag * jnp.sin(a_im * dt)
    den = a_re * a_re + a_im * a_im
    cr = ((lr - 1.0) * a_re + li * a_im) / den
    ci = (li * a_re - (lr - 1.0) * a_im) / den
    b_re = b_re.astype(f32)
    b_im = b_im.astype(f32)
    bbr = cr[..., None] * b_re - ci[..., None] * b_im
    bbi = cr[..., None] * b_im + ci[..., None] * b_re
    bur = jnp.einsum('blgc,gpc->lbgp', u, bbr)
    bui = jnp.einsum('blgc,gpc->lbgp', u, bbi)
    x0r = x0_re.astype(f32)
    x0i = x0_im.astype(f32)
    bur = bur.at[0].add(lr * x0r - li * x0i)
    bui = bui.at[0].add(lr * x0i + li * x0r)
    ar = jnp.broadcast_to(lr, (l, 1, S5_GROUPS, S5_STATE))
    ai = jnp.broadcast_to(li, (l, 1, S5_GROUPS, S5_STATE))
    _, _, xr, xi = lax.associative_scan(s5_combine, (ar, ai, bur, bui), axis=0)
    y = (jnp.einsum('lbgp,gcp->blgc', xr, c_re.astype(f32))
         - jnp.einsum('lbgp,gcp->blgc', xi, c_im.astype(f32)))
    y = y.reshape(bt, l, D_MODEL) + d.astype(f32) * n.astype(f32)
    g = jax.nn.gelu(y).astype(n.dtype)
    zg = jnp.einsum('bld,dz->blz', g, w_glu)
    out = zg[..., :D_MODEL] * jax.nn.sigmoid(zg[..., D_MODEL:])
    return out, xr[-1].astype(x0_re.dtype), xi[-1].astype(x0_im.dtype)


def channel_mixer(h, g, w_up, w_down):
    a = jax.nn.relu(jnp.einsum('bld,df->blf', rmsnorm(h, g), w_up))
    return jnp.einsum('blf,fd->bld', a * a, w_down)


def per_layer_embedding(h, p, g, w_gate, w_proj):
    gate = jax.nn.sigmoid(jnp.einsum('bld,de->ble', rmsnorm(h, g), w_gate))
    return gate * jnp.einsum('blr,rd->bld', p, w_proj)


def setup_inputs(seed: int = 0) -> dict:
    key = jax.random.key(seed)
    ks = iter(jax.random.split(key, 64))
    f32 = jnp.float32

    def nrm(shape, scale):
        return jax.random.normal(next(ks), shape, f32) * scale

    def gain(shape):
        return 1.0 + nrm(shape, 0.02)

    n_pages = PAST_LEN // PAGE_SIZE
    n_used = DEC_BATCH * n_pages
    n_pool = n_used + max(1, n_used // 4)
    page_table = jax.random.permutation(next(ks), n_pool)[:n_used].reshape(DEC_BATCH, n_pages).astype(jnp.int32)
    a_im = jnp.broadcast_to(math.pi * jnp.arange(S5_STATE, dtype=f32), (N_C, S5_GROUPS, S5_STATE))
    a_re = -0.5 * jnp.exp(nrm((N_C, S5_GROUPS, S5_STATE), 0.05))
    log_dt = jax.random.uniform(next(ks), (N_C, S5_GROUPS), f32, math.log(DT_MIN), math.log(DT_MAX))
    return {
        'x_prompt': nrm((BATCH, SEQ, D_MODEL), 1.0),
        'x_sample': nrm((DEC_BATCH, DEC_SEQ, D_MODEL), 1.0),
        'cache_ckv': nrm((N_AB, n_pool, PAGE_SIZE, KV_LORA), 1.0),
        'cache_kpe': nrm((N_AB, n_pool, PAGE_SIZE, ROPE_DIM), 1.0),
        'state_gla': nrm((N_AB, DEC_BATCH, GLA_HEADS, GLA_DK, GLA_DV), 0.1),
        'state_s5_re': nrm((N_C, DEC_BATCH, S5_GROUPS, S5_STATE), 0.1),
        'state_s5_im': nrm((N_C, DEC_BATCH, S5_GROUPS, S5_STATE), 0.1),
        'page_table': page_table,
        'p_prompt': nrm((DEPTH, BATCH, SEQ, PLE_DIM), 1.0),
        'p_sample': nrm((DEPTH, DEC_BATCH, DEC_SEQ, PLE_DIM), 1.0),
        'g_norm_ab': gain((N_AB, D_MODEL)),
        'w_in_ab': nrm((N_AB, D_MODEL, IN_AB), D_MODEL ** -0.5),
        'g_qlat': gain((N_AB, Q_LORA)),
        'w_uq': nrm((N_AB, Q_LORA, MLA_HEADS * QK_DIM), Q_LORA ** -0.5),
        'g_kvlat': gain((N_AB, KV_LORA)),
        'w_ukv': nrm((N_AB, KV_LORA, MLA_HEADS * (NOPE_DIM + V_DIM)), KV_LORA ** -0.5),
        'g_qh': gain((N_AB, QK_DIM)),
        'g_kh': gain((N_AB, QK_DIM)),
        'w_gla_a2': nrm((N_AB, GLA_GATE_RANK, GLA_HEADS * GLA_DK), GLA_GATE_RANK ** -0.5),
        'b_gla_a': nrm((N_AB, GLA_HEADS * GLA_DK), 0.1),
        'g_gla_o': gain((N_AB, GLA_DV)),
        'w_out_ab': nrm((N_AB, MIX_AB, D_MODEL), MIX_AB ** -0.5),
        'g_norm_c': gain((N_C, D_MODEL)),
        's5_a_re': a_re,
        's5_a_im': a_im,
        's5_log_dt': log_dt,
        's5_b_re': nrm((N_C, S5_GROUPS, S5_STATE, S5_GROUP), (2 * S5_GROUP) ** -0.5),
        's5_b_im': nrm((N_C, S5_GROUPS, S5_STATE, S5_GROUP), (2 * S5_GROUP) ** -0.5),
        's5_c_re': nrm((N_C, S5_GROUPS, S5_GROUP, S5_STATE), S5_STATE ** -0.5),
        's5_c_im': nrm((N_C, S5_GROUPS, S5_GROUP, S5_STATE), S5_STATE ** -0.5),
        's5_d': nrm((N_C, D_MODEL), 1.0),
        'w_glu': nrm((N_C, D_MODEL, 2 * D_MODEL), D_MODEL ** -0.5),
        'g_norm_mlp': gain((DEPTH, D_MODEL)),
        'w_up': nrm((DEPTH, D_MODEL, D_FF), D_MODEL ** -0.5),
        'w_down': nrm((DEPTH, D_FF, D_MODEL), D_FF ** -0.5),
        'g_norm_ple': gain((DEPTH, D_MODEL)),
        'w_ple_gate': nrm((DEPTH, D_MODEL, D_MODEL), D_MODEL ** -0.5),
        'w_ple_proj': nrm((DEPTH, PLE_DIM, D_MODEL), PLE_DIM ** -0.5),
    }


def reference(x_prompt, x_sample, cache_ckv, cache_kpe, state_gla, state_s5_re, state_s5_im, page_table,
              p_prompt, p_sample, g_norm_ab, w_in_ab, g_qlat, w_uq, g_kvlat, w_ukv, g_qh, g_kh,
              w_gla_a2, b_gla_a, g_gla_o, w_out_ab, g_norm_c, s5_a_re, s5_a_im, s5_log_dt,
              s5_b_re, s5_b_im, s5_c_re, s5_c_im, s5_d, w_glu, g_norm_mlp, w_up, w_down,
              g_norm_ple, w_ple_gate, w_ple_proj):
    lp = x_prompt.shape[1]
    t = x_sample.shape[1]
    past_len = page_table.shape[1] * PAGE_SIZE
    pos_p = jnp.arange(lp)
    pos_s = past_len + jnp.arange(t)
    hp, hs = x_prompt, x_sample
    ckv_p, kpe_p, gla_p, s5r_p, s5i_p = [], [], [], [], []
    ckv_s, kpe_s, gla_s, s5r_s, s5i_s = [], [], [], [], []
    for i in range(DEPTH):
        j = i // 2
        if i % 2 == 0:
            wts = (w_in_ab[j], g_qlat[j], w_uq[j], g_kvlat[j], w_ukv[j], g_qh[j], g_kh[j],
                   w_gla_a2[j], b_gla_a[j], g_gla_o[j], w_out_ab[j])
            s0 = jnp.zeros((hp.shape[0], GLA_HEADS, GLA_DK, GLA_DV), state_gla.dtype)
            mp, c1, c2, c3 = ab_mixer(rmsnorm(hp, g_norm_ab[j]), pos_p, s0, None, *wts)
            ms, d1, d2, d3 = ab_mixer(rmsnorm(hs, g_norm_ab[j]), pos_s, state_gla[j],
                                      (cache_ckv[j], cache_kpe[j], page_table), *wts)
            ckv_p.append(c1)
            kpe_p.append(c2)
            gla_p.append(c3)
            ckv_s.append(d1)
            kpe_s.append(d2)
            gla_s.append(d3)
        else:
            wts = (s5_a_re[j], s5_a_im[j], s5_log_dt[j], s5_b_re[j], s5_b_im[j],
                   s5_c_re[j], s5_c_im[j], s5_d[j], w_glu[j])
            z0 = jnp.zeros((hp.shape[0], S5_GROUPS, S5_STATE), state_s5_re.dtype)
            mp, c1, c2 = s5_mixer(rmsnorm(hp, g_norm_c[j]), z0, z0, *wts)
            ms, d1, d2 = s5_mixer(rmsnorm(hs, g_norm_c[j]), state_s5_re[j], state_s5_im[j], *wts)
            s5r_p.append(c1)
            s5i_p.append(c2)
            s5r_s.append(d1)
            s5i_s.append(d2)
        hp = hp + mp
        hs = hs + ms
        hp = hp + channel_mixer(hp, g_norm_mlp[i], w_up[i], w_down[i])
        hs = hs + channel_mixer(hs, g_norm_mlp[i], w_up[i], w_down[i])
        hp = hp + per_layer_embedding(hp, p_prompt[i], g_norm_ple[i], w_ple_gate[i], w_ple_proj[i])
        hs = hs + per_layer_embedding(hs, p_sample[i], g_norm_ple[i], w_ple_gate[i], w_ple_proj[i])
    y_prompt, y_sample = hp, hs
    ckv_prompt, kpe_prompt, gla_prompt = jnp.stack(ckv_p), jnp.stack(kpe_p), jnp.stack(gla_p)
    s5re_prompt, s5im_prompt = jnp.stack(s5r_p), jnp.stack(s5i_p)
    ckv_sample, kpe_sample, gla_sample = jnp.stack(ckv_s), jnp.stack(kpe_s), jnp.stack(gla_s)
    s5re_sample, s5im_sample = jnp.stack(s5r_s), jnp.stack(s5i_s)
    return (y_prompt, y_sample, ckv_prompt, kpe_prompt, gla_prompt, s5re_prompt, s5im_prompt,
            ckv_sample, kpe_sample, gla_sample, s5re_sample, s5im_sample)
```

```cpp
#include <hip/hip_runtime.h>
#include <cstdio>
#include <cstdint>

#ifndef PROBE_PHASE
#define PROBE_PHASE -1
#endif
#define REPS(k) (PROBE_PHASE == (k) ? 2 : 1)
#define GAS __attribute__((address_space(1)))
#define LAS __attribute__((address_space(3)))
#define DI __device__ __forceinline__
typedef unsigned short bf16;
typedef short bf16x8 __attribute__((ext_vector_type(8)));
typedef short s16x4 __attribute__((ext_vector_type(4)));
typedef short v4i16_t __attribute__((ext_vector_type(4)));
typedef float f32x2 __attribute__((ext_vector_type(2)));
typedef float f32x4 __attribute__((ext_vector_type(4)));
typedef float f32x16 __attribute__((ext_vector_type(16)));
typedef unsigned u32x2 __attribute__((ext_vector_type(2)));
typedef unsigned u32x4 __attribute__((ext_vector_type(4)));
typedef __bf16 bf16x2_t __attribute__((ext_vector_type(2)));

constexpr int DM = 1024, NB = 8, SEQ = 2048, MP = NB * SEQ, DB = 128, DT = 4, MS = DB * DT, MT = MP + MS;
constexpr int NPAGES = 64, PAGE = 128, PAST = NPAGES * PAGE;
constexpr int QL = 384, KVL = 256, ROPE = 32, NOPE = 64, QK = 96, VD = 64, NH = 8;
constexpr int GH = 4, GDK = 128, GDV = 128, GRK = 16;
constexpr int ZW = 2816;
constexpr int FF = 4096, PLE = 256;
constexpr int S5G = 64, S5P = 64, S5C = 16, S5T = 16, S5NC = SEQ / S5T, S5K = 384, S5N = NB * S5NC;
constexpr float EPS = 1e-6f;
constexpr int ZC_CQ = 0, ZC_CKV = 384, ZC_GQ = 640, ZC_GK = 1152, ZC_GV = 1664, ZC_GR = 2176, ZC_KPE = 2688, ZC_GA = 2720, ZC_END = 2736;

constexpr size_t O_Y = 0;
constexpr size_t O_CKVP = (size_t)MT * DM;
constexpr size_t O_KPEP = O_CKVP + (size_t)MP * KVL;
constexpr size_t O_GLAP = O_KPEP + (size_t)MP * ROPE;
constexpr size_t O_S5RP = O_GLAP + (size_t)NB * GH * GDK * GDV;
constexpr size_t O_S5IP = O_S5RP + (size_t)NB * S5G * S5P;
constexpr size_t O_CKVS = O_S5IP + (size_t)NB * S5G * S5P;
constexpr size_t O_KPES = O_CKVS + (size_t)MS * KVL;
constexpr size_t O_GLAS = O_KPES + (size_t)MS * ROPE;
constexpr size_t O_S5RS = O_GLAS + (size_t)DB * GH * GDK * GDV;
constexpr size_t O_S5IS = O_S5RS + (size_t)DB * S5G * S5P;
constexpr size_t O_END = O_S5IS + (size_t)DB * S5G * S5P;
static_assert(O_END == 32194560, "output size");

constexpr size_t MiB = 1u << 20;
constexpr size_t WS_CTL = 0, CTL_ZERO_BYTES = 2 * MiB;
constexpr int CW_BAR = 1024;
constexpr int CW_SS = 8192;
static_assert((CW_SS + 8 * MT) * 4 <= (int)CTL_ZERO_BYTES, "ctl");
constexpr size_t WS_WIN = 2 * MiB;
constexpr size_t WS_WUQ = 8 * MiB;
constexpr size_t WS_WUKV = 9 * MiB;
constexpr size_t WS_WUKVG = 9 * MiB + 512 * 1024;
constexpr size_t WS_WOUT = 10 * MiB;
constexpr size_t WS_WGLU = 12 * MiB;
constexpr size_t WS_WUP = 16 * MiB;
constexpr size_t WS_WDN = 32 * MiB;
constexpr size_t WS_WGATE = 48 * MiB;
constexpr size_t WS_WPROJ = 52 * MiB;
constexpr size_t WS_ROPE = 54 * MiB;
constexpr size_t WS_S5TAB = 56 * MiB;
constexpr size_t WS_S5TN = 58 * MiB;
constexpr size_t WS_S5BD = 98 * MiB;
constexpr size_t WS_PB = 118 * MiB;
constexpr size_t WS_XB0 = 136 * MiB;
constexpr size_t WS_XB1 = 170 * MiB;
constexpr size_t WS_Z = 204 * MiB;
constexpr size_t WS_CKVB = 296 * MiB;
constexpr size_t WS_SSQ = 305 * MiB;
constexpr size_t WS_LG = 306 * MiB;
constexpr size_t WS_QRAW = 340 * MiB;
constexpr size_t WS_KVRAW = 366 * MiB;
constexpr size_t WS_QF = 400 * MiB;
constexpr size_t WS_KF = 426 * MiB;
constexpr size_t WS_VT = 452 * MiB;
constexpr size_t WS_MIX = 470 * MiB;
constexpr size_t WS_A1 = 504 * MiB;
constexpr size_t WS_PP = 638 * MiB;
constexpr size_t WS_GU = 706 * MiB;
constexpr size_t WS_GDEC = 771 * MiB;
constexpr size_t WS_GSP = 772 * MiB;
constexpr size_t WS_U2 = 920 * MiB;
constexpr size_t WS_S5E = 970 * MiB;
constexpr size_t WS_GG = 866 * MiB;
constexpr size_t WS_QS = 900 * MiB;
constexpr size_t WS_SPART = 904 * MiB;
constexpr size_t WS_SL = 913 * MiB;
constexpr size_t WS_END = 1004 * MiB;

DI unsigned f2bf(float f) { unsigned u = __builtin_bit_cast(unsigned, f); return (u + 0x7fffu + ((u >> 16) & 1u)) >> 16; }
DI unsigned pk2(float lo, float hi) { f32x2 v = {lo, hi}; bf16x2_t b = __builtin_convertvector(v, bf16x2_t); return __builtin_bit_cast(unsigned, b); }
DI float bf2f(unsigned short b) { return __builtin_bit_cast(float, (unsigned)b << 16); }
DI float bflo(unsigned u) { return __builtin_bit_cast(float, u << 16); }
DI float bfhi(unsigned u) { return __builtin_bit_cast(float, u & 0xffff0000u); }
DI float wave_sum(float v) {
#pragma unroll
    for (int o = 1; o < 64; o <<= 1) v += __shfl_xor(v, o);
    return v;
}
DI float sigmoidf_(float x) { return 1.f / (1.f + __expf(-x)); }
DI float row16_sum(float v) {
    v += __builtin_bit_cast(float, __builtin_amdgcn_update_dpp(0, __builtin_bit_cast(int, v), 0x128, 0xf, 0xf, false));
    v += __builtin_bit_cast(float, __builtin_amdgcn_update_dpp(0, __builtin_bit_cast(int, v), 0x124, 0xf, 0xf, false));
    v += __builtin_bit_cast(float, __builtin_amdgcn_update_dpp(0, __builtin_bit_cast(int, v), 0x4E, 0xf, 0xf, false));
    v += __builtin_bit_cast(float, __builtin_amdgcn_update_dpp(0, __builtin_bit_cast(int, v), 0xB1, 0xf, 0xf, false));
    return v; }
DI float row8_sum(float v) {
    v += __builtin_bit_cast(float, __builtin_amdgcn_update_dpp(0, __builtin_bit_cast(int, v), 0xB1, 0xf, 0xf, false));
    v += __builtin_bit_cast(float, __builtin_amdgcn_update_dpp(0, __builtin_bit_cast(int, v), 0x4E, 0xf, 0xf, false));
    v += __builtin_bit_cast(float, __builtin_amdgcn_update_dpp(0, __builtin_bit_cast(int, v), 0x141, 0xf, 0xf, false));
    return v; }
#define LDS_WAIT() asm volatile("s_waitcnt lgkmcnt(0)" ::: "memory")
#define VM_WAIT() asm volatile("s_waitcnt vmcnt(0)" ::: "memory")

#define XB_TMO      128
#define XB_XCNT(j)  (256  + 64 * (j))
#define XB_XSUB(j)  (1280 + 64 * (j))
#define XB_XGEN(j)  (2304 + 64 * (j))
#define XB_TOP      3328
#define XB_TOPGEN   3392
#define XCD_BAR_WORDS 3456
#define XB_SPIN_CAP (1u << 18)
static_assert(CW_BAR + XCD_BAR_WORDS <= CW_SS, "ctl map");
DI unsigned xb_ld(unsigned* p)              { return __hip_atomic_load(p, __ATOMIC_RELAXED, __HIP_MEMORY_SCOPE_AGENT); }
DI unsigned xb_add(unsigned* p, unsigned v) { return __hip_atomic_fetch_add(p, v, __ATOMIC_RELAXED, __HIP_MEMORY_SCOPE_AGENT); }
DI unsigned xb_xcc_id() { return (unsigned)__builtin_amdgcn_s_getreg((3 << 11) | 20) & 0xFu; }
#define XB_SPIN(cond, bar) do { unsigned _sp = 0; while (cond) { __builtin_amdgcn_s_sleep(1); \
    if ((++_sp & 255u) == 0u) { if (xb_ld(&(bar)[XB_TMO])) break; if (_sp > XB_SPIN_CAP) { atomicAdd(&(bar)[XB_TMO], 1u); break; } } } } while (0)
struct XcdBarrier { unsigned* bar; unsigned x; volatile LAS unsigned* st; };
DI XcdBarrier xcd_barrier_post(unsigned* bar, volatile LAS unsigned* st) {
    XcdBarrier b; b.bar = bar; b.x = xb_xcc_id(); b.st = st;
    if (threadIdx.x == 0) (void)xb_add(&bar[XB_XCNT(b.x)], 1u);
    return b;
}
DI void xcd_barrier_complete(unsigned* bar, unsigned x, unsigned& nloc, unsigned& nx) {
    const unsigned G = gridDim.x * gridDim.y * gridDim.z;
    unsigned sum, cnt, mine, sp = 0u;
    for (;;) {
        sum = 0u; cnt = 0u; mine = 0u;
#pragma unroll
        for (unsigned j = 0; j < 16; ++j) { const unsigned c = xb_ld(&bar[XB_XCNT(j)]); sum += c; cnt += (c > 0u) ? 1u : 0u; mine = (j == x) ? c : mine; }
        if (sum == G) break;
        __builtin_amdgcn_s_sleep(1);
        if ((++sp & 255u) == 0u) { if (xb_ld(&bar[XB_TMO])) break; if (sp > XB_SPIN_CAP) { atomicAdd(&bar[XB_TMO], 1u); break; } }
    }
    nloc = mine > 0u ? mine : 1u; nx = cnt > 0u ? cnt : 1u;
}
DI void xcd_barrier(const XcdBarrier& b) {
    asm volatile("s_waitcnt vmcnt(0)" ::: "memory");
    __syncthreads();
    if (threadIdx.x == 0) {
        unsigned* bar = b.bar;
        __builtin_amdgcn_s_waitcnt(0);
        unsigned nloc = b.st[0], nx = b.st[1];
        if (nloc == 0u) { xcd_barrier_complete(bar, b.x, nloc, nx); b.st[0] = nloc; b.st[1] = nx; }
        const unsigned old = xb_add(&bar[XB_XSUB(b.x)], 1u);
        const unsigned gen = old / nloc;
        if (old + 1u == (gen + 1u) * nloc) {
            __builtin_amdgcn_fence(__ATOMIC_RELEASE, "agent");
            asm volatile("s_waitcnt vmcnt(0)" ::: "memory");
            const unsigned og = xb_add(&bar[XB_TOP], 1u);
            const unsigned tg = og / nx;
            if (og + 1u == (tg + 1u) * nx) xb_add(&bar[XB_TOPGEN], 1u);
            else XB_SPIN(xb_ld(&bar[XB_TOPGEN]) == tg, bar);
            __builtin_amdgcn_fence(__ATOMIC_ACQUIRE, "agent");
            xb_add(&bar[XB_XGEN(b.x)], 1u);
            asm volatile("s_waitcnt vmcnt(0)" ::: "memory");
        } else {
            XB_SPIN(xb_ld(&bar[XB_XGEN(b.x)]) == gen, bar);
            __builtin_amdgcn_fence(__ATOMIC_ACQUIRE, "agent");
            asm volatile("s_waitcnt vmcnt(0)" ::: "memory");
        }
    }
    __syncthreads();
}
namespace pg8 {
constexpr int BM = 256, BK = 64, HALF = 128, HTB = HALF * BK * 2, STAGE_BYTES = 8 * HTB, NXCD = 8, WGM = 4;
__host__ __device__ __forceinline__ int lds_byte(int r, int c) { const int st = (r >> 4) * 2 + (c >> 5), rr = r & 15, cc = c & 31, ob = rr * 64 + cc * 2; return st * 1024 + (ob ^ (((ob >> 9) & 1) << 5)); }
__host__ __device__ __forceinline__ void stage_rc(int b, int& R, int& C) { const int st = b / 1024, sb = b % 1024, swz = sb ^ (((sb >> 9) & 1) << 5); R = (st >> 1) * 16 + swz / 64; C = (st & 1) * 32 + (swz % 64) / 2; }
__host__ __device__ __forceinline__ int perm32(int rho) { const int n = rho >> 4, i = rho & 15; return 8 * (i >> 2) + 4 * n + (i & 3); }

struct Unit { int pm, pn; size_t aoff, boff; };
struct Gemm { const bf16* A; const bf16* Bt; int lda, ldb, K; };

struct GridOrder {
    int nM, nN, nwg, G, c;
    DI void init(int nM_, int nN_, int G_, int c_) { nM = nM_; nN = nN_; nwg = nM * nN; G = G_; c = c_; }
    DI bool next(int i, Unit& u) const {
        const long L = (long)i * G + c; if (L >= nwg) return false;
        int wgid = (int)L; { const int q = nwg / NXCD, r = nwg % NXCD, xcd = wgid % NXCD, off = wgid / NXCD; wgid = (xcd < r ? xcd * (q + 1) : r * (q + 1) + (xcd - r) * q) + off; }
        const int nig = WGM * nN, gid = wgid / nig, fm = gid * WGM, gsz = (nM - fm) < WGM ? (nM - fm) : WGM;
        u.pm = fm + ((wgid % nig) % gsz); u.pn = (wgid % nig) / gsz; u.aoff = 0; u.boff = 0; return true;
    }
};
struct BatchOrder {
    int nM, nN, nb, G, c; size_t astride, bstride;
    DI void init(int nb_, int nM_, int nN_, size_t as_, size_t bs_, int G_, int c_) { nb = nb_; nM = nM_; nN = nN_; astride = as_; bstride = bs_; G = G_; c = c_; }
    DI bool next(int i, Unit& u) const {
        const long L = (long)i * G + c; if (L >= (long)nb * nM * nN) return false;
        const int per = nM * nN, b = (int)(L / per), r = (int)(L % per);
        u.pm = r / nN; u.pn = r % nN; u.aoff = (size_t)b * astride; u.boff = (size_t)b * bstride; return true;
    }
};

template <class Epi, class Sched, bool ALIGN_EPI = false, bool KUNROLL1 = false>
DI void gemm_phase(LAS unsigned char* lds, const Gemm g, const Sched& S, const Epi& E) {
    const int tid = threadIdx.x, wid = __builtin_amdgcn_readfirstlane(tid >> 6), lane = tid & 63, wr = wid >> 2, wc = wid & 3, fr = lane & 15, fq = lane >> 4;
    const int K = g.K, nt = K / BK;
    unsigned voffA[2], voffB[2];
#pragma unroll
    for (int i = 0; i < 2; ++i) { int R, C; stage_rc(tid * 16 + i * 8192, R, C); const int Rb = Epi::PERM ? ((R & ~31) + perm32(R & 31)) : R;
        voffA[i] = (unsigned)(R * g.lda + C) * 2u; voffB[i] = (unsigned)(Rb * g.ldb + C) * 2u; }
    const size_t kstep = (size_t)(BK * 2);
    const size_t hstepA = (size_t)HALF * g.lda * 2, hstepB = (size_t)HALF * g.ldb * 2;
    const size_t tstepA = 2 * hstepA, tstepB = 2 * hstepB;
    const unsigned ldsw = (unsigned)wid * 1024u;
    const int aoff = lds_byte(wr * 64 + fr, fq * 8), boff = lds_byte(wc * 32 + fr, fq * 8);
#define PG8_SA(b, h) (((b) * 2 + (h)) * HTB)
#define PG8_SB(b, h) ((4 + (b) * 2 + (h)) * HTB)
#define PG8_STAGE(bufoff, gbase, voff) do { _Pragma("unroll") for (int _i = 0; _i < 2; ++_i) \
        __builtin_amdgcn_global_load_lds((const unsigned*)((const char*)(gbase) + (voff)[_i]), (LAS unsigned*)(lds + (bufoff) + ldsw + _i * 8192), 16, 0, 0); } while (0)
#define PG8_LDA(dst, b, h) do { _Pragma("unroll") for (int m = 0; m < 4; ++m) _Pragma("unroll") for (int k = 0; k < 2; ++k) dst[m][k] = *(const LAS bf16x8*)(lds + PG8_SA(b, h) + aoff + m * 2048 + k * 1024); } while (0)
#define PG8_LDB(dst, b, h) do { _Pragma("unroll") for (int n = 0; n < 2; ++n) _Pragma("unroll") for (int k = 0; k < 2; ++k) dst[n][k] = *(const LAS bf16x8*)(lds + PG8_SB(b, h) + boff + n * 2048 + k * 1024); } while (0)
#define PG8_MMA(ai, bj, At, Bt) do { __builtin_amdgcn_s_setprio(1); _Pragma("unroll") for (int m = 0; m < 4; ++m) _Pragma("unroll") for (int n = 0; n < 2; ++n) _Pragma("unroll") for (int k = 0; k < 2; ++k) \
        acc[ai][bj][m][n] = __builtin_amdgcn_mfma_f32_16x16x32_bf16(Bt[n][k], At[m][k], acc[ai][bj][m][n], 0, 0, 0); __builtin_amdgcn_s_setprio(0); } while (0)
#define PG8_WAIT_V(n) asm volatile("s_waitcnt vmcnt(" #n ")" ::: "memory")
#define PG8_WAIT_L(n) asm volatile("s_waitcnt lgkmcnt(" #n ")" ::: "memory")
#define PG8_BAR __builtin_amdgcn_s_barrier()
#define PG8_SCHED __builtin_amdgcn_sched_barrier(0)
    Unit cur, nxt; int ui = 0;
    if (!S.next(0, cur)) return;
    f32x4 acc[2][2][4][2];
#pragma unroll
    for (int a = 0; a < 2; ++a)
#pragma unroll
        for (int b = 0; b < 2; ++b)
#pragma unroll
            for (int m = 0; m < 4; ++m)
#pragma unroll
                for (int n = 0; n < 2; ++n) acc[a][b][m][n] = (f32x4){0.f, 0.f, 0.f, 0.f};
    bf16x8 At[4][2], B0[2][2], B1[2][2];
    const char* cA = (const char*)g.A + cur.aoff + (size_t)cur.pm * tstepA; const char* cB = (const char*)g.Bt + cur.boff + (size_t)cur.pn * tstepB;
    PG8_STAGE(PG8_SB(0, 0), cB, voffB); PG8_STAGE(PG8_SB(0, 1), cB + hstepB, voffB); PG8_STAGE(PG8_SA(0, 0), cA, voffA); PG8_STAGE(PG8_SA(0, 1), cA + hstepA, voffA);
    if (wr == 1) PG8_BAR;
    PG8_WAIT_V(2); PG8_BAR;
    PG8_STAGE(PG8_SB(1, 0), cB + kstep, voffB); PG8_STAGE(PG8_SA(1, 0), cA + kstep, voffA); PG8_STAGE(PG8_SB(1, 1), cB + hstepB + kstep, voffB);
    PG8_WAIT_V(6); PG8_BAR;
    for (;;) {
        const bool has_next = S.next(ui + 1, nxt);
        const char* nA = has_next ? (const char*)g.A + nxt.aoff + (size_t)nxt.pm * tstepA : cA; const char* nB = has_next ? (const char*)g.Bt + nxt.boff + (size_t)nxt.pn * tstepB : cB;
        int nt_ = nt; if constexpr (KUNROLL1) asm volatile("" : "+s"(nt_));
        for (int t = 0; t < nt_; t += 2) {
            const bool last = (t == nt_ - 2);
            const char* a1 = cA + (size_t)(t + 1) * kstep;
            const char* a2 = last ? nA : cA + (size_t)(t + 2) * kstep; const char* b2 = last ? nB : cB + (size_t)(t + 2) * kstep;
            const char* a3 = a2 + kstep; const char* b3 = b2 + kstep;
            PG8_LDB(B0, 0, 0); PG8_LDB(B1, 0, 1); PG8_SCHED; PG8_LDA(At, 0, 0); PG8_STAGE(PG8_SA(1, 1), a1 + hstepA, voffA);
            PG8_WAIT_V(8); PG8_WAIT_L(0); PG8_BAR; PG8_MMA(0, 0, At, B0); PG8_MMA(0, 1, At, B1); PG8_BAR; PG8_SCHED;
            PG8_LDA(At, 0, 1); PG8_STAGE(PG8_SB(0, 0), b2, voffB); PG8_STAGE(PG8_SB(0, 1), b2 + hstepB, voffB); PG8_STAGE(PG8_SA(0, 0), a2, voffA);
            PG8_WAIT_V(8); PG8_WAIT_L(0); PG8_BAR; PG8_MMA(1, 0, At, B0); PG8_MMA(1, 1, At, B1); PG8_BAR; PG8_SCHED;
            PG8_LDB(B0, 1, 0); PG8_LDB(B1, 1, 1); PG8_SCHED; PG8_LDA(At, 1, 0); PG8_STAGE(PG8_SA(0, 1), a2 + hstepA, voffA);
            PG8_WAIT_V(8); PG8_WAIT_L(0); PG8_BAR; PG8_MMA(0, 0, At, B0); PG8_MMA(0, 1, At, B1); PG8_BAR; PG8_SCHED;
            PG8_LDA(At, 1, 1); PG8_STAGE(PG8_SB(1, 0), b3, voffB); PG8_STAGE(PG8_SB(1, 1), b3 + hstepB, voffB); PG8_STAGE(PG8_SA(1, 0), a3, voffA);
            PG8_WAIT_V(8); PG8_WAIT_L(0); PG8_BAR; PG8_MMA(1, 0, At, B0); PG8_MMA(1, 1, At, B1); PG8_BAR; PG8_SCHED;
        }
        if constexpr (ALIGN_EPI) { if (wr == 0) PG8_BAR; }
        E(acc, cur, wr, wc, fr, fq);
        if (!has_next) break;
#pragma unroll
        for (int a = 0; a < 2; ++a)
#pragma unroll
            for (int b = 0; b < 2; ++b)
#pragma unroll
                for (int m = 0; m < 4; ++m)
#pragma unroll
                    for (int n = 0; n < 2; ++n) acc[a][b][m][n] = (f32x4){0.f, 0.f, 0.f, 0.f};
        cur = nxt; cA = nA; cB = nB; ++ui;
        if constexpr (ALIGN_EPI) { if (wr == 1) PG8_BAR; }
    }
    PG8_WAIT_V(0);
    if constexpr (!ALIGN_EPI) { if (wr == 0) PG8_BAR; }
    PG8_BAR;
#undef PG8_SA
#undef PG8_SB
#undef PG8_STAGE
#undef PG8_LDA
#undef PG8_LDB
#undef PG8_MMA
#undef PG8_WAIT_V
#undef PG8_WAIT_L
#undef PG8_BAR
#undef PG8_SCHED
}

template <int MODE> struct EpiBf16 {
    static constexpr bool PERM = true;
    bf16* O; int ldc; const float* ss; float ssdiv;
    DI void operator()(const f32x4 (&acc)[2][2][4][2], const Unit& u, int wr, int wc, int fr, int fq) const {
        const int row0 = u.pm * BM + wr * 64 + fr, col0 = u.pn * BM + wc * 32 + 8 * fq;
#pragma unroll
        for (int ai = 0; ai < 2; ++ai)
#pragma unroll
            for (int m = 0; m < 4; ++m) { const int row = row0 + ai * HALF + m * 16; bf16* rowp = O + (size_t)row * ldc + col0;
                float r = 1.f; if (ss) r = __builtin_amdgcn_rsqf(ss[row] * ssdiv + EPS);
#pragma unroll
                for (int bj = 0; bj < 2; ++bj) { f32x4 v0 = acc[ai][bj][m][0] * r, v1 = acc[ai][bj][m][1] * r;
                    if (MODE == 1) {
#pragma unroll
                        for (int j = 0; j < 4; ++j) { const float a = fmaxf(v0[j], 0.f), b = fmaxf(v1[j], 0.f); v0[j] = a * a; v1[j] = b * b; } }
                    u32x4 w; w.x = pk2(v0[0], v0[1]); w.y = pk2(v0[2], v0[3]); w.z = pk2(v1[0], v1[1]); w.w = pk2(v1[2], v1[3]);
                    *(u32x4*)(rowp + bj * HALF) = w; } }
    }
};
struct EpiZ {
    static constexpr bool PERM = true;
    bf16* O; const float* ss; float* ssq;
    DI void operator()(const f32x4 (&acc)[2][2][4][2], const Unit& u, int wr, int wc, int fr, int fq) const {
        const int row0 = u.pm * BM + wr * 64 + fr, col0 = u.pn * BM + wc * 32 + 8 * fq;
#pragma unroll
        for (int ai = 0; ai < 2; ++ai)
#pragma unroll
            for (int m = 0; m < 4; ++m) { const int row = row0 + ai * HALF + m * 16; bf16* rowp = O + (size_t)row * ZW + col0;
                const float r = __builtin_amdgcn_rsqf(ss[row] * (1.f / DM) + EPS);
#pragma unroll
                for (int bj = 0; bj < 2; ++bj) { const f32x4 v0 = acc[ai][bj][m][0] * r, v1 = acc[ai][bj][m][1] * r;
                    u32x4 w; w.x = pk2(v0[0], v0[1]); w.y = pk2(v0[2], v0[3]); w.z = pk2(v1[0], v1[1]); w.w = pk2(v1[2], v1[3]);
                    *(u32x4*)(rowp + bj * HALF) = w;
                    const int blk = u.pn * 2 + bj;
                    if (blk < 5) { float s = ((v0[0] * v0[0] + v0[1] * v0[1]) + (v0[2] * v0[2] + v0[3] * v0[3])) + ((v1[0] * v1[0] + v1[1] * v1[1]) + (v1[2] * v1[2] + v1[3] * v1[3]));
                        s += __shfl_xor(s, 16); s += __shfl_xor(s, 32); if (fq == 0) atomicAdd(ssq + (blk < 3 ? 0 : MT) + row, s); } } }
    }
};
template <int MODE> struct EpiRes {
    static constexpr bool PERM = false;
    const float* base0; const float* base1;
    const bf16* baseb;
    float* H; bf16* XB; float* ssout; const float* ssin; const bf16* PP;
    DI void operator()(const f32x4 (&acc)[2][2][4][2], const Unit& u, int wr, int wc, int fr, int fq) const {
        const int row0 = u.pm * BM + wr * 64 + fr, col0 = u.pn * BM + wc * 32 + 4 * fq;
#pragma unroll
        for (int ai = 0; ai < 2; ++ai)
#pragma unroll
            for (int m = 0; m < 4; ++m) { const int row = row0 + ai * HALF + m * 16;
                const float* bp = (row < MP) ? base0 + (size_t)row * DM : base1 + (size_t)(row - MP) * DM;
                float r = 1.f; if (MODE == 1) r = __builtin_amdgcn_rsqf(ssin[row] * (1.f / DM) + EPS);
                float s = 0.f;
#pragma unroll
                for (int bj = 0; bj < 2; ++bj)
#pragma unroll
                    for (int n = 0; n < 2; ++n) { const int col = col0 + bj * HALF + n * 16;
                        f32x4 v = acc[ai][bj][m][n];
                        if (MODE == 1) { const u32x2 pw = *(const u32x2*)(PP + (size_t)row * DM + col);
                            v[0] = sigmoidf_(v[0] * r) * bflo(pw.x); v[1] = sigmoidf_(v[1] * r) * bfhi(pw.x); v[2] = sigmoidf_(v[2] * r) * bflo(pw.y); v[3] = sigmoidf_(v[3] * r) * bfhi(pw.y); }
                        f32x4 h;
                        if (baseb) { const u32x2 bw = *(const u32x2*)(baseb + (size_t)row * DM + col); h = (f32x4){bflo(bw.x), bfhi(bw.x), bflo(bw.y), bfhi(bw.y)} + v; }
                        else h = *(const f32x4*)(bp + col) + v;
                        if (H) *(f32x4*)(H + (size_t)row * DM + col) = h;
                        if (XB) { u32x2 w; w.x = pk2(h[0], h[1]); w.y = pk2(h[2], h[3]); *(u32x2*)(XB + (size_t)row * DM + col) = w; }
                        s += (h[0] * h[0] + h[1] * h[1]) + (h[2] * h[2] + h[3] * h[3]); }
                if (ssout) { s += __shfl_xor(s, 16); s += __shfl_xor(s, 32); if (fq == 0) atomicAdd(ssout + row, s); } }
    }
};
struct EpiGlu {
    static constexpr bool PERM = false;
    const bf16* baseb; bf16* XB; float* ssout;
    DI void operator()(const f32x4 (&acc)[2][2][4][2], const Unit& u, int wr, int wc, int fr, int fq) const {
        const int row0 = u.pm * BM + wr * 64 + fr, col0 = u.pn * HALF + wc * 32 + 4 * fq;
#pragma unroll
        for (int ai = 0; ai < 2; ++ai)
#pragma unroll
            for (int m = 0; m < 4; ++m) { const int row = row0 + ai * HALF + m * 16; float s = 0.f;
#pragma unroll
                for (int n = 0; n < 2; ++n) { const int col = col0 + n * 16; const f32x4 v = acc[ai][0][m][n], gt = acc[ai][1][m][n];
                    const u32x2 bw = *(const u32x2*)(baseb + (size_t)row * DM + col); f32x4 h = {bflo(bw.x), bfhi(bw.x), bflo(bw.y), bfhi(bw.y)};
#pragma unroll
                    for (int j = 0; j < 4; ++j) h[j] += v[j] * sigmoidf_(gt[j]);
                    u32x2 w; w.x = pk2(h[0], h[1]); w.y = pk2(h[2], h[3]); *(u32x2*)(XB + (size_t)row * DM + col) = w;
                    s += (h[0] * h[0] + h[1] * h[1]) + (h[2] * h[2] + h[3] * h[3]); }
                s += __shfl_xor(s, 16); s += __shfl_xor(s, 32); if (fq == 0) atomicAdd(ssout + row, s); }
    }
};
}
struct Args { const void* in[38]; float* out; unsigned char* ws; int ph_lo, ph_hi; };
enum { I_XP = 0, I_XS, I_CCKV, I_CKPE, I_SGLA, I_S5RE, I_S5IM, I_PT, I_PP, I_PS, I_GNAB, I_WIN, I_GQLAT, I_WUQ, I_GKVLAT, I_WUKV, I_GQH, I_GKH,
       I_WA2, I_BA, I_GGLAO, I_WOUT, I_GNC, I_S5ARE, I_S5AIM, I_S5LDT, I_S5BRE, I_S5BIM, I_S5CRE, I_S5CIM, I_S5D, I_WGLU, I_GNMLP, I_WUP, I_WDN, I_GNPLE, I_WGATE, I_WPROJ };
constexpr int NWAVES = 8, NTHR = 512;
constexpr int LDS_BYTES = 163840;
constexpr int RING_BYTES = 131072;
constexpr int MISC_OFF = 163840 - 256;

struct MapId { DI int operator()(int n) const { return n; } };
struct MapZ {
    DI int operator()(int n) const {
        if (n < 640) return n;
        if (n < 1152) return 672 + (n - 640);
        if (n < 1664) return 1184 + (n - 1152);
        if (n < 2176) return 1696 + (n - 1664);
        if (n < 2688) return 2224 + (n - 2176);
        if (n < 2720) return 640 + (n - 2688);
        if (n < 2736) return 2208 + (n - 2720);
        return -1; }
};
struct MapGlu { DI int operator()(int n) const { const int pn = n >> 8, rr = n & 255; return rr < 128 ? 128 * pn + rr : 1024 + 128 * pn + (rr - 128); } };
template <class Map> DI void transpose_item(const float* W, int K, int N, int Nout, bf16* WT, const float* gain, Map map, LAS float* scr, int item, int lane) {
    const int nblk = Nout / 32, kb = item / nblk, nb = item % nblk, k0 = 64 * kb, n0 = 32 * nb;
    const int n4 = (lane & 7) * 4, kr = lane >> 3, ns = map(n0 + n4);
    f32x4 v[8];
#pragma unroll
    for (int i = 0; i < 8; ++i) { const int kk = kr + 8 * i; v[i] = (f32x4){0.f, 0.f, 0.f, 0.f};
        if (ns >= 0) { v[i] = *(const f32x4*)(W + (size_t)(k0 + kk) * N + ns); if (gain) v[i] = v[i] * gain[k0 + kk]; } }
#pragma unroll
    for (int i = 0; i < 8; ++i) { LAS float* d = scr + (kr + 8 * i) * 33 + n4; d[0] = v[i].x; d[1] = v[i].y; d[2] = v[i].z; d[3] = v[i].w; }
    LDS_WAIT(); asm volatile("" ::: "memory");
    const int c = lane & 7;
#pragma unroll
    for (int j = 0; j < 4; ++j) { const int n = (lane >> 3) + 8 * j; const LAS float* s = scr + (8 * c) * 33 + n;
        u32x4 o; o.x = pk2(s[0 * 33], s[1 * 33]); o.y = pk2(s[2 * 33], s[3 * 33]); o.z = pk2(s[4 * 33], s[5 * 33]); o.w = pk2(s[6 * 33], s[7 * 33]);
        *(u32x4*)(WT + (size_t)(n0 + n) * K + k0 + 8 * c) = o; }
    LDS_WAIT(); asm volatile("" ::: "memory");
}

DI void s5_setup_item(const Args& a, LAS unsigned char* lds, int g, int qt, int tid) {
    LAS float* LPr = (LAS float*)lds;
    LAS float* LPi = LPr + 64 * 34;
    LAS float* BBr = LPi + 64 * 34;
    LAS float* BBi = BBr + 64 * 16;
    LAS float* Cr = BBi + 64 * 16;
    LAS float* Ci = Cr + 16 * 64;
    LAS float* KT = Ci + 16 * 64;
    const float* are = (const float*)a.in[I_S5ARE] + g * 64; const float* aim = (const float*)a.in[I_S5AIM] + g * 64;
    const float dt = expf(((const float*)a.in[I_S5LDT])[g]);
    float* tab = (float*)(a.ws + WS_S5TAB);
    __syncthreads();
    for (int i = tid; i < 64 * 17; i += NTHR) { const int p = i / 17, tau = i % 17;
        const float ar = are[p] * dt * (float)tau, ai = aim[p] * dt * (float)tau, mg = expf(ar);
        LPr[p * 34 + tau] = mg * cosf(ai); LPi[p * 34 + tau] = mg * sinf(ai); }
    for (int i = tid; i < 64 * 16; i += NTHR) { const int p = i >> 4, c = i & 15;
        const float ar = are[p], ai = aim[p], mg = expf(ar * dt), lr = mg * cosf(ai * dt), li = mg * sinf(ai * dt), den = ar * ar + ai * ai;
        const float cr = ((lr - 1.0f) * ar + li * ai) / den, ci = (li * ar - (lr - 1.0f) * ai) / den;
        const float br = ((const float*)a.in[I_S5BRE])[((size_t)g * 64 + p) * 16 + c], bi = ((const float*)a.in[I_S5BIM])[((size_t)g * 64 + p) * 16 + c];
        BBr[i] = cr * br - ci * bi; BBi[i] = cr * bi + ci * br;
        const int co = i >> 6, pp = i & 63;
        Cr[i] = ((const float*)a.in[I_S5CRE])[((size_t)g * 16 + co) * 64 + pp]; Ci[i] = ((const float*)a.in[I_S5CIM])[((size_t)g * 16 + co) * 64 + pp]; }
    __syncthreads();
    if (qt == 0) {
        for (int i = tid; i < 64; i += NTHR) { float* L = tab + ((size_t)g * 64 + i) * 2; L[0] = LPr[i * 34 + 1]; L[1] = LPi[i * 34 + 1];
            float* LT = tab + 8192 + ((size_t)g * 64 + i) * 2; LT[0] = LPr[i * 34 + 16]; LT[1] = LPi[i * 34 + 16]; }
        for (int i = tid; i < 1024; i += NTHR) { float* B = tab + 16384 + ((size_t)g * 1024 + i) * 2; B[0] = BBr[i]; B[1] = BBi[i]; }
    }
    if (tid < 256) { const int tau = tid >> 4, co = tid & 15; float acc[16];
#pragma unroll
        for (int j = 0; j < 16; ++j) acc[j] = 0.f;
        for (int p = 0; p < 64; ++p) { const float lr = LPr[p * 34 + tau], li = LPi[p * 34 + tau], cr = Cr[co * 64 + p], ci = Ci[co * 64 + p];
            const float tr = cr * lr - ci * li, ti = cr * li + ci * lr;
#pragma unroll
            for (int q = 0; q < 4; ++q) { const f32x4 br = *(const LAS f32x4*)(BBr + p * 16 + 4 * q), bi = *(const LAS f32x4*)(BBi + p * 16 + 4 * q);
                acc[4 * q + 0] += tr * br.x - ti * bi.x; acc[4 * q + 1] += tr * br.y - ti * bi.y; acc[4 * q + 2] += tr * br.z - ti * bi.z; acc[4 * q + 3] += tr * br.w - ti * bi.w; } }
#pragma unroll
        for (int j = 0; j < 16; ++j) KT[(tau * 16 + co) * 16 + j] = acc[j]; }
    __syncthreads();
    LAS float* LTr = KT + 32 * 256; LAS float* LTi = LTr + 33 * 68;
    for (int i = tid; i < 64 * 17; i += NTHR) { const int p = i & 63, tau = i >> 6; LTr[tau * 68 + p] = LPr[p * 34 + tau]; LTi[tau * 68 + p] = LPi[p * 34 + tau]; }
    __syncthreads();
    bf16* TN = (bf16*)(a.ws + WS_S5TN) + (size_t)g * 256 * S5K;
    for (int i = tid; i < 64 * 48; i += NTHR) { const int row = 64 * qt + i / 48, kg = i % 48, t = row >> 4, co = row & 15; f32x4 v0 = {0.f, 0.f, 0.f, 0.f}, v1 = {0.f, 0.f, 0.f, 0.f};
        if (kg < 32) { const int sidx = kg >> 1, hf = kg & 1; if (sidx <= t) { const LAS f32x4* kp = (const LAS f32x4*)(KT + ((t - sidx) * 16 + co) * 16 + 8 * hf); v0 = kp[0]; v1 = kp[1]; } }
        else { const int p0 = ((kg - 32) & 7) * 8; const bool im = kg >= 40;
            const LAS f32x4* cr4 = (const LAS f32x4*)(Cr + co * 64 + p0); const LAS f32x4* ci4 = (const LAS f32x4*)(Ci + co * 64 + p0);
            const LAS f32x4* lr4 = (const LAS f32x4*)(LTr + (t + 1) * 68 + p0); const LAS f32x4* li4 = (const LAS f32x4*)(LTi + (t + 1) * 68 + p0);
            if (!im) { v0 = cr4[0] * lr4[0] - ci4[0] * li4[0]; v1 = cr4[1] * lr4[1] - ci4[1] * li4[1]; }
            else { v0 = -(cr4[0] * li4[0] + ci4[0] * lr4[0]); v1 = -(cr4[1] * li4[1] + ci4[1] * lr4[1]); } }
        u32x4 o; o.x = pk2(v0.x, v0.y); o.y = pk2(v0.z, v0.w); o.z = pk2(v1.x, v1.y); o.w = pk2(v1.z, v1.w);
        *(u32x4*)(TN + (size_t)row * S5K + kg * 8) = o; }
    bf16* BD = (bf16*)(a.ws + WS_S5BD) + (size_t)(g >> 1) * 256 * (2 * S5K);
    for (int i = tid; i < 32 * 96; i += NTHR) { const int rr = 32 * qt + i / 96, kg = i % 96, reim = rr >> 6, p = rr & 63, row = (g & 1) * 128 + rr; f32x4 v0 = {0.f, 0.f, 0.f, 0.f}, v1 = {0.f, 0.f, 0.f, 0.f};
        const int kgl = kg - (g & 1) * 48;
        if (kgl >= 0 && kgl < 32) { const int t = kgl >> 1, hf = kgl & 1; const float lr = LPr[p * 34 + 15 - t], li = LPi[p * 34 + 15 - t];
            const LAS f32x4* br4 = (const LAS f32x4*)(BBr + p * 16 + 8 * hf); const LAS f32x4* bi4 = (const LAS f32x4*)(BBi + p * 16 + 8 * hf);
            if (reim) { v0 = br4[0] * li + bi4[0] * lr; v1 = br4[1] * li + bi4[1] * lr; } else { v0 = br4[0] * lr - bi4[0] * li; v1 = br4[1] * lr - bi4[1] * li; } }
        u32x4 o; o.x = pk2(v0.x, v0.y); o.y = pk2(v0.z, v0.w); o.z = pk2(v1.x, v1.y); o.w = pk2(v1.z, v1.w);
        *(u32x4*)(BD + (size_t)row * (2 * S5K) + kg * 8) = o; }
}

DI void p0_prologue(const Args& a, LAS unsigned char* lds, int vcu, int G, int tid, int lane, int wave) {
    LAS float* scr = (LAS float*)(lds + wave * 16384);
    const int gw = vcu * NWAVES + wave, NGW = G * NWAVES;
    unsigned char* ws = a.ws;
    constexpr int I_IN = 16 * (ZW / 32), I_UQ = 6 * 24, I_UKV = 2 * 4 * 32, I_OUT = 16 * 32, I_GLU = 16 * 64, I_UP = 16 * 128, I_DN = 64 * 32, I_GATE = 16 * 32, I_PROJ = 4 * 32;
    constexpr int NITEMS = I_IN + I_UQ + I_UKV + I_OUT + I_GLU + 2 * (I_UP + I_DN + I_GATE + I_PROJ);
    for (int it = gw; it < NITEMS; it += NGW) {
        int r = it;
        if (r < I_IN) { transpose_item((const float*)a.in[I_WIN], DM, 2736, ZW, (bf16*)(ws + WS_WIN), (const float*)a.in[I_GNAB], MapZ(), scr, r, lane); continue; } r -= I_IN;
        if (r < I_UQ) { transpose_item((const float*)a.in[I_WUQ], QL, 768, 768, (bf16*)(ws + WS_WUQ), (const float*)a.in[I_GQLAT], MapId(), scr, r, lane); continue; } r -= I_UQ;
        if (r < I_UKV) { if (r < 128) transpose_item((const float*)a.in[I_WUKV], KVL, 1024, 1024, (bf16*)(ws + WS_WUKV), nullptr, MapId(), scr, r, lane);
            else transpose_item((const float*)a.in[I_WUKV], KVL, 1024, 1024, (bf16*)(ws + WS_WUKVG), (const float*)a.in[I_GKVLAT], MapId(), scr, r - 128, lane); continue; } r -= I_UKV;
        if (r < I_OUT) { transpose_item((const float*)a.in[I_WOUT], DM, DM, DM, (bf16*)(ws + WS_WOUT), nullptr, MapId(), scr, r, lane); continue; } r -= I_OUT;
        if (r < I_GLU) { transpose_item((const float*)a.in[I_WGLU], DM, 2048, 2048, (bf16*)(ws + WS_WGLU), nullptr, MapGlu(), scr, r, lane); continue; } r -= I_GLU;
        const int li = r / (I_UP + I_DN + I_GATE + I_PROJ); r -= li * (I_UP + I_DN + I_GATE + I_PROJ);
        if (r < I_UP) { transpose_item((const float*)a.in[I_WUP] + (size_t)li * DM * FF, DM, FF, FF, (bf16*)(ws + WS_WUP) + (size_t)li * FF * DM, (const float*)a.in[I_GNMLP] + li * DM, MapId(), scr, r, lane); continue; } r -= I_UP;
        if (r < I_DN) { transpose_item((const float*)a.in[I_WDN] + (size_t)li * FF * DM, FF, DM, DM, (bf16*)(ws + WS_WDN) + (size_t)li * DM * FF, nullptr, MapId(), scr, r, lane); continue; } r -= I_DN;
        if (r < I_GATE) { transpose_item((const float*)a.in[I_WGATE] + (size_t)li * DM * DM, DM, DM, DM, (bf16*)(ws + WS_WGATE) + (size_t)li * DM * DM, (const float*)a.in[I_GNPLE] + li * DM, MapId(), scr, r, lane); continue; } r -= I_GATE;
        transpose_item((const float*)a.in[I_WPROJ] + (size_t)li * PLE * DM, PLE, DM, DM, (bf16*)(ws + WS_WPROJ) + (size_t)li * DM * PLE, nullptr, MapId(), scr, r, lane);
    }
    float* ss0 = (float*)(ws + WS_SSQ) + MT;
    for (int m0 = gw; m0 < MT; m0 += 4 * NGW) {
        int mr[4]; const f32x4* xr[4]; f32x4 v[4][4];
#pragma unroll
        for (int q = 0; q < 4; ++q) { mr[q] = (m0 + q * NGW < MT) ? m0 + q * NGW : m0;
            xr[q] = (const f32x4*)((mr[q] < MP) ? (const float*)a.in[I_XP] + (size_t)mr[q] * DM : (const float*)a.in[I_XS] + (size_t)(mr[q] - MP) * DM) + lane; }
#pragma unroll
        for (int q = 0; q < 4; ++q)
#pragma unroll
            for (int j = 0; j < 4; ++j) v[q][j] = xr[q][64 * j];
#pragma unroll
        for (int q = 0; q < 4; ++q) { u32x2* o8 = (u32x2*)((bf16*)(ws + WS_XB0) + (size_t)mr[q] * DM) + lane; float s = 0.f;
#pragma unroll
            for (int j = 0; j < 4; ++j) { const f32x4 t = v[q][j]; s += (t.x * t.x + t.y * t.y) + (t.z * t.z + t.w * t.w); u32x2 w; w.x = pk2(t.x, t.y); w.y = pk2(t.z, t.w); o8[64 * j] = w; }
            s = wave_sum(s); if (lane == 0) ss0[mr[q]] = s; }
    }
    { const int gt = vcu * NTHR + tid, NGT = G * NTHR; constexpr int NV = 2 * MT * PLE / 8;
        for (int i0 = gt; i0 < NV; i0 += 4 * NGT) { f32x4 v0[4], v1[4]; int ii[4];
#pragma unroll
            for (int q = 0; q < 4; ++q) { const int i = (i0 + q * NGT < NV) ? i0 + q * NGT : i0; ii[q] = i; const int li = i / (MT * PLE / 8), r = i % (MT * PLE / 8), row = r / (PLE / 8), c8 = r % (PLE / 8);
                const float* src = (row < MP) ? (const float*)a.in[I_PP] + ((size_t)li * MP + row) * PLE : (const float*)a.in[I_PS] + ((size_t)li * MS + (row - MP)) * PLE;
                v0[q] = *(const f32x4*)(src + c8 * 8); v1[q] = *(const f32x4*)(src + c8 * 8 + 4); }
#pragma unroll
            for (int q = 0; q < 4; ++q) { u32x4 o; o.x = pk2(v0[q].x, v0[q].y); o.y = pk2(v0[q].z, v0[q].w); o.z = pk2(v1[q].x, v1[q].y); o.w = pk2(v1[q].z, v1[q].w);
                *(u32x4*)((bf16*)(ws + WS_PB) + (size_t)ii[q] * 8) = o; } } }
    { const int gt = vcu * NTHR + tid, NGT = G * NTHR; float* rc = (float*)(ws + WS_ROPE); float* rs = rc + 8200 * 16;
        for (int i = gt; i < 8200 * 16; i += NGT) { const int pos = i >> 4, k = i & 15; const float fr = powf(10000.0f, -(float)k / 16.0f), ang = (float)pos * fr; rc[i] = cosf(ang); rs[i] = sinf(ang); } }
    for (int it = vcu; it < 256; it += G) s5_setup_item(a, lds, it >> 2, it & 3, tid);
}
constexpr float QSCALE = 0.10206207261596575f * 1.4426950408889634f;
DI u32x4 prep_vec(u32x4 w, int li, int pos, const float* rc, const float* rs, const f32x4& g0, const f32x4& g1, float scale) {
    float x[8] = {bflo(w.x), bfhi(w.x), bflo(w.y), bfhi(w.y), bflo(w.z), bfhi(w.z), bflo(w.w), bfhi(w.w)};
    float ss = ((x[0] * x[0] + x[1] * x[1]) + (x[2] * x[2] + x[3] * x[3])) + ((x[4] * x[4] + x[5] * x[5]) + (x[6] * x[6] + x[7] * x[7]));
    ss = row16_sum(ss);
    const float r = __builtin_amdgcn_rsqf(ss * (1.f / 96.f) + EPS) ;
    float y[8] = {x[0] * r * g0.x, x[1] * r * g0.y, x[2] * r * g0.z, x[3] * r * g0.w, x[4] * r * g1.x, x[5] * r * g1.y, x[6] * r * g1.z, x[7] * r * g1.w};
    float yo[8];
#pragma unroll
    for (int j = 0; j < 8; ++j) yo[j] = __builtin_bit_cast(float, __builtin_amdgcn_update_dpp(0, __builtin_bit_cast(int, y[j]), 0x4E, 0xf, 0xf, false));
    if (li >= 8) { const f32x4 c0 = *(const f32x4*)(rc + pos * 16 + 8 * (li & 1)), c1 = *(const f32x4*)(rc + pos * 16 + 8 * (li & 1) + 4), s0 = *(const f32x4*)(rs + pos * 16 + 8 * (li & 1)), s1 = *(const f32x4*)(rs + pos * 16 + 8 * (li & 1) + 4);
        const float c[8] = {c0.x, c0.y, c0.z, c0.w, c1.x, c1.y, c1.z, c1.w}, sn[8] = {s0.x, s0.y, s0.z, s0.w, s1.x, s1.y, s1.z, s1.w};
#pragma unroll
        for (int j = 0; j < 8; ++j) y[j] = (li < 10) ? (y[j] * c[j] - yo[j] * sn[j]) : (y[j] * c[j] + yo[j] * sn[j]); }
    u32x4 o; o.x = pk2(y[0] * scale, y[1] * scale); o.y = pk2(y[2] * scale, y[3] * scale); o.z = pk2(y[4] * scale, y[5] * scale); o.w = pk2(y[6] * scale, y[7] * scale);
    return o;
}
DI void p4_attn_prep(const Args& a, LAS unsigned char* lds, int vcu, int G, int tid, int lane, int wave) {
    const bf16* QR = (const bf16*)(a.ws + WS_QRAW); const bf16* KV = (const bf16*)(a.ws + WS_KVRAW); const bf16* Z = (const bf16*)(a.ws + WS_Z);
    bf16* QF = (bf16*)(a.ws + WS_QF); bf16* KF = (bf16*)(a.ws + WS_KF);
    const float* rc = (const float*)(a.ws + WS_ROPE); const float* rs = rc + 8200 * 16;
    const float* gqh = (const float*)a.in[I_GQH]; const float* gkh = (const float*)a.in[I_GKH]; const float* gkv = (const float*)a.in[I_GKVLAT];
    const float* ssckv = (const float*)(a.ws + WS_CTL) + CW_SS + 7 * MT; bf16* ckvb = (bf16*)(a.ws + WS_CKVB);
    const int li = lane & 15, gq = lane >> 4, lic = li < 12 ? li : 11;
    const f32x4 gq0 = *(const f32x4*)(gqh + 8 * lic), gq1 = *(const f32x4*)(gqh + 8 * lic + 4), gk0 = *(const f32x4*)(gkh + 8 * lic), gk1 = *(const f32x4*)(gkh + 8 * lic + 4);
    for (int tile = vcu; tile < MP / 64; tile += G) {
        const int row0 = tile * 64;
#pragma unroll 1
        for (int s4 = 0; s4 < 4; ++s4) { u32x4 w[4];
#pragma unroll
            for (int e = 0; e < 4; ++e) { const int idx = (s4 * 4 + e) * 4 + gq, rl = wave * 8 + (idx >> 3), h = idx & 7; const size_t row = (size_t)row0 + rl;
                const bf16* src = li < 8 ? KV + row * 1024 + h * 128 + 8 * li : Z + row * ZW + ZC_KPE + 8 * (lic - 8);
                w[e] = *(const u32x4*)src; if (li >= 12) w[e] = (u32x4){0u, 0u, 0u, 0u}; }
#pragma unroll
            for (int e = 0; e < 4; ++e) { const int idx = (s4 * 4 + e) * 4 + gq, rl = wave * 8 + (idx >> 3), h = idx & 7; const size_t row = (size_t)row0 + rl; const int pos = (int)(row & (SEQ - 1));
                const u32x4 o = prep_vec(w[e], li, pos, rc, rs, gk0, gk1, 1.f);
                if (li < 12) *(u32x4*)(KF + row * 768 + h * 96 + 8 * li) = o; }
        }
#pragma unroll
        for (int rep = 0; rep < 4; ++rep) { const int i8 = tid + NTHR * rep, rl = i8 >> 5, c8 = (i8 & 31) * 8; const size_t row = (size_t)row0 + rl;
            const float r = __builtin_amdgcn_rsqf(ssckv[row] * (1.f / KVL) + EPS); const u32x4 w = *(const u32x4*)(Z + row * ZW + ZC_CKV + c8); const f32x4 g0 = *(const f32x4*)(gkv + c8), g1 = *(const f32x4*)(gkv + c8 + 4);
            float* o = a.out + O_CKVP + row * KVL + c8;
            *(f32x4*)o = (f32x4){bflo(w.x) * r * g0.x, bfhi(w.x) * r * g0.y, bflo(w.y) * r * g0.z, bfhi(w.y) * r * g0.w}; *(f32x4*)(o + 4) = (f32x4){bflo(w.z) * r * g1.x, bfhi(w.z) * r * g1.y, bflo(w.w) * r * g1.z, bfhi(w.w) * r * g1.w}; }
        if (tid < 256) { const int rl = tid >> 2, c8 = (tid & 3) * 8; const size_t row = (size_t)row0 + rl; const u32x4 w = *(const u32x4*)(Z + row * ZW + ZC_KPE + c8); float* o = a.out + O_KPEP + row * ROPE + c8;
            *(f32x4*)o = (f32x4){bflo(w.x), bfhi(w.x), bflo(w.y), bfhi(w.y)}; *(f32x4*)(o + 4) = (f32x4){bflo(w.z), bfhi(w.z), bflo(w.w), bfhi(w.w)}; }
    }
    for (int sr = 2 * vcu; sr < MS; sr += 2 * G) {
        if (wave < 4) { const int idx = wave * 4 + gq, row = MP + sr + (idx >> 3), h = idx & 7; const int pos = PAST + ((row - MP) & 3);
            u32x4 w = *(const u32x4*)(QR + (size_t)row * 768 + h * 96 + 8 * lic); if (li >= 12) w = (u32x4){0u, 0u, 0u, 0u};
            const u32x4 o = prep_vec(w, li, pos, rc, rs, gq0, gq1, QSCALE);
            if (li < 12) *(u32x4*)(QF + (size_t)row * 768 + h * 96 + 8 * li) = o; }
        if (tid < 64) { const int rl = tid >> 5, c8 = (tid & 31) * 8; const size_t srow = (size_t)sr + rl, grow = MP + srow;
            const float rr = __builtin_amdgcn_rsqf(ssckv[grow] * (1.f / KVL) + EPS); const u32x4 w = *(const u32x4*)(Z + grow * ZW + ZC_CKV + c8); const f32x4 g0 = *(const f32x4*)(gkv + c8), g1 = *(const f32x4*)(gkv + c8 + 4);
            const f32x4 v0 = {bflo(w.x) * rr * g0.x, bfhi(w.x) * rr * g0.y, bflo(w.y) * rr * g0.z, bfhi(w.y) * rr * g0.w}, v1 = {bflo(w.z) * rr * g1.x, bfhi(w.z) * rr * g1.y, bflo(w.w) * rr * g1.z, bfhi(w.w) * rr * g1.w};
            float* oo = a.out + O_CKVS + srow * KVL + c8; *(f32x4*)oo = v0; *(f32x4*)(oo + 4) = v1;
            u32x4 ww; ww.x = pk2(v0.x, v0.y); ww.y = pk2(v0.z, v0.w); ww.z = pk2(v1.x, v1.y); ww.w = pk2(v1.z, v1.w); *(u32x4*)(ckvb + grow * KVL + c8) = ww; }
        else if (tid < 72) { const int j = tid - 64, rl = j >> 2, c8 = (j & 3) * 8; const size_t srow = (size_t)sr + rl, grow = MP + srow; const u32x4 w = *(const u32x4*)(Z + grow * ZW + ZC_KPE + c8); float* oo = a.out + O_KPES + srow * ROPE + c8;
            *(f32x4*)oo = (f32x4){bflo(w.x), bfhi(w.x), bflo(w.y), bfhi(w.y)}; *(f32x4*)(oo + 4) = (f32x4){bflo(w.z), bfhi(w.z), bflo(w.w), bfhi(w.w)}; }
    }
}
#define MFMA32(a, b, c) __builtin_amdgcn_mfma_f32_32x32x16_bf16((a), (b), (c), 0, 0, 0)
#define MFMA16(a, b, c) __builtin_amdgcn_mfma_f32_16x16x32_bf16((a), (b), (c), 0, 0, 0)
DI int crow(int r, int hi) { return (r & 3) + 8 * (r >> 2) + 4 * hi; }
DI bf16x8 pack8(const f32x16& x, int s) {
    u32x4 p; p.x = pk2(x[8 * s + 0], x[8 * s + 1]); p.y = pk2(x[8 * s + 2], x[8 * s + 3]); p.z = pk2(x[8 * s + 4], x[8 * s + 5]); p.w = pk2(x[8 * s + 6], x[8 * s + 7]);
    return __builtin_bit_cast(bf16x8, p);
}
DI bf16x8 cat44(u32x2 lo, u32x2 hi) { u32x4 p = {lo.x, lo.y, hi.x, hi.y}; return __builtin_bit_cast(bf16x8, p); }
constexpr float GQS = 0.08838834764831845f;
DI bf16x8 tr_frag(const LAS bf16* base, int stride, int rowA, int rowB, int col0, int lane) {
    const int q = (lane & 15) >> 2, p = lane & 3, blk = (lane >> 4) & 1;
    const LAS bf16* a = base + (rowA + q) * stride + col0 + 16 * blk + 4 * p; const LAS bf16* b = base + (rowB + q) * stride + col0 + 16 * blk + 4 * p;
    const s16x4 lo = __builtin_bit_cast(s16x4, __builtin_amdgcn_ds_read_tr16_b64_v4i16((LAS v4i16_t*)a)), hi = __builtin_bit_cast(s16x4, __builtin_amdgcn_ds_read_tr16_b64_v4i16((LAS v4i16_t*)b));
    return __builtin_shufflevector(lo, hi, 0, 1, 2, 3, 4, 5, 6, 7);
}

DI void gla_a_phase(const Args& a, LAS unsigned char* lds, int vcu, int G, int tid, int lane, int wave) {
    LAS float* bt = (LAS float*)lds;
    LAS bf16* KB = (LAS bf16*)(lds + 32768);
    LAS bf16* VH = (LAS bf16*)(lds + 32768 + 20480);
    LAS float* gas = (LAS float*)(lds + 32768 + 2 * 20480);
    const float* wa2_ = (const float*)a.in[I_WA2]; const float* ba_ = (const float*)a.in[I_BA]; const bf16* Z = (const bf16*)(a.ws + WS_Z);
    float* GU = (float*)(a.ws + WS_GU); float* GDEC = (float*)(a.ws + WS_GDEC);
    const int r32 = lane & 31, h2 = lane >> 5;
    float wcol[16], bias = 0.f; int hcur = -1;
#pragma unroll
    for (int r = 0; r < 16; ++r) wcol[r] = 0.f;
    for (int u = vcu; u < 1024; u += G) {
        const int b = u >> 7, h = (u >> 5) & 3, c = u & 31, row0 = b * SEQ + c * 64;
        __syncthreads();
        if (tid < 128) { const u32x4 w = *(const u32x4*)(Z + (size_t)(row0 + (tid >> 1)) * ZW + ZC_GA + (tid & 1) * 8); LAS f32x4* gd = (LAS f32x4*)(gas + tid * 8);
            gd[0] = (f32x4){bflo(w.x), bfhi(w.x), bflo(w.y), bfhi(w.y)}; gd[1] = (f32x4){bflo(w.z), bfhi(w.z), bflo(w.w), bfhi(w.w)}; }
        __syncthreads();
        { const int dk = tid & 127, sg = tid >> 7; float s = 0.f;
            if (h != hcur) { hcur = h; bias = ba_[h * 128 + dk];
#pragma unroll
                for (int r = 0; r < 16; ++r) wcol[r] = wa2_[r * 512 + h * 128 + dk]; }
#pragma unroll 4
            for (int t = 0; t < 16; ++t) { const LAS f32x4* gp = (const LAS f32x4*)(gas + (sg * 16 + t) * 16); const f32x4 g0 = gp[0], g1 = gp[1], g2 = gp[2], g3 = gp[3];
                float x = bias + ((g0.x * wcol[0] + g0.y * wcol[1]) + (g0.z * wcol[2] + g0.w * wcol[3])) + ((g1.x * wcol[4] + g1.y * wcol[5]) + (g1.z * wcol[6] + g1.w * wcol[7]))
                               + ((g2.x * wcol[8] + g2.y * wcol[9]) + (g2.z * wcol[10] + g2.w * wcol[11])) + ((g3.x * wcol[12] + g3.y * wcol[13]) + (g3.z * wcol[14] + g3.w * wcol[15]));
                s += (fminf(x, 0.f) - __logf(1.f + __expf(-fabsf(x)))) * (1.f / 16.f); bt[(sg * 16 + t) * 128 + dk] = s; }
            __syncthreads();
            float off = 0.f;
#pragma unroll
            for (int q = 0; q < 3; ++q) if (q < sg) off += bt[(q * 16 + 15) * 128 + dk];
            __syncthreads();
#pragma unroll
            for (int t = 0; t < 16; ++t) bt[(sg * 16 + t) * 128 + dk] += off;
            if (sg == 3) GDEC[(size_t)u * 128 + dk] = __expf(s + off); }
        __syncthreads();
#pragma unroll
        for (int rep = 0; rep < 2; ++rep) { const int i8 = tid + NTHR * rep, t = i8 >> 4, d8 = (i8 & 15) * 8; const bf16* zr = Z + (size_t)(row0 + t) * ZW + h * 128 + d8;
            const u32x4 kw = *(const u32x4*)(zr + ZC_GK), vw = *(const u32x4*)(zr + ZC_GV);
            const f32x4 b0 = *(const LAS f32x4*)(bt + t * 128 + d8), b1 = *(const LAS f32x4*)(bt + t * 128 + d8 + 4), B0 = *(const LAS f32x4*)(bt + 63 * 128 + d8), B1 = *(const LAS f32x4*)(bt + 63 * 128 + d8 + 4);
            u32x4 o; o.x = pk2(bflo(kw.x) * __expf(B0.x - b0.x), bfhi(kw.x) * __expf(B0.y - b0.y)); o.y = pk2(bflo(kw.y) * __expf(B0.z - b0.z), bfhi(kw.y) * __expf(B0.w - b0.w));
            o.z = pk2(bflo(kw.z) * __expf(B1.x - b1.x), bfhi(kw.z) * __expf(B1.y - b1.y)); o.w = pk2(bflo(kw.w) * __expf(B1.z - b1.z), bfhi(kw.w) * __expf(B1.w - b1.w));
            *(LAS u32x4*)(KB + t * 160 + d8) = o; *(LAS u32x4*)(VH + t * 160 + d8) = vw; }
        __syncthreads();
        const int dkb = wave >> 1;
#pragma unroll
        for (int e = 0; e < 2; ++e) { const int dvb = 2 * (wave & 1) + e; f32x16 acc = {};
#pragma unroll
            for (int s = 0; s < 4; ++s) { const bf16x8 af = tr_frag(KB, 160, 16 * s + 8 * h2, 16 * s + 8 * h2 + 4, dkb * 32, lane), bfv = tr_frag(VH, 160, 16 * s + 8 * h2, 16 * s + 8 * h2 + 4, dvb * 32, lane);
                acc = MFMA32(bfv, af, acc); }
            float* o = GU + (size_t)u * 16384 + (size_t)(dkb * 32 + r32) * 128 + dvb * 32 + 4 * h2;
#pragma unroll
            for (int q = 0; q < 4; ++q) *(f32x4*)(o + 8 * q) = (f32x4){acc[4 * q], acc[4 * q + 1], acc[4 * q + 2], acc[4 * q + 3]}; }
    }
}

DI void gla_b_phase(const Args& a, int vcu, int G, int tid) {
    const float* GU = (const float*)(a.ws + WS_GU); const float* GDEC = (const float*)(a.ws + WS_GDEC); bf16* GSP = (bf16*)(a.ws + WS_GSP);
    for (int i = vcu * NTHR + tid; i < 32 * 128 * 32; i += G * NTHR) { const int bh = i >> 12, dk = (i >> 5) & 127, dv = (i & 31) * 4;
        f32x4 S = {0.f, 0.f, 0.f, 0.f};
#pragma unroll 4
        for (int c = 0; c < 32; ++c) { const size_t u = (size_t)bh * 32 + c; const f32x4 U = *(const f32x4*)(GU + u * 16384 + dk * 128 + dv); const float d = GDEC[u * 128 + dk];
            u32x2 w; w.x = pk2(S.x, S.y); w.y = pk2(S.z, S.w); *(u32x2*)(GSP + u * 16384 + dk * 128 + dv) = w;
            S = S * d + U; }
        *(f32x4*)(a.out + O_GLAP + (size_t)bh * 16384 + dk * 128 + dv) = S; }
}

DI void gla_c_phase(const Args& a, LAS unsigned char* lds, int vcu, int G, int tid, int lane, int wave) {
    LAS float* bt = (LAS float*)lds;
    LAS bf16* QH = (LAS bf16*)(lds + 32768);
    LAS bf16* KH = (LAS bf16*)(lds + 32768 + 17408);
    LAS bf16* VH = (LAS bf16*)(lds + 32768 + 2 * 17408);
    LAS bf16* SH = (LAS bf16*)(lds + 32768 + 2 * 17408 + 20480);
    LAS float* RS = (LAS float*)(lds + 32768 + 2 * 17408 + 20480 + 40960);
    LAS float* gas = RS + 256;
    const float* wa2_ = (const float*)a.in[I_WA2]; const float* ba_ = (const float*)a.in[I_BA]; const bf16* Z = (const bf16*)(a.ws + WS_Z); const bf16* GSP = (const bf16*)(a.ws + WS_GSP); bf16* MIX = (bf16*)(a.ws + WS_MIX);
    const float* go = (const float*)a.in[I_GGLAO];
    const int r32 = lane & 31, h2 = lane >> 5, dvb = wave >> 1, tb = wave & 1;
    float wcol[16], bias = 0.f; int hcur = -1;
#pragma unroll
    for (int r = 0; r < 16; ++r) wcol[r] = 0.f;
    for (int u = vcu; u < 1024; u += G) {
        const int b = u >> 7, h = (u >> 5) & 3, c = u & 31, row0 = b * SEQ + c * 64;
        __syncthreads();
        if (tid < 128) { const u32x4 w = *(const u32x4*)(Z + (size_t)(row0 + (tid >> 1)) * ZW + ZC_GA + (tid & 1) * 8); LAS f32x4* gd = (LAS f32x4*)(gas + tid * 8);
            gd[0] = (f32x4){bflo(w.x), bfhi(w.x), bflo(w.y), bfhi(w.y)}; gd[1] = (f32x4){bflo(w.z), bfhi(w.z), bflo(w.w), bfhi(w.w)}; }
        __syncthreads();
        { const int dk = tid & 127, sg = tid >> 7; float s = 0.f;
            if (h != hcur) { hcur = h; bias = ba_[h * 128 + dk];
#pragma unroll
                for (int r = 0; r < 16; ++r) wcol[r] = wa2_[r * 512 + h * 128 + dk]; }
#pragma unroll 4
            for (int t = 0; t < 16; ++t) { const LAS f32x4* gp = (const LAS f32x4*)(gas + (sg * 16 + t) * 16); const f32x4 g0 = gp[0], g1 = gp[1], g2 = gp[2], g3 = gp[3];
                float x = bias + ((g0.x * wcol[0] + g0.y * wcol[1]) + (g0.z * wcol[2] + g0.w * wcol[3])) + ((g1.x * wcol[4] + g1.y * wcol[5]) + (g1.z * wcol[6] + g1.w * wcol[7]))
                               + ((g2.x * wcol[8] + g2.y * wcol[9]) + (g2.z * wcol[10] + g2.w * wcol[11])) + ((g3.x * wcol[12] + g3.y * wcol[13]) + (g3.z * wcol[14] + g3.w * wcol[15]));
                s += (fminf(x, 0.f) - __logf(1.f + __expf(-fabsf(x)))) * (1.f / 16.f); bt[(sg * 16 + t) * 128 + dk] = s; }
            __syncthreads();
            float off = 0.f;
#pragma unroll
            for (int q = 0; q < 3; ++q) if (q < sg) off += bt[(q * 16 + 15) * 128 + dk];
            __syncthreads();
#pragma unroll
            for (int t = 0; t < 16; ++t) bt[(sg * 16 + t) * 128 + dk] += off;
        }
        __syncthreads();
#pragma unroll
        for (int rep = 0; rep < 2; ++rep) { const int i8 = tid + NTHR * rep, t = i8 >> 4, d8 = (i8 & 15) * 8; const bf16* zr = Z + (size_t)(row0 + t) * ZW + h * 128 + d8;
            const u32x4 qw = *(const u32x4*)(zr + ZC_GQ), kw = *(const u32x4*)(zr + ZC_GK), vw = *(const u32x4*)(zr + ZC_GV);
            const f32x4 b0 = *(const LAS f32x4*)(bt + t * 128 + d8), b1 = *(const LAS f32x4*)(bt + t * 128 + d8 + 4);
            const float e0 = __expf(b0.x), e1 = __expf(b0.y), e2 = __expf(b0.z), e3 = __expf(b0.w), e4 = __expf(b1.x), e5 = __expf(b1.y), e6 = __expf(b1.z), e7 = __expf(b1.w);
            u32x4 oq, ok;
            oq.x = pk2(bflo(qw.x) * GQS * e0, bfhi(qw.x) * GQS * e1); oq.y = pk2(bflo(qw.y) * GQS * e2, bfhi(qw.y) * GQS * e3); oq.z = pk2(bflo(qw.z) * GQS * e4, bfhi(qw.z) * GQS * e5); oq.w = pk2(bflo(qw.w) * GQS * e6, bfhi(qw.w) * GQS * e7);
            ok.x = pk2(bflo(kw.x) * __builtin_amdgcn_rcpf(e0), bfhi(kw.x) * __builtin_amdgcn_rcpf(e1)); ok.y = pk2(bflo(kw.y) * __builtin_amdgcn_rcpf(e2), bfhi(kw.y) * __builtin_amdgcn_rcpf(e3));
            ok.z = pk2(bflo(kw.z) * __builtin_amdgcn_rcpf(e4), bfhi(kw.z) * __builtin_amdgcn_rcpf(e5)); ok.w = pk2(bflo(kw.w) * __builtin_amdgcn_rcpf(e6), bfhi(kw.w) * __builtin_amdgcn_rcpf(e7));
            *(LAS u32x4*)(QH + t * 136 + d8) = oq; *(LAS u32x4*)(KH + t * 136 + d8) = ok; *(LAS u32x4*)(VH + t * 160 + d8) = vw; }
#pragma unroll
        for (int rep = 0; rep < 4; ++rep) { const int i8 = tid + NTHR * rep, dk = i8 >> 4, d8 = (i8 & 15) * 8; *(LAS u32x4*)(SH + dk * 160 + d8) = *(const u32x4*)(GSP + (size_t)u * 16384 + dk * 128 + d8); }
        __syncthreads();
        f32x16 o = {};
#pragma unroll
        for (int sb = 0; sb < 2; ++sb) {
            if (sb > tb) continue;
            f32x16 p = {};
#pragma unroll
            for (int k = 0; k < 8; ++k) { const bf16x8 af = *(const LAS bf16x8*)(KH + (sb * 32 + r32) * 136 + 16 * k + 8 * h2), bq = *(const LAS bf16x8*)(QH + (tb * 32 + r32) * 136 + 16 * k + 8 * h2);
                p = MFMA32(af, bq, p); }
            if (sb == tb) {
#pragma unroll
                for (int r = 0; r < 16; ++r) if (crow(r, h2) > r32) p[r] = 0.f; }
#pragma unroll
            for (int sub = 0; sub < 2; ++sub) { const int s4 = sb * 2 + sub; const bf16x8 pf = pack8(p, sub);
                o = MFMA32(tr_frag(VH, 160, 16 * s4 + 4 * h2, 16 * s4 + 8 + 4 * h2, dvb * 32, lane), pf, o); }
        }
#pragma unroll
        for (int k = 0; k < 8; ++k) { const bf16x8 af = tr_frag(SH, 160, 16 * k + 8 * h2, 16 * k + 8 * h2 + 4, dvb * 32, lane), bq = *(const LAS bf16x8*)(QH + (tb * 32 + r32) * 136 + 16 * k + 8 * h2);
            o = MFMA32(af, bq, o); }
        float ss = 0.f;
#pragma unroll
        for (int r = 0; r < 16; ++r) ss += o[r] * o[r];
        ss += __shfl_xor(ss, 32);
        if (h2 == 0) RS[dvb * 64 + tb * 32 + r32] = ss;
        __syncthreads();
        const int t = tb * 32 + r32; const float tot = (RS[t] + RS[64 + t]) + (RS[128 + t] + RS[192 + t]);
        const float rn = __builtin_amdgcn_rsqf(tot * (1.f / 128.f) + EPS);
        const size_t row = (size_t)row0 + t;
#pragma unroll
        for (int q = 0; q < 4; ++q) { const int dv = dvb * 32 + 8 * q + 4 * h2; const f32x4 g4 = *(const f32x4*)(go + dv);
            const u32x2 gw = *(const u32x2*)(Z + row * ZW + ZC_GR + h * 128 + dv); const float g0 = bflo(gw.x), g1 = bfhi(gw.x), g2 = bflo(gw.y), g3 = bfhi(gw.y);
            const float v0 = o[4 * q + 0] * rn * g4.x * g0 * sigmoidf_(g0), v1 = o[4 * q + 1] * rn * g4.y * g1 * sigmoidf_(g1), v2 = o[4 * q + 2] * rn * g4.z * g2 * sigmoidf_(g2), v3 = o[4 * q + 3] * rn * g4.w * g3 * sigmoidf_(g3);
            u32x2 w; w.x = pk2(v0, v1); w.y = pk2(v2, v3); *(u32x2*)(MIX + row * DM + 512 + h * 128 + dv) = w; }
    }
}

DI void gla_sample_phase(const Args& a, LAS unsigned char* lds, int vcu, int G, int tid, int lane, int wave) {
    LAS float* qt = (LAS float*)lds;
    LAS float* kh = qt + 512;
    LAS float* kb = kh + 512;
    LAS float* vs = kb + 512;
    LAS float* dec = vs + 512;
    LAS float* att = dec + 128;
    LAS float* red = att + 16;
    LAS float* rsum = red + 2048;
    const float* wa2_ = (const float*)a.in[I_WA2]; const float* ba_ = (const float*)a.in[I_BA]; const bf16* Z = (const bf16*)(a.ws + WS_Z); bf16* MIX = (bf16*)(a.ws + WS_MIX);
    const float* S0 = (const float*)a.in[I_SGLA]; const float* go = (const float*)a.in[I_GGLAO];
    for (int it = vcu; it < DB * GH; it += G) { const int bd = it >> 2, h = it & 3; const size_t row0 = (size_t)MP + bd * 4;
        __syncthreads();
        if (tid < 128) { float bs[4], s = 0.f;
#pragma unroll
            for (int t = 0; t < 4; ++t) { float x = ba_[h * 128 + tid];
#pragma unroll
                for (int r = 0; r < 16; ++r) x += bf2f(Z[(row0 + t) * ZW + ZC_GA + r]) * wa2_[r * 512 + h * 128 + tid];
                s += (fminf(x, 0.f) - __logf(1.f + __expf(-fabsf(x)))) * (1.f / 16.f); bs[t] = s; }
            dec[tid] = __expf(s);
#pragma unroll
            for (int t = 0; t < 4; ++t) { const bf16* zr = Z + (row0 + t) * ZW + h * 128 + tid; const float q = bf2f(zr[ZC_GQ]) * GQS, k = bf2f(zr[ZC_GK]);
                qt[t * 128 + tid] = q * __expf(bs[t]); kh[t * 128 + tid] = k * __expf(-bs[t]); kb[t * 128 + tid] = k * __expf(s - bs[t]); } }
        else if (tid < 256) { const int d = tid - 128;
#pragma unroll
            for (int t = 0; t < 4; ++t) vs[t * 128 + d] = bf2f(Z[(row0 + t) * ZW + ZC_GV + h * 128 + d]); }
        __syncthreads();
#pragma unroll
        for (int e = 0; e < 2; ++e) { const int pr = wave * 2 + e, t = pr >> 2, s = pr & 3;
            float x = qt[t * 128 + lane] * kh[s * 128 + lane] + qt[t * 128 + 64 + lane] * kh[s * 128 + 64 + lane]; x = wave_sum(x);
            if (lane == 0) att[pr] = (s <= t) ? x : 0.f; }
        { const int part = tid >> 7, dv = tid & 127; float op[4] = {0.f, 0.f, 0.f, 0.f};
            const float v0 = vs[dv], v1 = vs[128 + dv], v2 = vs[256 + dv], v3 = vs[384 + dv];
            const float* sp = S0 + ((size_t)bd * 4 + h) * 16384 + dv; float* so = a.out + O_GLAS + ((size_t)bd * 4 + h) * 16384 + dv;
#pragma unroll 4
            for (int j = 0; j < 32; ++j) { const int dk = part * 32 + j; const float s0 = sp[(size_t)dk * 128];
                op[0] += qt[dk] * s0; op[1] += qt[128 + dk] * s0; op[2] += qt[256 + dk] * s0; op[3] += qt[384 + dk] * s0;
                so[(size_t)dk * 128] = dec[dk] * s0 + ((kb[dk] * v0 + kb[128 + dk] * v1) + (kb[256 + dk] * v2 + kb[384 + dk] * v3)); }
#pragma unroll
            for (int t = 0; t < 4; ++t) red[(part * 4 + t) * 128 + dv] = op[t]; }
        __syncthreads();
        { const int t = tid >> 7, dv = tid & 127; float o = (red[(0 * 4 + t) * 128 + dv] + red[(1 * 4 + t) * 128 + dv]) + (red[(2 * 4 + t) * 128 + dv] + red[(3 * 4 + t) * 128 + dv]);
#pragma unroll
            for (int s = 0; s < 4; ++s) o += att[t * 4 + s] * vs[s * 128 + dv];
            float ss = wave_sum(o * o); if (lane == 0) rsum[wave] = ss;
            __syncthreads();
            const float tot = rsum[2 * t] + rsum[2 * t + 1]; const float rn = __builtin_amdgcn_rsqf(tot * (1.f / 128.f) + EPS);
            const float g = bf2f(Z[(row0 + t) * ZW + ZC_GR + h * 128 + dv]);
            MIX[(row0 + t) * DM + 512 + h * 128 + dv] = (bf16)f2bf(o * rn * go[dv] * g * sigmoidf_(g)); }
    }
}
namespace sk {
DI void glds16(const void* gsrc, unsigned lds_dst) { unsigned keep;
    asm volatile("s_mov_b32 %0, m0\n\ts_mov_b32 m0, %2\n\ts_nop 0\n\tglobal_load_lds_dwordx4 %1, off\n\ts_mov_b32 m0, %0" : "=&s"(keep) : "v"(gsrc), "s"(lds_dst) : "memory"); }
struct BMapLin { DI int operator()(int tn, int rr) const { return tn * 32 + rr; } };
struct BMapGlu { DI int operator()(int tn, int rr) const { const int c0 = tn * 16, r0 = (c0 >> 7) * 256 + (c0 & 127); return rr < 16 ? r0 + rr : r0 + 128 + (rr - 16); } };
constexpr int SLOT = 24576, ABYTES = 16384;
template <class Epi, class BMap>
DI void skinny_gemm(LAS unsigned char* lds, const bf16* A, int lda, const bf16* Bt, int ldb, int K, int ntn, const Epi& E, const BMap& bmap, int cu, int G, int tid, int lane, int wave) {
    const unsigned lds0 = (unsigned)(uintptr_t)lds;
    const int mi = wave & 3, ni = wave >> 2, fr = lane & 15, fq = lane >> 4;
    const int S = K / 128, ntiles = 8 * ntn;
    const int drow = lane >> 4, dpc = lane & 15;
    for (int t = cu; t < ntiles; t += G) { const int tm = t & 7, tn = t >> 3;
        const int ar0 = 8 * wave + drow, ar1 = ar0 + 4, br = 4 * wave + drow;
        const bf16* pa0 = A + (size_t)(tm * 64 + ar0) * lda + ((dpc ^ (ar0 & 15)) * 8);
        const bf16* pa1 = A + (size_t)(tm * 64 + ar1) * lda + ((dpc ^ (ar1 & 15)) * 8);
        const bf16* pb = Bt + (size_t)bmap(tn, br) * ldb + ((dpc ^ (br & 15)) * 8);
        const unsigned da0 = lds0 + (8 * wave) * 256, da1 = da0 + 1024, db = lds0 + ABYTES + (4 * wave) * 256;
#define SK_ISSUE(s_) do { const unsigned so_ = (unsigned)((s_) & 3) * SLOT; const int ko_ = (s_) * 128; \
        glds16(pa0 + ko_, (unsigned)__builtin_amdgcn_readfirstlane(da0 + so_)); glds16(pa1 + ko_, (unsigned)__builtin_amdgcn_readfirstlane(da1 + so_)); glds16(pb + ko_, (unsigned)__builtin_amdgcn_readfirstlane(db + so_)); } while (0)
        asm volatile("s_waitcnt vmcnt(0) lgkmcnt(0)\n\ts_barrier" ::: "memory");
        SK_ISSUE(0); if (S > 1) SK_ISSUE(1); if (S > 2) SK_ISSUE(2);
        f32x4 acc = {0.f, 0.f, 0.f, 0.f};
#pragma unroll 1
        for (int s = 0; s < S; ++s) {
            const int ahead = (S - 1 - s) < 2 ? (S - 1 - s) : 2;
            if (ahead == 2) asm volatile("s_waitcnt vmcnt(6)\n\ts_barrier" ::: "memory");
            else if (ahead == 1) asm volatile("s_waitcnt vmcnt(3)\n\ts_barrier" ::: "memory");
            else asm volatile("s_waitcnt vmcnt(0)\n\ts_barrier" ::: "memory");
            if (s + 3 < S) SK_ISSUE(s + 3);
            const LAS unsigned char* sa = lds + (s & 3) * SLOT + (16 * mi + fr) * 256; const LAS unsigned char* sb = lds + (s & 3) * SLOT + ABYTES + (16 * ni + fr) * 256;
#pragma unroll
            for (int ks = 0; ks < 4; ++ks) { const int pc = (4 * ks + fq) ^ fr;
                const bf16x8 af = *(const LAS bf16x8*)(sa + pc * 16), bfv = *(const LAS bf16x8*)(sb + pc * 16);
                acc = MFMA16(bfv, af, acc); }
            asm volatile("s_waitcnt lgkmcnt(0)" ::: "memory");
        }
        E(lds, tm * 64 + 16 * mi + fr, tn, ni, fq, acc, tid);
#undef SK_ISSUE
    }
}
template <class Epi>
DI void skinny_gemm4(LAS unsigned char* lds, const bf16* A, int lda, const bf16* Bt, int ldb, int K, int ntn, const Epi& E, int cu, int G, int tid, int lane, int wave) {
    const unsigned lds0 = (unsigned)(uintptr_t)lds;
    const int mi = wave & 3, ni = wave >> 2, fr = lane & 15, fq = lane >> 4;
    const int S = K / 64, ntiles = 8 * ntn;
    const int drow = lane >> 3, dpc = lane & 7;
    for (int t = cu; t < ntiles; t += G) { const int tm = t & 7, tn = t >> 3;
        const int ar = 8 * wave + drow, br0 = 16 * wave + drow, br1 = br0 + 8;
        const bf16* pa = A + (size_t)(tm * 64 + ar) * lda + ((dpc ^ (ar & 7)) * 8);
        const bf16* pb0 = Bt + (size_t)(tn * 128 + br0) * ldb + ((dpc ^ (br0 & 7)) * 8);
        const bf16* pb1 = Bt + (size_t)(tn * 128 + br1) * ldb + ((dpc ^ (br1 & 7)) * 8);
        const unsigned da = lds0 + (8 * wave) * 128, db0 = lds0 + 8192 + (16 * wave) * 128, db1 = db0 + 1024;
#define SK4_ISSUE(s_) do { const unsigned so_ = (unsigned)((s_) & 3) * SLOT; const int ko_ = (s_) * 64; \
        glds16(pa + ko_, (unsigned)__builtin_amdgcn_readfirstlane(da + so_)); glds16(pb0 + ko_, (unsigned)__builtin_amdgcn_readfirstlane(db0 + so_)); glds16(pb1 + ko_, (unsigned)__builtin_amdgcn_readfirstlane(db1 + so_)); } while (0)
        asm volatile("s_waitcnt vmcnt(0) lgkmcnt(0)\n\ts_barrier" ::: "memory");
        SK4_ISSUE(0); if (S > 1) SK4_ISSUE(1); if (S > 2) SK4_ISSUE(2);
        f32x4 acc[4] = {};
#pragma unroll 1
        for (int s = 0; s < S; ++s) {
            const int ahead = (S - 1 - s) < 2 ? (S - 1 - s) : 2;
            if (ahead == 2) asm volatile("s_waitcnt vmcnt(6)\n\ts_barrier" ::: "memory");
            else if (ahead == 1) asm volatile("s_waitcnt vmcnt(3)\n\ts_barrier" ::: "memory");
            else asm volatile("s_waitcnt vmcnt(0)\n\ts_barrier" ::: "memory");
            if (s + 3 < S) SK4_ISSUE(s + 3);
            const LAS unsigned char* sa = lds + (s & 3) * SLOT + (16 * mi + fr) * 128; const LAS unsigned char* sb = lds + (s & 3) * SLOT + 8192 + (64 * ni + fr) * 128;
#pragma unroll
            for (int ks = 0; ks < 2; ++ks) { const int pc = (4 * ks + fq) ^ (fr & 7);
                const bf16x8 af = *(const LAS bf16x8*)(sa + pc * 16);
#pragma unroll
                for (int b = 0; b < 4; ++b) { const bf16x8 bfv = *(const LAS bf16x8*)(sb + b * 2048 + pc * 16); acc[b] = MFMA16(bfv, af, acc[b]); } }
            asm volatile("s_waitcnt lgkmcnt(0)" ::: "memory");
        }
#pragma unroll
        for (int b = 0; b < 4; ++b) E.at(tm * 64 + 16 * mi + fr, tn * 128 + 64 * ni + 16 * b + 4 * fq, fq, acc[b]);
#undef SK4_ISSUE
    }
}
template <int MODE> struct SkBf16 {
    bf16* O; int ldc; const float* ss; float ssdiv;
    DI void operator()(LAS unsigned char*, int row, int tn, int ni, int fq, f32x4 v, int) const {
        const int grow = MP + row, col = tn * 32 + 16 * ni + 4 * fq; float r = 1.f; if (ss) r = __builtin_amdgcn_rsqf(ss[grow] * ssdiv + EPS);
        v = v * r;
        if (MODE == 1) {
#pragma unroll
            for (int j = 0; j < 4; ++j) { const float a = fmaxf(v[j], 0.f); v[j] = a * a; } }
        u32x2 w; w.x = pk2(v[0], v[1]); w.y = pk2(v[2], v[3]); *(u32x2*)(O + (size_t)grow * ldc + col) = w;
    }
    DI void at(int row, int col, int fq, f32x4 v) const {
        const int grow = MP + row; float r = 1.f; if (ss) r = __builtin_amdgcn_rsqf(ss[grow] * ssdiv + EPS);
        v = v * r;
        if (MODE == 1) {
#pragma unroll
            for (int j = 0; j < 4; ++j) { const float a = fmaxf(v[j], 0.f); v[j] = a * a; } }
        u32x2 w; w.x = pk2(v[0], v[1]); w.y = pk2(v[2], v[3]); *(u32x2*)(O + (size_t)grow * ldc + col) = w; (void)fq;
    }
};
struct SkZ {
    bf16* O; const float* ss; float* ssq;
    DI void operator()(LAS unsigned char*, int row, int tn, int ni, int fq, f32x4 v, int) const {
        const int grow = MP + row, col = tn * 32 + 16 * ni + 4 * fq; const float r = __builtin_amdgcn_rsqf(ss[grow] * (1.f / DM) + EPS);
        v = v * r;
        u32x2 w; w.x = pk2(v[0], v[1]); w.y = pk2(v[2], v[3]); *(u32x2*)(O + (size_t)grow * ZW + col) = w;
        const int blk = tn >> 2;
        if (blk < 5) { float s = (v[0] * v[0] + v[1] * v[1]) + (v[2] * v[2] + v[3] * v[3]); s += __shfl_xor(s, 16); s += __shfl_xor(s, 32); if (fq == 0) atomicAdd(ssq + (blk < 3 ? 0 : MT) + grow, s); }
    }
    DI void at(int row, int col, int fq, f32x4 v) const {
        const int grow = MP + row; const float r = __builtin_amdgcn_rsqf(ss[grow] * (1.f / DM) + EPS);
        v = v * r;
        u32x2 w; w.x = pk2(v[0], v[1]); w.y = pk2(v[2], v[3]); *(u32x2*)(O + (size_t)grow * ZW + col) = w;
        const int blk = col >> 7;
        if (blk < 5) { float s = (v[0] * v[0] + v[1] * v[1]) + (v[2] * v[2] + v[3] * v[3]); s += __shfl_xor(s, 16); s += __shfl_xor(s, 32); if (fq == 0) atomicAdd(ssq + (blk < 3 ? 0 : MT) + grow, s); }
    }
};
template <int MODE> struct SkRes {
    const float* basef; const bf16* baseb; float* H; bf16* XB; float* ssout; const float* ssin; const bf16* PP;
    DI void operator()(LAS unsigned char*, int row, int tn, int ni, int fq, f32x4 v, int) const {
        const int grow = MP + row, col = tn * 32 + 16 * ni + 4 * fq;
        if (MODE == 1) { const float r = __builtin_amdgcn_rsqf(ssin[grow] * (1.f / DM) + EPS); const u32x2 pw = *(const u32x2*)(PP + (size_t)grow * DM + col);
            v[0] = sigmoidf_(v[0] * r) * bflo(pw.x); v[1] = sigmoidf_(v[1] * r) * bfhi(pw.x); v[2] = sigmoidf_(v[2] * r) * bflo(pw.y); v[3] = sigmoidf_(v[3] * r) * bfhi(pw.y); }
        f32x4 h;
        if (baseb) { const u32x2 bw = *(const u32x2*)(baseb + (size_t)grow * DM + col); h = (f32x4){bflo(bw.x), bfhi(bw.x), bflo(bw.y), bfhi(bw.y)} + v; }
        else h = *(const f32x4*)(basef + (size_t)row * DM + col) + v;
        if (H) *(f32x4*)(H + (size_t)grow * DM + col) = h;
        if (XB) { u32x2 w; w.x = pk2(h[0], h[1]); w.y = pk2(h[2], h[3]); *(u32x2*)(XB + (size_t)grow * DM + col) = w; }
        if (ssout) { float s = (h[0] * h[0] + h[1] * h[1]) + (h[2] * h[2] + h[3] * h[3]); s += __shfl_xor(s, 16); s += __shfl_xor(s, 32); if (fq == 0) atomicAdd(ssout + grow, s); }
    }
};
struct SkGlu {
    const bf16* baseb; bf16* XB; float* ssout;
    DI void operator()(LAS unsigned char* lds, int row, int tn, int ni, int fq, f32x4 v, int tid) const {
        LAS f32x4* X = (LAS f32x4*)(lds + 4 * SLOT);
        const int lr = row & 63;
        if (ni == 1) X[lr * 4 + fq] = v;
        asm volatile("s_waitcnt lgkmcnt(0)\n\ts_barrier" ::: "memory");
        if (ni == 0) { const f32x4 gt = X[lr * 4 + fq]; const int grow = MP + row, col = tn * 16 + 4 * fq;
            const u32x2 bw = *(const u32x2*)(baseb + (size_t)grow * DM + col); f32x4 h = {bflo(bw.x), bfhi(bw.x), bflo(bw.y), bfhi(bw.y)};
#pragma unroll
            for (int j = 0; j < 4; ++j) h[j] += v[j] * sigmoidf_(gt[j]);
            u32x2 w; w.x = pk2(h[0], h[1]); w.y = pk2(h[2], h[3]); *(u32x2*)(XB + (size_t)grow * DM + col) = w;
            float s = (h[0] * h[0] + h[1] * h[1]) + (h[2] * h[2] + h[3] * h[3]); s += __shfl_xor(s, 16); s += __shfl_xor(s, 32); if (fq == 0) atomicAdd(ssout + grow, s); }
    }
};
}
DI float score_bound(const Args& a, int lane) {
    const float* gq = (const float*)a.in[I_GQH]; const float* gk = (const float*)a.in[I_GKH];
    float mq = fmaxf(fabsf(gq[lane]), (lane < 32) ? fabsf(gq[64 + lane]) : 0.f), mk = fmaxf(fabsf(gk[lane]), (lane < 32) ? fabsf(gk[64 + lane]) : 0.f);
#pragma unroll
    for (int o = 1; o < 64; o <<= 1) { mq = fmaxf(mq, __shfl_xor(mq, o)); mk = fmaxf(mk, __shfl_xor(mk, o)); }
    return 96.f * QSCALE * mq * mk;
}
DI void attn_prompt_unit(const Args& a, LAS unsigned char* lds, int b, int h, int qb, float cB, int tid, int lane, int wave) {
    const bf16* KF = (const bf16*)(a.ws + WS_KF); const bf16* KVR = (const bf16*)(a.ws + WS_KVRAW); bf16* MIX = (bf16*)(a.ws + WS_MIX);
    LAS bf16* Ks = (LAS bf16*)lds;
    LAS bf16* Vs = (LAS bf16*)(lds + 26624);
    const int r32 = lane & 31, h2 = lane >> 5;
    const int qloc = qb * 256 + wave * 32 + r32;
    const size_t qrow = (size_t)b * SEQ + qloc;
    bf16x8 qf[6];
    { const bf16* QR = (const bf16*)(a.ws + WS_QRAW); const float* gq = (const float*)a.in[I_GQH]; const float* rc = (const float*)(a.ws + WS_ROPE); const float* rs = rc + 8200 * 16;
        u32x4 wq[6]; float ss = 0.f;
#pragma unroll
        for (int s = 0; s < 6; ++s) { wq[s] = *(const u32x4*)(QR + qrow * 768 + h * 96 + 16 * s + 8 * h2);
            const float e0 = bflo(wq[s].x), e1 = bfhi(wq[s].x), e2 = bflo(wq[s].y), e3 = bfhi(wq[s].y), e4 = bflo(wq[s].z), e5 = bfhi(wq[s].z), e6 = bflo(wq[s].w), e7 = bfhi(wq[s].w);
            ss += ((e0 * e0 + e1 * e1) + (e2 * e2 + e3 * e3)) + ((e4 * e4 + e5 * e5) + (e6 * e6 + e7 * e7)); }
        ss += __shfl_xor(ss, 32);
        const float r = __builtin_amdgcn_rsqf(ss * (1.f / 96.f) + EPS) * QSCALE;
#pragma unroll
        for (int s = 0; s < 4; ++s) { const f32x4 g0 = *(const f32x4*)(gq + 16 * s + 8 * h2) * r, g1 = *(const f32x4*)(gq + 16 * s + 8 * h2 + 4) * r;
            u32x4 o; o.x = pk2(bflo(wq[s].x) * g0.x, bfhi(wq[s].x) * g0.y); o.y = pk2(bflo(wq[s].y) * g0.z, bfhi(wq[s].y) * g0.w); o.z = pk2(bflo(wq[s].z) * g1.x, bfhi(wq[s].z) * g1.y); o.w = pk2(bflo(wq[s].w) * g1.z, bfhi(wq[s].w) * g1.w);
            qf[s] = __builtin_bit_cast(bf16x8, o); }
        { const f32x4 ga0 = *(const f32x4*)(gq + 64 + 8 * h2) * r, ga1 = *(const f32x4*)(gq + 64 + 8 * h2 + 4) * r, gb0 = *(const f32x4*)(gq + 80 + 8 * h2) * r, gb1 = *(const f32x4*)(gq + 80 + 8 * h2 + 4) * r;
            const f32x4 c0 = *(const f32x4*)(rc + qloc * 16 + 8 * h2), c1 = *(const f32x4*)(rc + qloc * 16 + 8 * h2 + 4), s0 = *(const f32x4*)(rs + qloc * 16 + 8 * h2), s1 = *(const f32x4*)(rs + qloc * 16 + 8 * h2 + 4);
            const f32x4 xa0 = (f32x4){bflo(wq[4].x), bfhi(wq[4].x), bflo(wq[4].y), bfhi(wq[4].y)} * ga0, xa1 = (f32x4){bflo(wq[4].z), bfhi(wq[4].z), bflo(wq[4].w), bfhi(wq[4].w)} * ga1;
            const f32x4 xb0 = (f32x4){bflo(wq[5].x), bfhi(wq[5].x), bflo(wq[5].y), bfhi(wq[5].y)} * gb0, xb1 = (f32x4){bflo(wq[5].z), bfhi(wq[5].z), bflo(wq[5].w), bfhi(wq[5].w)} * gb1;
            const f32x4 ra0 = xa0 * c0 - xb0 * s0, ra1 = xa1 * c1 - xb1 * s1, rb0 = xb0 * c0 + xa0 * s0, rb1 = xb1 * c1 + xa1 * s1;
            u32x4 o4, o5; o4.x = pk2(ra0.x, ra0.y); o4.y = pk2(ra0.z, ra0.w); o4.z = pk2(ra1.x, ra1.y); o4.w = pk2(ra1.z, ra1.w); o5.x = pk2(rb0.x, rb0.y); o5.y = pk2(rb0.z, rb0.w); o5.z = pk2(rb1.x, rb1.y); o5.w = pk2(rb1.z, rb1.w);
            qf[4] = __builtin_bit_cast(bf16x8, o4); qf[5] = __builtin_bit_cast(bf16x8, o5); } }
    const int NT = 4 * (qb + 1);
    const int kr0 = tid / 12, kp0 = tid % 12, kr1 = (tid + 512) / 12, kp1 = (tid + 512) % 12; const bool k1 = tid < 256;
    const bf16* kbase = KF + ((size_t)b * SEQ) * 768 + h * 96;
    const bf16* vbase = KVR + ((size_t)b * SEQ + (tid >> 3)) * 1024 + h * 128 + 64 + (tid & 7) * 8;
    u32x4 kst0, kst1 = {0u, 0u, 0u, 0u}, vst;
    kst0 = *(const u32x4*)(kbase + (size_t)kr0 * 768 + kp0 * 8); if (k1) kst1 = *(const u32x4*)(kbase + (size_t)kr1 * 768 + kp1 * 8); vst = *(const u32x4*)(vbase);
    __syncthreads();
    *(LAS u32x4*)(Ks + kr0 * 104 + kp0 * 8) = kst0; if (k1) *(LAS u32x4*)(Ks + kr1 * 104 + kp1 * 8) = kst1;
    *(LAS u32x4*)(Vs + (tid >> 3) * 96 + (tid & 7) * 8) = vst;
    __syncthreads();
    f32x16 o0 = {}, o1 = {}; float lsum = 0.f;
    const int qmax_w = qb * 256 + wave * 32 + 31;
    for (int t = 0; t < NT; ++t) {
        const int buf = t & 1;
        if (t + 1 < NT) { const size_t kv1 = (size_t)(t + 1) * 64;
            kst0 = *(const u32x4*)(kbase + (kv1 + kr0) * 768 + kp0 * 8); if (k1) kst1 = *(const u32x4*)(kbase + (kv1 + kr1) * 768 + kp1 * 8); vst = *(const u32x4*)(vbase + kv1 * 1024); }
        if (t * 64 <= qmax_w) {
            const LAS bf16* Kb = Ks + buf * 6656; const LAS bf16* Vb = Vs + buf * 6144;
            f32x16 p0, p1;
#pragma unroll
            for (int r = 0; r < 16; ++r) { p0[r] = -cB; p1[r] = -cB; }
#pragma unroll
            for (int s = 0; s < 6; ++s) { const bf16x8 k0 = *(const LAS bf16x8*)(Kb + r32 * 104 + 16 * s + 8 * h2), k1f = *(const LAS bf16x8*)(Kb + (32 + r32) * 104 + 16 * s + 8 * h2);
                p0 = MFMA32(k0, qf[s], p0); p1 = MFMA32(k1f, qf[s], p1); }
            const bool diag = (t * 64 + 63 > qb * 256 + wave * 32);
#pragma unroll
            for (int r = 0; r < 16; ++r) { const int kv = t * 64 + crow(r, h2);
                float e0 = __builtin_amdgcn_exp2f(p0[r]), e1 = __builtin_amdgcn_exp2f(p1[r]);
                if (diag) { if (kv > qloc) e0 = 0.f; if (kv + 32 > qloc) e1 = 0.f; }
                p0[r] = e0; p1[r] = e1; lsum += e0 + e1; }
#pragma unroll
            for (int s4 = 0; s4 < 4; ++s4) { const bf16x8 pf = (s4 < 2) ? pack8(p0, s4 & 1) : pack8(p1, s4 & 1);
                o0 = MFMA32(tr_frag(Vb, 96, 16 * s4 + 4 * h2, 16 * s4 + 8 + 4 * h2, 0, lane), pf, o0); o1 = MFMA32(tr_frag(Vb, 96, 16 * s4 + 4 * h2, 16 * s4 + 8 + 4 * h2, 32, lane), pf, o1); }
        }
        if (t + 1 < NT) { LAS bf16* Kn = Ks + (buf ^ 1) * 6656; LAS bf16* Vn = Vs + (buf ^ 1) * 6144;
            *(LAS u32x4*)(Kn + kr0 * 104 + kp0 * 8) = kst0; if (k1) *(LAS u32x4*)(Kn + kr1 * 104 + kp1 * 8) = kst1;
            *(LAS u32x4*)(Vn + (tid >> 3) * 96 + (tid & 7) * 8) = vst; }
        __syncthreads();
    }
    lsum += __shfl_xor(lsum, 32);
    const float inv = 1.f / lsum;
    bf16* op = MIX + qrow * DM + h * 64;
#pragma unroll
    for (int q = 0; q < 4; ++q) { const int dv = 8 * q + 4 * h2;
        u32x2 w0, w1; w0.x = pk2(o0[4 * q] * inv, o0[4 * q + 1] * inv); w0.y = pk2(o0[4 * q + 2] * inv, o0[4 * q + 3] * inv);
        w1.x = pk2(o1[4 * q] * inv, o1[4 * q + 1] * inv); w1.y = pk2(o1[4 * q + 2] * inv, o1[4 * q + 3] * inv);
        *(u32x2*)(op + dv) = w0; *(u32x2*)(op + 32 + dv) = w1; }
}
DI void attn_prompt_phase(const Args& a, LAS unsigned char* lds, int vcu, int G, int tid, int lane, int wave) {
    const float cB = score_bound(a, lane);
    for (int pi = vcu; pi < 256; pi += G) { const int bh = pi >> 2, s = pi & 3;
        attn_prompt_unit(a, lds, bh >> 3, bh & 7, 7 - s, cB, tid, lane, wave);
        attn_prompt_unit(a, lds, bh >> 3, bh & 7, s, cB, tid, lane, wave); }
}
constexpr int CSW = 296;
DI void p4b_sample_q(const Args& a, LAS unsigned char* lds, int vcu, int G, int tid, int lane, int wave) {
    LAS float* qs = (LAS float*)lds;
    const bf16* QF = (const bf16*)(a.ws + WS_QF); bf16* QS = (bf16*)(a.ws + WS_QS);
    const float* W = (const float*)a.in[I_WUKV]; const float* gk = (const float*)a.in[I_GKH];
    for (int it = vcu; it < 256; it += G) { const int h = it >> 5, rg = it & 31;
        __syncthreads();
        for (int i = tid; i < 16 * 96; i += NTHR) { const int r = i / 96, d = i % 96; qs[i] = bf2f(QF[((size_t)MP + rg * 16 + r) * 768 + h * 96 + d]); }
        __syncthreads();
        if (tid < 256) { float w[64];
#pragma unroll
            for (int d4 = 0; d4 < 16; ++d4) { const f32x4 v = *(const f32x4*)(W + (size_t)tid * 1024 + h * 128 + d4 * 4), g = *(const f32x4*)(gk + d4 * 4); w[4 * d4] = v.x * g.x; w[4 * d4 + 1] = v.y * g.y; w[4 * d4 + 2] = v.z * g.z; w[4 * d4 + 3] = v.w * g.w; }
#pragma unroll 1
            for (int r = 0; r < 16; ++r) { float s = 0.f;
#pragma unroll
                for (int d4 = 0; d4 < 16; ++d4) { const f32x4 qv = *(const LAS f32x4*)(qs + r * 96 + 4 * d4); s += (w[4 * d4] * qv.x + w[4 * d4 + 1] * qv.y) + (w[4 * d4 + 2] * qv.z + w[4 * d4 + 3] * qv.w); }
                const int srow = rg * 16 + r, bd = srow >> 2, t = srow & 3;
                QS[((size_t)bd * 32 + h * 4 + t) * CSW + tid] = (bf16)f2bf(s); } }
        else { for (int i = tid - 256; i < 16 * 40; i += 256) { const int r = i / 40, d = i % 40; const int srow = rg * 16 + r, bd = srow >> 2, t = srow & 3;
                QS[((size_t)bd * 32 + h * 4 + t) * CSW + 256 + d] = (d < 32) ? (bf16)f2bf(qs[r * 96 + 64 + d]) : (bf16)0; } }
    }
}

DI void glds16(const void* gsrc, unsigned lds_dst) { unsigned keep;
    asm volatile("s_mov_b32 %0, m0\n\ts_mov_b32 m0, %2\n\ts_nop 0\n\tglobal_load_lds_dwordx4 %1, off\n\ts_mov_b32 m0, %0" : "=&s"(keep) : "v"(gsrc), "s"(lds_dst) : "memory"); }
#define BAR_LDS() asm volatile("s_waitcnt lgkmcnt(0)\n\ts_barrier" ::: "memory")
#define BAR_ALL() asm volatile("s_waitcnt vmcnt(0) lgkmcnt(0)\n\ts_barrier" ::: "memory")
DI void attn_sample_phase(const Args& a, LAS unsigned char* lds, int vcu, int G, int tid, int lane, int wave) {
    LAS bf16* Cs = (LAS bf16*)lds;
    LAS unsigned char* C8 = lds + 56832;
    LAS bf16* Qs = (LAS bf16*)(lds + 74240);
    LAS bf16* PT = (LAS bf16*)(lds + 93184);
    LAS float* RI = (LAS float*)(lds + 95744);
    LAS float* SSPE = (LAS float*)(lds + 96768);
    LAS float* LRED = (LAS float*)(lds + 97024);
    LAS int* PG = (LAS int*)(lds + 97152);
    const float cB = score_bound(a, lane);
    const bf16* Wt = (const bf16*)(a.ws + WS_WUKV);
    const bf16* QS = (const bf16*)(a.ws + WS_QS);
    const float* cckv = (const float*)a.in[I_CCKV]; const float* ckpe = (const float*)a.in[I_CKPE]; const int* ptab = (const int*)a.in[I_PT];
    const float* rc = (const float*)(a.ws + WS_ROPE); const float* rs = rc + 8200 * 16; const float* gk = (const float*)a.in[I_GKH];
    float* SPART = (float*)(a.ws + WS_SPART); float* SL = (float*)(a.ws + WS_SL);
    const int r16 = lane & 15, q4 = lane >> 4, r32 = lane & 31, h2 = lane >> 5;
    typedef int v8i_t __attribute__((ext_vector_type(8)));
    v8i_t wf8[4][2];
#pragma unroll
    for (int nb = 0; nb < 4; ++nb)
#pragma unroll
        for (int ks = 0; ks < 2; ++ks) { const bf16* wp = Wt + (size_t)(wave * 128 + nb * 16 + r16) * 256 + 128 * ks + 32 * q4;
#pragma unroll
            for (int i = 0; i < 4; ++i) { const u32x4 w = *(const u32x4*)(wp + 8 * i); int lo = 0, hi = 0;
                lo = __builtin_amdgcn_cvt_pk_fp8_f32(bflo(w.x) * 16.f, bfhi(w.x) * 16.f, lo, false); lo = __builtin_amdgcn_cvt_pk_fp8_f32(bflo(w.y) * 16.f, bfhi(w.y) * 16.f, lo, true);
                hi = __builtin_amdgcn_cvt_pk_fp8_f32(bflo(w.z) * 16.f, bfhi(w.z) * 16.f, hi, false); hi = __builtin_amdgcn_cvt_pk_fp8_f32(bflo(w.w) * 16.f, bfhi(w.w) * 16.f, hi, true);
                wf8[nb][ks][2 * i] = lo; wf8[nb][ks][2 * i + 1] = hi; } }
    const bool kthr = tid >= 256; const int krow = (tid >> 3) & 31, kp = tid & 7;
    const f32x2 gpa = *(const f32x2*)(gk + 64 + 2 * kp), gpb = *(const f32x2*)(gk + 80 + 2 * kp);
    const f32x2 cd = *(const f32x2*)(rc + 32 * 16 + 2 * kp), sd = *(const f32x2*)(rs + 32 * 16 + 2 * kp);
    const int lrow = tid >> 6, lpc = tid & 63;
    f32x4 a0, a1, a2, a3; f32x2 aka = {0.f, 0.f}, akb = {0.f, 0.f};
#define SA_LOAD(jj, v0, v1, v2, v3, ka, kb) do { const int phys_ = __builtin_amdgcn_readfirstlane(PG[(jj) >> 2]); const size_t key0_ = (size_t)phys_ * PAGE + ((jj) & 3) * 32; \
        const float* src_ = cckv + (key0_ + lrow) * KVL + lpc * 4; v0 = *(const f32x4*)src_; v1 = *(const f32x4*)(src_ + 8 * KVL); v2 = *(const f32x4*)(src_ + 16 * KVL); v3 = *(const f32x4*)(src_ + 24 * KVL); \
        if (kthr) { const float* ks_ = ckpe + (key0_ + krow) * ROPE + 2 * kp; ka = *(const f32x2*)ks_; kb = *(const f32x2*)(ks_ + 16); } } while (0)
#define SA_CONV1(v, i_, cb, c8b) do { const int row_ = lrow + 8 * (i_); u32x2 w_; w_.x = pk2(v.x, v.y); w_.y = pk2(v.z, v.w); *(LAS u32x2*)(cb + row_ * CSW + lpc * 4) = w_; \
        int f8_ = 0; f8_ = __builtin_amdgcn_cvt_pk_fp8_f32(v.x, v.y, f8_, false); f8_ = __builtin_amdgcn_cvt_pk_fp8_f32(v.z, v.w, f8_, true); *(LAS int*)(c8b + row_ * 272 + lpc * 4) = f8_; } while (0)
#define SA_CONVERT(jj, cb3, v0, v1, v2, v3, ka, kb) do { LAS bf16* cb_ = Cs + (cb3) * (32 * CSW); LAS unsigned char* c8_ = C8 + ((jj) & 1) * 8704; \
        SA_CONV1(v0, 0, cb_, c8_); SA_CONV1(v1, 1, cb_, c8_); SA_CONV1(v2, 2, cb_, c8_); SA_CONV1(v3, 3, cb_, c8_); \
        if (kthr) { const float ss_ = row8_sum((ka.x * ka.x + ka.y * ka.y) + (kb.x * kb.x + kb.y * kb.y)); if (kp == 0) SSPE[((jj) & 1) * 32 + krow] = ss_; \
            const f32x2 ya_ = ka * gpa, yb_ = kb * gpb; const f32x2 r1_ = ya_ * rcur - yb_ * rsur, r2_ = yb_ * rcur + ya_ * rsur; \
            *(LAS unsigned*)(cb_ + krow * CSW + 256 + 2 * kp) = pk2(r1_.x, r1_.y); *(LAS unsigned*)(cb_ + krow * CSW + 272 + 2 * kp) = pk2(r2_.x, r2_.y); \
            const f32x2 nc_ = rcur * cd - rsur * sd, ns_ = rsur * cd + rcur * sd; rcur = nc_; rsur = ns_; } } while (0)
#define SA_PV(cb3) do { const LAS bf16* cb_ = Cs + (cb3) * (32 * CSW); const int q_ = (lane & 15) >> 2, p_ = lane & 3, blk_ = (lane >> 4) & 1; \
        _Pragma("unroll") for (int s4 = 0; s4 < 2; ++s4) { const LAS bf16* ap = cb_ + (16 * s4 + 8 * h2 + q_) * CSW + 32 * wave + 16 * blk_ + 4 * p_; \
            const s16x4 lo = __builtin_bit_cast(s16x4, __builtin_amdgcn_ds_read_tr16_b64_v4i16((LAS v4i16_t*)ap)), hi = __builtin_bit_cast(s16x4, __builtin_amdgcn_ds_read_tr16_b64_v4i16((LAS v4i16_t*)(ap + 4 * CSW))); \
            const bf16x8 af = __builtin_shufflevector(lo, hi, 0, 1, 2, 3, 4, 5, 6, 7); const bf16x8 bp = *(const LAS bf16x8*)(PT + r32 * 40 + 16 * s4 + 8 * h2); \
            accT = MFMA32(af, bp, accT); } } while (0)
    for (int it = vcu; it < 2 * DB; it += G) { const int bd = it >> 1, split = it & 1;
        __syncthreads();
        if (tid < 32) { PG[tid] = ptab[bd * NPAGES + split * 32 + tid]; LRED[tid] = 0.f; }
        bf16x8 qfr[9];
#pragma unroll
        for (int s9 = 0; s9 < 9; ++s9) qfr[s9] = *(const bf16x8*)(QS + ((size_t)bd * 32 + (wave & 1) * 16 + r16) * CSW + 32 * s9 + 8 * q4);
        f32x2 rcur = *(const f32x2*)(rc + (split * 4096 + krow) * 16 + 2 * kp), rsur = *(const f32x2*)(rs + (split * 4096 + krow) * 16 + 2 * kp);
        __syncthreads();
        SA_LOAD(0, a0, a1, a2, a3, aka, akb);
        SA_CONVERT(0, 0, a0, a1, a2, a3, aka, akb);
        SA_LOAD(1, a0, a1, a2, a3, aka, akb);
        __syncthreads();
        f32x16 accT = {}; float lsum = 0.f; int c3 = 0;
#pragma unroll 1
        for (int j = 0; j < 128; ++j) {
            const int c3n = (c3 == 2) ? 0 : c3 + 1, c3p = (c3 == 0) ? 2 : c3 - 1;
            if (j > 0) SA_PV(c3p);
            { const LAS unsigned char* c8b = C8 + (j & 1) * 8704; const LAS float* spe = SSPE + (j & 1) * 32;
#pragma unroll
                for (int kb = 0; kb < 2; ++kb) { f32x4 acc[4] = {};
#pragma unroll
                    for (int ks = 0; ks < 2; ++ks) { const LAS unsigned char* ap = c8b + (kb * 16 + r16) * 272 + 128 * ks + 32 * q4;
                        const u32x4 x0 = *(const LAS u32x4*)ap, x1 = *(const LAS u32x4*)(ap + 16);
                        const v8i_t af = {(int)x0.x, (int)x0.y, (int)x0.z, (int)x0.w, (int)x1.x, (int)x1.y, (int)x1.z, (int)x1.w};
#pragma unroll
                        for (int nb = 0; nb < 4; ++nb) acc[nb] = __builtin_amdgcn_mfma_scale_f32_16x16x128_f8f6f4(af, wf8[nb][ks], acc[nb], 0, 0, 0, 0x7F7F7F7F, 0, 0x7F7F7F7F); }
                    f32x4 sq = (acc[0] * acc[0] + acc[1] * acc[1] + acc[2] * acc[2] + acc[3] * acc[3]) * (1.f / 256.f);
                    sq.x = row16_sum(sq.x); sq.y = row16_sum(sq.y); sq.z = row16_sum(sq.z); sq.w = row16_sum(sq.w);
                    if (r16 == 0) { const f32x4 pe = *(const LAS f32x4*)(spe + kb * 16 + 4 * q4); f32x4 r;
                        r.x = __builtin_amdgcn_rsqf((sq.x + pe.x) * (1.f / 96.f) + EPS); r.y = __builtin_amdgcn_rsqf((sq.y + pe.y) * (1.f / 96.f) + EPS);
                        r.z = __builtin_amdgcn_rsqf((sq.z + pe.z) * (1.f / 96.f) + EPS); r.w = __builtin_amdgcn_rsqf((sq.w + pe.w) * (1.f / 96.f) + EPS);
                        *(LAS f32x4*)(RI + wave * 32 + kb * 16 + 4 * q4) = r; } } }
            f32x4 sa = {0.f, 0.f, 0.f, 0.f};
            if (wave < 4) { const int kb = wave >> 1, nb2 = wave & 1; const LAS bf16* cb = Cs + c3 * (32 * CSW);
#pragma unroll
                for (int s9 = 0; s9 < 9; ++s9) { const bf16x8 af = *(const LAS bf16x8*)(cb + (kb * 16 + r16) * CSW + 32 * s9 + 8 * q4);
                    sa = MFMA16(af, qfr[s9], sa); } (void)nb2; }
            if (j + 1 < 128) { SA_CONVERT(j + 1, c3n, a0, a1, a2, a3, aka, akb); if (j + 2 < 128) SA_LOAD(j + 2, a0, a1, a2, a3, aka, akb); }
            __syncthreads();
            if (wave < 4) { const int kb = wave >> 1, nb2 = wave & 1; const int row = nb2 * 16 + r16, hrow = row >> 2; const f32x4 ri = *(const LAS f32x4*)(RI + hrow * 32 + kb * 16 + 4 * q4);
                const float p0 = __builtin_amdgcn_exp2f(sa.x * ri.x - cB), p1 = __builtin_amdgcn_exp2f(sa.y * ri.y - cB), p2 = __builtin_amdgcn_exp2f(sa.z * ri.z - cB), p3 = __builtin_amdgcn_exp2f(sa.w * ri.w - cB);
                lsum += (p0 + p1) + (p2 + p3);
                u32x2 w; w.x = pk2(p0, p1); w.y = pk2(p2, p3); *(LAS u32x2*)(PT + row * 40 + kb * 16 + 4 * q4) = w; }
            __syncthreads();
            c3 = c3n;
        }
        SA_PV(((c3 == 0) ? 2 : c3 - 1));
        lsum += __shfl_xor(lsum, 16); lsum += __shfl_xor(lsum, 32);
        if (wave < 4 && q4 == 0) (void)__hip_atomic_fetch_add(LRED + (wave & 1) * 16 + r16, lsum, __ATOMIC_RELAXED, __HIP_MEMORY_SCOPE_WORKGROUP);
        __syncthreads();
        if (tid < 32) SL[(size_t)it * 32 + tid] = LRED[tid];
        float* sp = SPART + ((size_t)it * 32 + r32) * 256 + 32 * wave;
#pragma unroll
        for (int r = 0; r < 16; ++r) sp[crow(r, h2)] = accT[r];
    }
#undef SA_LOAD
#undef SA_CONV1
#undef SA_CONVERT
#undef SA_PV
}

DI void attn_sample_final(const Args& a, LAS unsigned char* lds, int vcu, int G, int tid, int lane, int wave) {
    LAS float* lat = (LAS float*)lds;
    LAS float* cn = lat + 1024;
    LAS float* kper = cn + 1024;
    LAS float* rinv = kper + 128;
    LAS float* pw = rinv + 4;
    LAS float* lt = pw + 16;
    LAS float* red = lt + 4;
    const float cB = score_bound(a, lane);
    const bf16* CKVB = (const bf16*)(a.ws + WS_CKVB); const bf16* Z = (const bf16*)(a.ws + WS_Z); const bf16* KV = (const bf16*)(a.ws + WS_KVRAW); const bf16* QS = (const bf16*)(a.ws + WS_QS);
    const float* SPART = (const float*)(a.ws + WS_SPART); const float* SL = (const float*)(a.ws + WS_SL); bf16* MIX = (bf16*)(a.ws + WS_MIX);
    const float* rc = (const float*)(a.ws + WS_ROPE); const float* rs = rc + 8200 * 16; const float* gk = (const float*)a.in[I_GKH]; const float* W = (const float*)a.in[I_WUKV];
    for (int it = vcu; it < DB * NH; it += G) { const int bd = it >> 3, h = it & 7; const size_t row0 = (size_t)MP + bd * 4;
        __syncthreads();
        for (int i = tid; i < 1024; i += NTHR) { const int t = i >> 8, c = i & 255; cn[i] = bf2f(CKVB[(row0 + t) * KVL + c]);
            lat[i] = SPART[(((size_t)bd * 2 + 0) * 32 + h * 4 + t) * 256 + c] + SPART[(((size_t)bd * 2 + 1) * 32 + h * 4 + t) * 256 + c]; }
        if (tid < 128) { const int t = tid >> 5, d = tid & 31; const float x = bf2f(Z[(row0 + t) * ZW + ZC_KPE + d]); const float y = x * gk[64 + d], yo = __shfl_xor(y, 16);
            const int pos = PAST + t; const float c = rc[pos * 16 + (d & 15)], s = rs[pos * 16 + (d & 15)];
            kper[tid] = (d < 16) ? (y * c - yo * s) : (y * c + yo * s);
            float ss = x * x;
            const float k0 = bf2f(KV[(row0 + t) * 1024 + h * 128 + d]), k1 = bf2f(KV[(row0 + t) * 1024 + h * 128 + 32 + d]); ss += k0 * k0 + k1 * k1;
#pragma unroll
            for (int o = 1; o < 32; o <<= 1) ss += __shfl_xor(ss, o);
            if (d == 0) rinv[t] = __builtin_amdgcn_rsqf(ss * (1.f / 96.f) + EPS); }
        __syncthreads();
#pragma unroll
        for (int e = 0; e < 2; ++e) { const int pr = wave * 2 + e, t = pr >> 2, tp = pr & 3; const bf16* q = QS + ((size_t)bd * 32 + h * 4 + t) * CSW;
            float s = 0.f;
#pragma unroll
            for (int j = 0; j < 4; ++j) s += bf2f(q[j * 64 + lane]) * cn[tp * 256 + j * 64 + lane];
            if (lane < 32) s += bf2f(q[256 + lane]) * kper[tp * 32 + lane];
            s = wave_sum(s);
            if (lane == 0) pw[pr] = (tp <= t) ? __builtin_amdgcn_exp2f(s * rinv[tp] - cB) : 0.f; }
        __syncthreads();
        for (int i = tid; i < 1024; i += NTHR) { const int t = i >> 8, c = i & 255; lat[i] += (pw[t * 4] * cn[c] + pw[t * 4 + 1] * cn[256 + c]) + (pw[t * 4 + 2] * cn[512 + c] + pw[t * 4 + 3] * cn[768 + c]); }
        if (tid < 4) lt[tid] = SL[((size_t)bd * 2 + 0) * 32 + h * 4 + tid] + SL[((size_t)bd * 2 + 1) * 32 + h * 4 + tid] + (pw[tid * 4] + pw[tid * 4 + 1]) + (pw[tid * 4 + 2] + pw[tid * 4 + 3]);
        __syncthreads();
        { const int half = tid >> 8, t = (tid >> 6) & 3, dv = tid & 63; float s = 0.f; const float* wp = W + (size_t)(half * 128) * 1024 + h * 128 + 64 + dv;
#pragma unroll 8
            for (int c = 0; c < 128; ++c) s += lat[t * 256 + half * 128 + c] * wp[(size_t)c * 1024];
            red[(half * 4 + t) * 64 + dv] = s; }
        __syncthreads();
        if (tid < 256) { const int t = tid >> 6, dv = tid & 63; const float o = (red[t * 64 + dv] + red[(4 + t) * 64 + dv]) / lt[t];
            MIX[(row0 + t) * DM + h * 64 + dv] = (bf16)f2bf(o); }
    }
}
DI float gelu_tanh(float x) { const float u = 1.5957691216057308f * (x + 0.044715f * x * x * x); return x * sigmoidf_(u); }
DI void s5_norm_phase(const Args& a, int vcu, int G, int lane, int wave) {
    const bf16* XB = (const bf16*)(a.ws + WS_XB1); const float* SS3 = (const float*)(a.ws + WS_CTL) + CW_SS + 3 * MT; bf16* U2 = (bf16*)(a.ws + WS_U2);
    const float* gn = (const float*)a.in[I_GNC];
    const int gw = vcu * NWAVES + wave, NGW = G * NWAVES;
    { f32x4 g0 = *(const f32x4*)(gn + lane * 16), g1 = *(const f32x4*)(gn + lane * 16 + 4), g2 = *(const f32x4*)(gn + lane * 16 + 8), g3 = *(const f32x4*)(gn + lane * 16 + 12);
        for (int m = gw; m < MP; m += NGW) { const float r = __builtin_amdgcn_rsqf(SS3[m] * (1.f / DM) + EPS);
            const u32x4 w0 = *(const u32x4*)(XB + (size_t)m * DM + lane * 16), w1 = *(const u32x4*)(XB + (size_t)m * DM + lane * 16 + 8);
            u32x4 o0, o1;
            o0.x = pk2(bflo(w0.x) * r * g0.x, bfhi(w0.x) * r * g0.y); o0.y = pk2(bflo(w0.y) * r * g0.z, bfhi(w0.y) * r * g0.w); o0.z = pk2(bflo(w0.z) * r * g1.x, bfhi(w0.z) * r * g1.y); o0.w = pk2(bflo(w0.w) * r * g1.z, bfhi(w0.w) * r * g1.w);
            o1.x = pk2(bflo(w1.x) * r * g2.x, bfhi(w1.x) * r * g2.y); o1.y = pk2(bflo(w1.y) * r * g2.z, bfhi(w1.y) * r * g2.w); o1.z = pk2(bflo(w1.z) * r * g3.x, bfhi(w1.z) * r * g3.y); o1.w = pk2(bflo(w1.w) * r * g3.z, bfhi(w1.w) * r * g3.w);
            bf16* dst = U2 + ((size_t)(m >> 4) * S5G + lane) * S5K + (m & 15) * 16;
            *(u32x4*)dst = o0; *(u32x4*)(dst + 8) = o1; } }
}
DI void s5_sample_phase(const Args& a, LAS unsigned char* lds, int gw, int NGW, int it_lo, int it_hi, int lane, int wave) {
    const bf16* XB = (const bf16*)(a.ws + WS_XB1); const float* SS3 = (const float*)(a.ws + WS_CTL) + CW_SS + 3 * MT; bf16* GG = (bf16*)(a.ws + WS_GG);
    const float* gn = (const float*)a.in[I_GNC];
    LAS float* us = (LAS float*)lds + wave * 2688;
    LAS float* xr = us + 64;
    LAS float* xi = xr + 256;
    LAS float* cs = xi + 256;
    const float* tab = (const float*)(a.ws + WS_S5TAB);
    const float* x0r = (const float*)a.in[I_S5RE]; const float* x0i = (const float*)a.in[I_S5IM]; const float* dd = (const float*)a.in[I_S5D];
    float lr = 0.f, li = 0.f; f32x4 bbv[8]; int gcur = -1;
#pragma unroll
    for (int q = 0; q < 8; ++q) bbv[q] = (f32x4){0.f, 0.f, 0.f, 0.f};
    for (int it = it_lo + gw; it < it_hi; it += NGW) { const int g = it & 63, bd = it >> 6; const size_t row0 = (size_t)MP + bd * 4;
        if (g != gcur) { gcur = g; lr = tab[((size_t)g * 64 + lane) * 2]; li = tab[((size_t)g * 64 + lane) * 2 + 1];
            const f32x4* bb = (const f32x4*)(tab + 16384 + ((size_t)g * 1024 + lane * 16) * 2);
#pragma unroll
            for (int q = 0; q < 8; ++q) bbv[q] = bb[q];
            LDS_WAIT(); asm volatile("" ::: "memory");
            const float* cre = (const float*)a.in[I_S5CRE] + (size_t)g * 1024; const float* cim = (const float*)a.in[I_S5CIM] + (size_t)g * 1024;
#pragma unroll 4
            for (int i = 0; i < 16; ++i) { cs[(i * 64 + lane) * 2] = cre[i * 64 + lane]; cs[(i * 64 + lane) * 2 + 1] = cim[i * 64 + lane]; } }
        { const int t = lane >> 4, c = lane & 15; const size_t row = row0 + t; const float r = __builtin_amdgcn_rsqf(SS3[row] * (1.f / DM) + EPS);
            us[lane] = bf2f(XB[row * DM + g * 16 + c]) * r * gn[g * 16 + c]; }
        LDS_WAIT(); asm volatile("" ::: "memory");
        { float sr = x0r[((size_t)bd * 64 + g) * 64 + lane], si = x0i[((size_t)bd * 64 + g) * 64 + lane];
#pragma unroll
            for (int t = 0; t < 4; ++t) { float br = 0.f, bi = 0.f;
#pragma unroll
                for (int q = 0; q < 4; ++q) { const f32x4 u4 = *(const LAS f32x4*)(us + t * 16 + 4 * q); const f32x4 b0 = bbv[2 * q], b1 = bbv[2 * q + 1];
                    br += (b0.x * u4.x + b0.z * u4.y) + (b1.x * u4.z + b1.z * u4.w); bi += (b0.y * u4.x + b0.w * u4.y) + (b1.y * u4.z + b1.w * u4.w); }
                const float nr = lr * sr - li * si + br, ni = lr * si + li * sr + bi; sr = nr; si = ni; xr[t * 64 + lane] = sr; xi[t * 64 + lane] = si; }
            a.out[O_S5RS + ((size_t)bd * 64 + g) * 64 + lane] = sr; a.out[O_S5IS + ((size_t)bd * 64 + g) * 64 + lane] = si; }
        LDS_WAIT(); asm volatile("" ::: "memory");
        { const int t = lane >> 4, co = lane & 15; const LAS f32x2* cp = (const LAS f32x2*)(cs + co * 128);
            float y = dd[g * 16 + co] * us[t * 16 + co];
#pragma unroll 8
            for (int p = 0; p < 64; ++p) { const f32x2 cc = cp[p]; y += cc.x * xr[t * 64 + p] - cc.y * xi[t * 64 + p]; }
            GG[(row0 + t) * DM + g * 16 + co] = (bf16)f2bf(gelu_tanh(y)); }
        LDS_WAIT(); asm volatile("" ::: "memory");
    }
}
struct EpiS5E {
    static constexpr bool PERM = false;
    float* E;
    DI void operator()(const f32x4 (&acc)[2][2][4][2], const pg8::Unit& u, int wr, int wc, int fr, int fq) const {
        const int j = (int)(u.aoff / (2 * S5K * 2)); const int row0 = u.pm * 256 + wr * 64 + fr, col0 = wc * 32 + 4 * fq;
#pragma unroll
        for (int ai = 0; ai < 2; ++ai)
#pragma unroll
            for (int m = 0; m < 4; ++m) { const int n = row0 + ai * 128 + m * 16;
#pragma unroll
                for (int bj = 0; bj < 2; ++bj)
#pragma unroll
                    for (int nn = 0; nn < 2; ++nn) *(f32x4*)(E + ((size_t)n * S5G + 2 * j + bj) * 128 + col0 + nn * 16) = acc[ai][bj][m][nn]; }
    }
};
DI void s5_scan_units(const Args& a, int bx, int G, int tid) {
    const float* E = (const float*)(a.ws + WS_S5E); bf16* U2 = (bf16*)(a.ws + WS_U2); const float* tab = (const float*)(a.ws + WS_S5TAB);
    for (int L = bx; L < 256; L += G) { const int g = L >> 2, pm = L & 3;
        if (tid < 128) { const int p = tid & 63, b = 2 * pm + (tid >> 6);
            const float lr = tab[8192 + ((size_t)g * 64 + p) * 2], li = tab[8192 + ((size_t)g * 64 + p) * 2 + 1];
            float sr = 0.f, si = 0.f;
#pragma unroll 4
            for (int c = 0; c < S5NC; ++c) { const size_t n = (size_t)b * S5NC + c; const float er = E[(n * S5G + g) * 128 + p], ei = E[(n * S5G + g) * 128 + 64 + p];
                bf16* up = U2 + (n * S5G + g) * S5K + 256; up[p] = (bf16)f2bf(sr); up[64 + p] = (bf16)f2bf(si);
                const float nr = lr * sr - li * si + er, ni = lr * si + li * sr + ei; sr = nr; si = ni; }
            const size_t i = ((size_t)b * 64 + g) * 64 + p; a.out[O_S5RP + i] = sr; a.out[O_S5IP + i] = si; } }
    asm volatile("s_waitcnt vmcnt(0)" ::: "memory");
    __syncthreads();
}
struct EpiS5Y {
    static constexpr bool PERM = false;
    const bf16* U2; const float* D; bf16* GG;
    DI void operator()(const f32x4 (&acc)[2][2][4][2], const pg8::Unit& u, int wr, int wc, int fr, int fq) const {
        const int g = (int)(u.aoff / (S5K * 2)); const int row0 = u.pm * 256 + wr * 64 + fr, col0 = wc * 32 + 4 * fq;
#pragma unroll
        for (int ai = 0; ai < 2; ++ai)
#pragma unroll
            for (int m = 0; m < 4; ++m) { const int n = row0 + ai * 128 + m * 16;
#pragma unroll
                for (int bj = 0; bj < 2; ++bj)
#pragma unroll
                    for (int nn = 0; nn < 2; ++nn) { const int col = col0 + bj * 128 + nn * 16, t = col >> 4, co = col & 15;
                        const u32x2 uw = *(const u32x2*)(U2 + ((size_t)n * S5G + g) * S5K + col); const f32x4 d4 = *(const f32x4*)(D + g * 16 + co); const f32x4 v = acc[ai][bj][m][nn];
                        const float y0 = gelu_tanh(v[0] + d4.x * bflo(uw.x)), y1 = gelu_tanh(v[1] + d4.y * bfhi(uw.x)), y2 = gelu_tanh(v[2] + d4.z * bflo(uw.y)), y3 = gelu_tanh(v[3] + d4.w * bfhi(uw.y));
                        u32x2 w; w.x = pk2(y0, y1); w.y = pk2(y2, y3); *(u32x2*)(GG + ((size_t)n * S5T + t) * DM + g * 16 + co) = w; }
                asm volatile("" ::: "memory"); }
    }
};
#ifndef MK_N_LAUNCHES
#define MK_N_LAUNCHES 1
#endif
constexpr int N_PHASES = 21;
__global__ void __launch_bounds__(NTHR, 2) mega_fwd(Args args) {
    extern __shared__ __attribute__((aligned(16))) unsigned char lds_raw[];
    LAS unsigned char* lds = (LAS unsigned char*)lds_raw;
    volatile LAS unsigned* MISC = (volatile LAS unsigned*)(lds + MISC_OFF);
    const int tid = threadIdx.x, lane = tid & 63, wave = __builtin_amdgcn_readfirstlane(tid >> 6);
    const int G = gridDim.x; const int bx = blockIdx.x; const int vcu = (G % 8 == 0) ? (bx % 8) * (G / 8) + bx / 8 : bx;
    unsigned char* ws = args.ws;
    unsigned* ctl = (unsigned*)(ws + WS_CTL);
    if (tid < 64) MISC[tid] = 0u;
    __syncthreads();
    const int lo = args.ph_lo, hi = args.ph_hi;
    XcdBarrier bar; bar.bar = ctl + CW_BAR; bar.x = 0; bar.st = nullptr;
    if (hi - lo > 1) bar = xcd_barrier_post(ctl + CW_BAR, MISC + 8);
#ifndef PHMASK
#define PHMASK 0xffffffffu
#endif
#define IN(k) (((PHMASK >> (k)) & 1u) && lo <= (k) && (k) < hi)
#define SEAM(k) do { if (IN(k) && IN((k) + 1)) xcd_barrier(bar); } while (0)
    const int rcu = G - 1 - bx;
    float* SS = (float*)(ctl + CW_SS);
    float* H = args.out + O_Y;
    bf16* XB0 = (bf16*)(ws + WS_XB0); bf16* XB1 = (bf16*)(ws + WS_XB1);
    const float* ss0 = (const float*)(ws + WS_SSQ) + MT;

    if (IN(0)) { _Pragma("unroll 1") for (int rep_ = 0; rep_ < REPS(0); ++rep_) { __syncthreads(); p0_prologue(args, lds, vcu, G, tid, lane, wave); } } SEAM(0);
    if (IN(1)) {
        pg8::Gemm g{XB0, (const bf16*)(ws + WS_WIN), DM, DM, DM}; pg8::GridOrder S; S.init(MP / 256, ZW / 256, G, bx);
        pg8::EpiZ E{(bf16*)(ws + WS_Z), ss0, SS + 6 * MT};
        pg8::gemm_phase<pg8::EpiZ, pg8::GridOrder, true>(lds, g, S, E);
        sk::skinny_gemm4(lds, XB0 + (size_t)MP * DM, DM, (const bf16*)(ws + WS_WIN), DM, DM, ZW / 128, sk::SkZ{(bf16*)(ws + WS_Z), ss0, SS + 6 * MT}, G == 256 ? (bx >= 192 ? bx - 192 : (1 << 20)) : rcu, G == 256 ? 64 : G, tid, lane, wave);
    } SEAM(1);
    if (IN(3)) { _Pragma("unroll 1") for (int rep_ = 0; rep_ < REPS(3); ++rep_) {
        { pg8::Gemm g{(const bf16*)(ws + WS_Z) + ZC_CQ, (const bf16*)(ws + WS_WUQ), ZW, QL, QL}; pg8::GridOrder S; S.init(MP / 256, 3, G, bx);
          pg8::EpiBf16<0> E{(bf16*)(ws + WS_QRAW), 768, SS + 6 * MT, 1.f / QL};
          pg8::gemm_phase<pg8::EpiBf16<0>, pg8::GridOrder, true>(lds, g, S, E); }
        sk::skinny_gemm(lds, (const bf16*)(ws + WS_Z) + (size_t)MP * ZW + ZC_CQ, ZW, (const bf16*)(ws + WS_WUQ), QL, QL, 24, sk::SkBf16<0>{(bf16*)(ws + WS_QRAW), 768, SS + 6 * MT, 1.f / QL}, sk::BMapLin(), G == 256 ? (bx >= 192 ? bx - 192 : (1 << 20)) : rcu, G == 256 ? 64 : G, tid, lane, wave);
        __syncthreads();
        { pg8::Gemm g{(const bf16*)(ws + WS_Z) + ZC_CKV, (const bf16*)(ws + WS_WUKVG), ZW, KVL, KVL}; pg8::GridOrder S; S.init(MP / 256, 4, G, bx);
          pg8::EpiBf16<0> E{(bf16*)(ws + WS_KVRAW), 1024, SS + 7 * MT, 1.f / KVL};
          pg8::gemm_phase<pg8::EpiBf16<0>, pg8::GridOrder, true>(lds, g, S, E); }
        sk::skinny_gemm(lds, (const bf16*)(ws + WS_Z) + (size_t)MP * ZW + ZC_CKV, ZW, (const bf16*)(ws + WS_WUKVG), KVL, KVL, 32, sk::SkBf16<0>{(bf16*)(ws + WS_KVRAW), 1024, SS + 7 * MT, 1.f / KVL}, sk::BMapLin(), rcu, G, tid, lane, wave);
        __syncthreads();
#pragma unroll 1
        for (int li = 0; li < 2; ++li) { pg8::Gemm g{(const bf16*)(ws + WS_PB) + (size_t)li * MT * PLE, (const bf16*)(ws + WS_WPROJ) + (size_t)li * DM * PLE, PLE, PLE, PLE}; pg8::GridOrder S; S.init(MP / 256, 4, G, bx);
          pg8::EpiBf16<0> E{(bf16*)(ws + WS_PP) + (size_t)li * MT * DM, DM, nullptr, 0.f};
          pg8::gemm_phase<pg8::EpiBf16<0>, pg8::GridOrder, true>(lds, g, S, E); }
#pragma unroll 1
        for (int li = 0; li < 2; ++li) sk::skinny_gemm(lds, (const bf16*)(ws + WS_PB) + ((size_t)li * MT + MP) * PLE, PLE, (const bf16*)(ws + WS_WPROJ) + (size_t)li * DM * PLE, PLE, PLE, 32, sk::SkBf16<0>{(bf16*)(ws + WS_PP) + (size_t)li * MT * DM, DM, nullptr, 0.f}, sk::BMapLin(), rcu, G, tid, lane, wave);
    }
    } if (IN(3) && IN(5)) xcd_barrier(bar);
    if (IN(5)) { p4_attn_prep(args, lds, vcu, G, tid, lane, wave); gla_a_phase(args, lds, vcu, G, tid, lane, wave); gla_sample_phase(args, lds, vcu, G, tid, lane, wave); } SEAM(5);
    if (IN(6)) { gla_b_phase(args, vcu, G, tid); p4b_sample_q(args, lds, vcu, G, tid, lane, wave); } SEAM(6);
    if (IN(7)) { _Pragma("unroll 1") for (int rep_ = 0; rep_ < REPS(70); ++rep_) { attn_prompt_phase(args, lds, vcu, G, tid, lane, wave); } _Pragma("unroll 1") for (int rep_ = 0; rep_ < REPS(71); ++rep_) { gla_c_phase(args, lds, vcu, G, tid, lane, wave); } _Pragma("unroll 1") for (int rep_ = 0; rep_ < REPS(72); ++rep_) { attn_sample_phase(args, lds, vcu, G, tid, lane, wave); } } SEAM(7);
    if (IN(8)) { _Pragma("unroll 1") for (int rep_ = 0; rep_ < REPS(8); ++rep_) { attn_sample_final(args, lds, vcu, G, tid, lane, wave); } } SEAM(8);
    if (IN(9)) {
        pg8::Gemm g{(const bf16*)(ws + WS_MIX), (const bf16*)(ws + WS_WOUT), DM, DM, DM}; pg8::GridOrder S; S.init(MP / 256, 4, G, bx);
        pg8::EpiRes<0> E{(const float*)args.in[I_XP], (const float*)args.in[I_XS], nullptr, nullptr, XB1, SS + 1 * MT, nullptr, nullptr};
        pg8::gemm_phase<pg8::EpiRes<0>, pg8::GridOrder, true>(lds, g, S, E);
        sk::skinny_gemm(lds, (const bf16*)(ws + WS_MIX) + (size_t)MP * DM, DM, (const bf16*)(ws + WS_WOUT), DM, DM, 32, sk::SkRes<0>{(const float*)args.in[I_XS], nullptr, nullptr, XB1, SS + 1 * MT, nullptr, nullptr}, sk::BMapLin(), rcu, G, tid, lane, wave);
    } SEAM(9);
#define LAYER_TAIL(li) do { \
        constexpr int pb = 10 + 8 * (li); \
        bf16* xin = (li) == 0 ? (bf16*)(args.ws + WS_XB1) : (bf16*)(args.ws + WS_XB0); bf16* xmid = (li) == 0 ? (bf16*)(args.ws + WS_XB0) : (bf16*)(args.ws + WS_XB1); \
        if (IN(pb)) { \
            pg8::Gemm g{xin, (const bf16*)(args.ws + WS_WUP) + (size_t)(li) * FF * DM, DM, DM, DM}; pg8::GridOrder S; S.init(MP / 256, FF / 256, G, bx); \
            pg8::EpiBf16<1> E{(bf16*)(args.ws + WS_A1), FF, (float*)((unsigned*)(args.ws + WS_CTL) + CW_SS) + ((li) == 0 ? 1 : 4) * MT, 1.f / DM}; \
            pg8::gemm_phase<pg8::EpiBf16<1>, pg8::GridOrder, true>(lds, g, S, E); \
            sk::skinny_gemm4(lds, xin + (size_t)MP * DM, DM, (const bf16*)(args.ws + WS_WUP) + (size_t)(li) * FF * DM, DM, DM, FF / 128, sk::SkBf16<1>{(bf16*)(args.ws + WS_A1), FF, (float*)((unsigned*)(args.ws + WS_CTL) + CW_SS) + ((li) == 0 ? 1 : 4) * MT, 1.f / DM}, rcu, G, tid, lane, wave); \
        } SEAM(pb); \
        if (IN(pb + 1)) { \
            float* Hh = args.out + O_Y; \
            pg8::Gemm g{(const bf16*)(args.ws + WS_A1), (const bf16*)(args.ws + WS_WDN) + (size_t)(li) * DM * FF, FF, FF, FF}; pg8::GridOrder S; S.init(MP / 256, 4, G, bx); \
            pg8::EpiRes<0> E{nullptr, nullptr, xin, nullptr, xmid, (float*)((unsigned*)(args.ws + WS_CTL) + CW_SS) + ((li) == 0 ? 2 : 5) * MT, nullptr, nullptr}; (void)Hh; \
            pg8::gemm_phase<pg8::EpiRes<0>, pg8::GridOrder, true>(lds, g, S, E); \
            sk::skinny_gemm(lds, (const bf16*)(args.ws + WS_A1) + (size_t)MP * FF, FF, (const bf16*)(args.ws + WS_WDN) + (size_t)(li) * DM * FF, FF, FF, 32, sk::SkRes<0>{nullptr, xin, nullptr, xmid, (float*)((unsigned*)(args.ws + WS_CTL) + CW_SS) + ((li) == 0 ? 2 : 5) * MT, nullptr, nullptr}, sk::BMapLin(), rcu, G, tid, lane, wave); \
        } SEAM(pb + 1); \
        if (IN(pb + 2)) { \
            float* Hh = args.out + O_Y; float* SSb = (float*)((unsigned*)(args.ws + WS_CTL) + CW_SS); \
            pg8::Gemm g{xmid, (const bf16*)(args.ws + WS_WGATE) + (size_t)(li) * DM * DM, DM, DM, DM}; pg8::GridOrder S; S.init(MP / 256, 4, G, bx); \
            pg8::EpiRes<1> E{nullptr, nullptr, xmid, (li) == 0 ? nullptr : Hh, (li) == 0 ? xin : nullptr, (li) == 0 ? SSb + 3 * MT : nullptr, SSb + ((li) == 0 ? 2 : 5) * MT, (const bf16*)(args.ws + WS_PP) + (size_t)(li) * MT * DM}; \
            pg8::gemm_phase<pg8::EpiRes<1>, pg8::GridOrder, true>(lds, g, S, E); \
            sk::skinny_gemm(lds, xmid + (size_t)MP * DM, DM, (const bf16*)(args.ws + WS_WGATE) + (size_t)(li) * DM * DM, DM, DM, 32, sk::SkRes<1>{nullptr, xmid, (li) == 0 ? nullptr : Hh, (li) == 0 ? xin : nullptr, (li) == 0 ? SSb + 3 * MT : nullptr, SSb + ((li) == 0 ? 2 : 5) * MT, (const bf16*)(args.ws + WS_PP) + (size_t)(li) * MT * DM}, sk::BMapLin(), rcu, G, tid, lane, wave); \
        } SEAM(pb + 2); } while (0)
    LAYER_TAIL(0);
    const int s5_split = (G > 128) ? (DB * S5G) / 2 : DB * S5G;
    if (IN(13)) { s5_norm_phase(args, vcu, G, lane, wave); s5_sample_phase(args, lds, vcu * NWAVES + wave, G * NWAVES, 0, s5_split, lane, wave); } SEAM(13);
    if (IN(14)) {
        pg8::Gemm g{(const bf16*)(args.ws + WS_U2), (const bf16*)(args.ws + WS_S5BD), S5G * S5K, 2 * S5K, 2 * S5K}; pg8::BatchOrder S; S.init(32, S5N / 256, 1, (size_t)2 * S5K * 2, (size_t)256 * 2 * S5K * 2, G, bx);
        EpiS5E E{(float*)(args.ws + WS_S5E)};
        pg8::gemm_phase<EpiS5E, pg8::BatchOrder, true, true>(lds, g, S, E);
        if (bx >= 128) s5_sample_phase(args, lds, (bx - 128) * NWAVES + wave, (G - 128) * NWAVES, s5_split, DB * S5G, lane, wave);
    } if (IN(14) && IN(16)) xcd_barrier(bar);
    if (IN(16)) {
        _Pragma("unroll 1") for (int rep_ = 0; rep_ < REPS(16); ++rep_) s5_scan_units(args, bx, G, tid);
        pg8::Gemm g{(const bf16*)(args.ws + WS_U2), (const bf16*)(args.ws + WS_S5TN), S5G * S5K, S5K, S5K}; pg8::BatchOrder S; S.init(64, S5N / 256, 1, (size_t)S5K * 2, (size_t)256 * S5K * 2, G, bx);
        EpiS5Y E{(const bf16*)(args.ws + WS_U2), (const float*)args.in[I_S5D], (bf16*)(args.ws + WS_GG)};
        pg8::gemm_phase<EpiS5Y, pg8::BatchOrder, true, true>(lds, g, S, E);
    } SEAM(16);
    if (IN(17)) {
        pg8::Gemm g{(const bf16*)(args.ws + WS_GG), (const bf16*)(args.ws + WS_WGLU), DM, DM, DM}; pg8::GridOrder S; S.init(MP / 256, 8, G, bx);
        pg8::EpiGlu E{(const bf16*)(args.ws + WS_XB1), (bf16*)(args.ws + WS_XB0), (float*)((unsigned*)(args.ws + WS_CTL) + CW_SS) + 4 * MT};
        pg8::gemm_phase<pg8::EpiGlu, pg8::GridOrder, true>(lds, g, S, E);
        sk::skinny_gemm(lds, (const bf16*)(args.ws + WS_GG) + (size_t)MP * DM, DM, (const bf16*)(args.ws + WS_WGLU), DM, DM, 64, sk::SkGlu{(const bf16*)(args.ws + WS_XB1), (bf16*)(args.ws + WS_XB0), (float*)((unsigned*)(args.ws + WS_CTL) + CW_SS) + 4 * MT}, sk::BMapGlu(), rcu, G, tid, lane, wave);
    } SEAM(17);
    LAYER_TAIL(1);
#undef LAYER_TAIL
#undef IN
#undef SEAM
}

extern "C" void kernel_launch(void* const* d_in, const int* in_sizes, int n_in, void* d_out, int out_size, void* d_ws, size_t ws_size, hipStream_t stream) {
    static int grid = 0;
    if (grid == 0) {
        if (n_in != 38 || out_size != (int)O_END || ws_size < WS_END) { fprintf(stderr, "kernel_launch: unexpected shapes (n_in %d, out %d, ws %zu); nothing launched\n", n_in, out_size, ws_size); grid = -1; return; }
        int dev = 0, cus = 0, per_cu = 0;
        if (hipGetDevice(&dev) != hipSuccess || hipDeviceGetAttribute(&cus, hipDeviceAttributeMultiprocessorCount, dev) != hipSuccess) { grid = -1; return; }
        if (hipFuncSetAttribute((const void*)mega_fwd, hipFuncAttributeMaxDynamicSharedMemorySize, LDS_BYTES) != hipSuccess) { fprintf(stderr, "kernel_launch: hipFuncSetAttribute failed\n"); grid = -1; return; }
        if (hipOccupancyMaxActiveBlocksPerMultiprocessor(&per_cu, (const void*)mega_fwd, NTHR, LDS_BYTES) != hipSuccess || per_cu < 1) { fprintf(stderr, "kernel_launch: occupancy query reports %d\n", per_cu); (void)hipGetLastError(); per_cu = 1; }
        grid = cus;
    }
    if (grid < 0) return;
    if (hipMemsetAsync((char*)d_ws + WS_CTL, 0, CTL_ZERO_BYTES, stream) != hipSuccess) return;
    Args a{};
    for (int i = 0; i < 38; ++i) a.in[i] = d_in[i];
    a.out = (float*)d_out; a.ws = (unsigned char*)d_ws;
#if MK_N_LAUNCHES == 1
    a.ph_lo = 0; a.ph_hi = N_PHASES;
    hipLaunchKernelGGL(mega_fwd, dim3(grid), dim3(NTHR), LDS_BYTES, stream, a);
#else
    for (int p = 0; p < N_PHASES; ++p) { a.ph_lo = p; a.ph_hi = p + 1; hipLaunchKernelGGL(mega_fwd, dim3(grid), dim3(NTHR), LDS_BYTES, stream, a); }
#endif
}
```

```cpp
#include <hip/hip_runtime.h>
#include <cstdio>
#include <cstdint>

#ifndef PROBE_PHASE
#define PROBE_PHASE -1
#endif
#define REPS(k) (PROBE_PHASE == (k) ? 2 : 1)
#define GAS __attribute__((address_space(1)))
#define LAS __attribute__((address_space(3)))
#define DI __device__ __forceinline__
typedef unsigned short bf16;
typedef short bf16x8 __attribute__((ext_vector_type(8)));
typedef short s16x4 __attribute__((ext_vector_type(4)));
typedef short v4i16_t __attribute__((ext_vector_type(4)));
typedef float f32x2 __attribute__((ext_vector_type(2)));
typedef float f32x4 __attribute__((ext_vector_type(4)));
typedef float f32x16 __attribute__((ext_vector_type(16)));
typedef unsigned u32x2 __attribute__((ext_vector_type(2)));
typedef unsigned u32x4 __attribute__((ext_vector_type(4)));
typedef __bf16 bf16x2_t __attribute__((ext_vector_type(2)));

constexpr int DM = 1024, NB = 8, SEQ = 2048, MP = NB * SEQ, DB = 128, DT = 4, MS = DB * DT, MT = MP + MS;
constexpr int NPAGES = 64, PAGE = 128, PAST = NPAGES * PAGE;
constexpr int QL = 384, KVL = 256, ROPE = 32, NOPE = 64, QK = 96, VD = 64, NH = 8;
constexpr int GH = 4, GDK = 128, GDV = 128, GRK = 16;
constexpr int ZW = 2816;
constexpr int FF = 4096, PLE = 256;
constexpr int S5G = 64, S5P = 64, S5C = 16, S5T = 16, S5NC = SEQ / S5T, S5K = 384, S5N = NB * S5NC;
constexpr float EPS = 1e-6f;
constexpr int ZC_CQ = 0, ZC_CKV = 384, ZC_GQ = 640, ZC_GK = 1152, ZC_GV = 1664, ZC_GR = 2176, ZC_KPE = 2688, ZC_GA = 2720, ZC_END = 2736;

constexpr size_t O_Y = 0;
constexpr size_t O_CKVP = (size_t)MT * DM;
constexpr size_t O_KPEP = O_CKVP + (size_t)MP * KVL;
constexpr size_t O_GLAP = O_KPEP + (size_t)MP * ROPE;
constexpr size_t O_S5RP = O_GLAP + (size_t)NB * GH * GDK * GDV;
constexpr size_t O_S5IP = O_S5RP + (size_t)NB * S5G * S5P;
constexpr size_t O_CKVS = O_S5IP + (size_t)NB * S5G * S5P;
constexpr size_t O_KPES = O_CKVS + (size_t)MS * KVL;
constexpr size_t O_GLAS = O_KPES + (size_t)MS * ROPE;
constexpr size_t O_S5RS = O_GLAS + (size_t)DB * GH * GDK * GDV;
constexpr size_t O_S5IS = O_S5RS + (size_t)DB * S5G * S5P;
constexpr size_t O_END = O_S5IS + (size_t)DB * S5G * S5P;
static_assert(O_END == 32194560, "output size");

constexpr size_t MiB = 1u << 20;
constexpr size_t WS_CTL = 0, CTL_ZERO_BYTES = 2 * MiB;
constexpr int CW_BAR = 1024;
constexpr int CW_SS = 8192;
static_assert((CW_SS + 8 * MT) * 4 <= (int)CTL_ZERO_BYTES, "ctl");
constexpr size_t WS_WIN = 2 * MiB;
constexpr size_t WS_WUQ = 8 * MiB;
constexpr size_t WS_WUKV = 9 * MiB;
constexpr size_t WS_WUKVG = 9 * MiB + 512 * 1024;
constexpr size_t WS_WOUT = 10 * MiB;
constexpr size_t WS_WGLU = 12 * MiB;
constexpr size_t WS_WUP = 16 * MiB;
constexpr size_t WS_WDN = 32 * MiB;
constexpr size_t WS_WGATE = 48 * MiB;
constexpr size_t WS_WPROJ = 52 * MiB;
constexpr size_t WS_ROPE = 54 * MiB;
constexpr size_t WS_S5TAB = 56 * MiB;
constexpr size_t WS_S5TN = 58 * MiB;
constexpr size_t WS_S5BD = 98 * MiB;
constexpr size_t WS_PB = 118 * MiB;
constexpr size_t WS_XB0 = 136 * MiB;
constexpr size_t WS_XB1 = 170 * MiB;
constexpr size_t WS_Z = 204 * MiB;
constexpr size_t WS_CKVB = 296 * MiB;
constexpr size_t WS_SSQ = 305 * MiB;
constexpr size_t WS_LG = 306 * MiB;
constexpr size_t WS_QRAW = 340 * MiB;
constexpr size_t WS_KVRAW = 366 * MiB;
constexpr size_t WS_QF = 400 * MiB;
constexpr size_t WS_KF = 426 * MiB;
constexpr size_t WS_VT = 452 * MiB;
constexpr size_t WS_MIX = 470 * MiB;
constexpr size_t WS_A1 = 504 * MiB;
constexpr size_t WS_PP = 638 * MiB;
constexpr size_t WS_GU = 706 * MiB;
constexpr size_t WS_GDEC = 771 * MiB;
constexpr size_t WS_GSP = 772 * MiB;
constexpr size_t WS_U2 = 920 * MiB;
constexpr size_t WS_S5E = 970 * MiB;
constexpr size_t WS_GG = 866 * MiB;
constexpr size_t WS_QS = 900 * MiB;
constexpr size_t WS_SPART = 904 * MiB;
constexpr size_t WS_SL = 913 * MiB;
constexpr size_t WS_END = 1004 * MiB;

DI unsigned f2bf(float f) { unsigned u = __builtin_bit_cast(unsigned, f); return (u + 0x7fffu + ((u >> 16) & 1u)) >> 16; }
DI unsigned pk2(float lo, float hi) { f32x2 v = {lo, hi}; bf16x2_t b = __builtin_convertvector(v, bf16x2_t); return __builtin_bit_cast(unsigned, b); }
DI float bf2f(unsigned short b) { return __builtin_bit_cast(float, (unsigned)b << 16); }
DI float bflo(unsigned u) { return __builtin_bit_cast(float, u << 16); }
DI float bfhi(unsigned u) { return __builtin_bit_cast(float, u & 0xffff0000u); }
DI float wave_sum(float v) {
#pragma unroll
    for (int o = 1; o < 64; o <<= 1) v += __shfl_xor(v, o);
    return v;
}
DI float sigmoidf_(float x) { return 1.f / (1.f + __expf(-x)); }
DI float row16_sum(float v) {
    v += __builtin_bit_cast(float, __builtin_amdgcn_update_dpp(0, __builtin_bit_cast(int, v), 0x128, 0xf, 0xf, false));
    v += __builtin_bit_cast(float, __builtin_amdgcn_update_dpp(0, __builtin_bit_cast(int, v), 0x124, 0xf, 0xf, false));
    v += __builtin_bit_cast(float, __builtin_amdgcn_update_dpp(0, __builtin_bit_cast(int, v), 0x4E, 0xf, 0xf, false));
    v += __builtin_bit_cast(float, __builtin_amdgcn_update_dpp(0, __builtin_bit_cast(int, v), 0xB1, 0xf, 0xf, false));
    return v; }
DI float row8_sum(float v) {
    v += __builtin_bit_cast(float, __builtin_amdgcn_update_dpp(0, __builtin_bit_cast(int, v), 0xB1, 0xf, 0xf, false));
    v += __builtin_bit_cast(float, __builtin_amdgcn_update_dpp(0, __builtin_bit_cast(int, v), 0x4E, 0xf, 0xf, false));
    v += __builtin_bit_cast(float, __builtin_amdgcn_update_dpp(0, __builtin_bit_cast(int, v), 0x141, 0xf, 0xf, false));
    return v; }
#define LDS_WAIT() asm volatile("s_waitcnt lgkmcnt(0)" ::: "memory")
#define VM_WAIT() asm volatile("s_waitcnt vmcnt(0)" ::: "memory")

#define XB_TMO      128
#define XB_XCNT(j)  (256  + 64 * (j))
#define XB_XSUB(j)  (1280 + 64 * (j))
#define XB_XGEN(j)  (2304 + 64 * (j))
#define XB_TOP      3328
#define XB_TOPGEN   3392
#define XCD_BAR_WORDS 3456
#define XB_SPIN_CAP (1u << 18)
static_assert(CW_BAR + XCD_BAR_WORDS <= CW_SS, "ctl map");
DI unsigned xb_ld(unsigned* p)              { return __hip_atomic_load(p, __ATOMIC_RELAXED, __HIP_MEMORY_SCOPE_AGENT); }
DI unsigned xb_add(unsigned* p, unsigned v) { return __hip_atomic_fetch_add(p, v, __ATOMIC_RELAXED, __HIP_MEMORY_SCOPE_AGENT); }
DI unsigned xb_xcc_id() { return (unsigned)__builtin_amdgcn_s_getreg((3 << 11) | 20) & 0xFu; }
#define XB_SPIN(cond, bar) do { unsigned _sp = 0; while (cond) { __builtin_amdgcn_s_sleep(1); \
    if ((++_sp & 255u) == 0u) { if (xb_ld(&(bar)[XB_TMO])) break; if (_sp > XB_SPIN_CAP) { atomicAdd(&(bar)[XB_TMO], 1u); break; } } } } while (0)
struct XcdBarrier { unsigned* bar; unsigned x; volatile LAS unsigned* st; };
DI XcdBarrier xcd_barrier_post(unsigned* bar, volatile LAS unsigned* st) {
    XcdBarrier b; b.bar = bar; b.x = xb_xcc_id(); b.st = st;
    if (threadIdx.x == 0) (void)xb_add(&bar[XB_XCNT(b.x)], 1u);
    return b;
}
DI void xcd_barrier_complete(unsigned* bar, unsigned x, unsigned& nloc, unsigned& nx) {
    const unsigned G = gridDim.x * gridDim.y * gridDim.z;
    unsigned sum, cnt, mine, sp = 0u;
    for (;;) {
        sum = 0u; cnt = 0u; mine = 0u;
#pragma unroll
        for (unsigned j = 0; j < 16; ++j) { const unsigned c = xb_ld(&bar[XB_XCNT(j)]); sum += c; cnt += (c > 0u) ? 1u : 0u; mine = (j == x) ? c : mine; }
        if (sum == G) break;
        __builtin_amdgcn_s_sleep(1);
        if ((++sp & 255u) == 0u) { if (xb_ld(&bar[XB_TMO])) break; if (sp > XB_SPIN_CAP) { atomicAdd(&bar[XB_TMO], 1u); break; } }
    }
    nloc = mine > 0u ? mine : 1u; nx = cnt > 0u ? cnt : 1u;
}
DI void xcd_barrier(const XcdBarrier& b) {
    asm volatile("s_waitcnt vmcnt(0)" ::: "memory");
    __syncthreads();
    if (threadIdx.x == 0) {
        unsigned* bar = b.bar;
        __builtin_amdgcn_s_waitcnt(0);
        unsigned nloc = b.st[0], nx = b.st[1];
        if (nloc == 0u) { xcd_barrier_complete(bar, b.x, nloc, nx); b.st[0] = nloc; b.st[1] = nx; }
        const unsigned old = xb_add(&bar[XB_XSUB(b.x)], 1u);
        const unsigned gen = old / nloc;
        if (old + 1u == (gen + 1u) * nloc) {
            __builtin_amdgcn_fence(__ATOMIC_RELEASE, "agent");
            asm volatile("s_waitcnt vmcnt(0)" ::: "memory");
            const unsigned og = xb_add(&bar[XB_TOP], 1u);
            const unsigned tg = og / nx;
            if (og + 1u == (tg + 1u) * nx) xb_add(&bar[XB_TOPGEN], 1u);
            else XB_SPIN(xb_ld(&bar[XB_TOPGEN]) == tg, bar);
            __builtin_amdgcn_fence(__ATOMIC_ACQUIRE, "agent");
            xb_add(&bar[XB_XGEN(b.x)], 1u);
            asm volatile("s_waitcnt vmcnt(0)" ::: "memory");
        } else {
            XB_SPIN(xb_ld(&bar[XB_XGEN(b.x)]) == gen, bar);
            __builtin_amdgcn_fence(__ATOMIC_ACQUIRE, "agent");
            asm volatile("s_waitcnt vmcnt(0)" ::: "memory");
        }
    }
    __syncthreads();
}
namespace pg8 {
constexpr int BM = 256, BK = 64, HALF = 128, HTB = HALF * BK * 2, STAGE_BYTES = 8 * HTB, NXCD = 8, WGM = 4;
__host__ __device__ __forceinline__ int lds_byte(int r, int c) { const int st = (r >> 4) * 2 + (c >> 5), rr = r & 15, cc = c & 31, ob = rr * 64 + cc * 2; return st * 1024 + (ob ^ (((ob >> 9) & 1) << 5)); }
__host__ __device__ __forceinline__ void stage_rc(int b, int& R, int& C) { const int st = b / 1024, sb = b % 1024, swz = sb ^ (((sb >> 9) & 1) << 5); R = (st >> 1) * 16 + swz / 64; C = (st & 1) * 32 + (swz % 64) / 2; }
__host__ __device__ __forceinline__ int perm32(int rho) { const int n = rho >> 4, i = rho & 15; return 8 * (i >> 2) + 4 * n + (i & 3); }

struct Unit { int pm, pn; size_t aoff, boff; };
struct Gemm { const bf16* A; const bf16* Bt; int lda, ldb, K; };

struct GridOrder {
    int nM, nN, nwg, G, c;
    DI void init(int nM_, int nN_, int G_, int c_) { nM = nM_; nN = nN_; nwg = nM * nN; G = G_; c = c_; }
    DI bool next(int i, Unit& u) const {
        const long L = (long)i * G + c; if (L >= nwg) return false;
        int wgid = (int)L; { const int q = nwg / NXCD, r = nwg % NXCD, xcd = wgid % NXCD, off = wgid / NXCD; wgid = (xcd < r ? xcd * (q + 1) : r * (q + 1) + (xcd - r) * q) + off; }
        const int nig = WGM * nN, gid = wgid / nig, fm = gid * WGM, gsz = (nM - fm) < WGM ? (nM - fm) : WGM;
        u.pm = fm + ((wgid % nig) % gsz); u.pn = (wgid % nig) / gsz; u.aoff = 0; u.boff = 0; return true;
    }
};
struct BatchOrder {
    int nM, nN, nb, G, c; size_t astride, bstride;
    DI void init(int nb_, int nM_, int nN_, size_t as_, size_t bs_, int G_, int c_) { nb = nb_; nM = nM_; nN = nN_; astride = as_; bstride = bs_; G = G_; c = c_; }
    DI bool next(int i, Unit& u) const {
        const long L = (long)i * G + c; if (L >= (long)nb * nM * nN) return false;
        const int per = nM * nN, b = (int)(L / per), r = (int)(L % per);
        u.pm = r / nN; u.pn = r % nN; u.aoff = (size_t)b * astride; u.boff = (size_t)b * bstride; return true;
    }
};

template <class Epi, class Sched, bool ALIGN_EPI = false, bool KUNROLL1 = false>
DI void gemm_phase(LAS unsigned char* lds, const Gemm g, const Sched& S, const Epi& E) {
    const int tid = threadIdx.x, wid = __builtin_amdgcn_readfirstlane(tid >> 6), lane = tid & 63, wr = wid >> 2, wc = wid & 3, fr = lane & 15, fq = lane >> 4;
    const int K = g.K, nt = K / BK;
    unsigned voffA[2], voffB[2];
#pragma unroll
    for (int i = 0; i < 2; ++i) { int R, C; stage_rc(tid * 16 + i * 8192, R, C); const int Rb = Epi::PERM ? ((R & ~31) + perm32(R & 31)) : R;
        voffA[i] = (unsigned)(R * g.lda + C) * 2u; voffB[i] = (unsigned)(Rb * g.ldb + C) * 2u; }
    const size_t kstep = (size_t)(BK * 2);
    const size_t hstepA = (size_t)HALF * g.lda * 2, hstepB = (size_t)HALF * g.ldb * 2;
    const size_t tstepA = 2 * hstepA, tstepB = 2 * hstepB;
    const unsigned ldsw = (unsigned)wid * 1024u;
    const int aoff = lds_byte(wr * 64 + fr, fq * 8), boff = lds_byte(wc * 32 + fr, fq * 8);
#define PG8_SA(b, h) (((b) * 2 + (h)) * HTB)
#define PG8_SB(b, h) ((4 + (b) * 2 + (h)) * HTB)
#define PG8_STAGE(bufoff, gbase, voff) do { _Pragma("unroll") for (int _i = 0; _i < 2; ++_i) \
        __builtin_amdgcn_global_load_lds((const unsigned*)((const char*)(gbase) + (voff)[_i]), (LAS unsigned*)(lds + (bufoff) + ldsw + _i * 8192), 16, 0, 0); } while (0)
#define PG8_LDA(dst, b, h) do { _Pragma("unroll") for (int m = 0; m < 4; ++m) _Pragma("unroll") for (int k = 0; k < 2; ++k) dst[m][k] = *(const LAS bf16x8*)(lds + PG8_SA(b, h) + aoff + m * 2048 + k * 1024); } while (0)
#define PG8_LDB(dst, b, h) do { _Pragma("unroll") for (int n = 0; n < 2; ++n) _Pragma("unroll") for (int k = 0; k < 2; ++k) dst[n][k] = *(const LAS bf16x8*)(lds + PG8_SB(b, h) + boff + n * 2048 + k * 1024); } while (0)
#define PG8_MMA(ai, bj, At, Bt) do { __builtin_amdgcn_s_setprio(1); _Pragma("unroll") for (int m = 0; m < 4; ++m) _Pragma("unroll") for (int n = 0; n < 2; ++n) _Pragma("unroll") for (int k = 0; k < 2; ++k) \
        acc[ai][bj][m][n] = __builtin_amdgcn_mfma_f32_16x16x32_bf16(Bt[n][k], At[m][k], acc[ai][bj][m][n], 0, 0, 0); __builtin_amdgcn_s_setprio(0); } while (0)
#define PG8_WAIT_V(n) asm volatile("s_waitcnt vmcnt(" #n ")" ::: "memory")
#define PG8_WAIT_L(n) asm volatile("s_waitcnt lgkmcnt(" #n ")" ::: "memory")
#define PG8_BAR __builtin_amdgcn_s_barrier()
#define PG8_SCHED __builtin_amdgcn_sched_barrier(0)
    Unit cur, nxt; int ui = 0;
    if (!S.next(0, cur)) return;
    f32x4 acc[2][2][4][2];
#pragma unroll
    for (int a = 0; a < 2; ++a)
#pragma unroll
        for (int b = 0; b < 2; ++b)
#pragma unroll
            for (int m = 0; m < 4; ++m)
#pragma unroll
                for (int n = 0; n < 2; ++n) acc[a][b][m][n] = (f32x4){0.f, 0.f, 0.f, 0.f};
    bf16x8 At[4][2], B0[2][2], B1[2][2];
    const char* cA = (const char*)g.A + cur.aoff + (size_t)cur.pm * tstepA; const char* cB = (const char*)g.Bt + cur.boff + (size_t)cur.pn * tstepB;
    PG8_STAGE(PG8_SB(0, 0), cB, voffB); PG8_STAGE(PG8_SB(0, 1), cB + hstepB, voffB); PG8_STAGE(PG8_SA(0, 0), cA, voffA); PG8_STAGE(PG8_SA(0, 1), cA + hstepA, voffA);
    if (wr == 1) PG8_BAR;
    PG8_WAIT_V(2); PG8_BAR;
    PG8_STAGE(PG8_SB(1, 0), cB + kstep, voffB); PG8_STAGE(PG8_SA(1, 0), cA + kstep, voffA); PG8_STAGE(PG8_SB(1, 1), cB + hstepB + kstep, voffB);
    PG8_WAIT_V(6); PG8_BAR;
    for (;;) {
        const bool has_next = S.next(ui + 1, nxt);
        const char* nA = has_next ? (const char*)g.A + nxt.aoff + (size_t)nxt.pm * tstepA : cA; const char* nB = has_next ? (const char*)g.Bt + nxt.boff + (size_t)nxt.pn * tstepB : cB;
        int nt_ = nt; if constexpr (KUNROLL1) asm volatile("" : "+s"(nt_));
        for (int t = 0; t < nt_; t += 2) {
            const bool last = (t == nt_ - 2);
            const char* a1 = cA + (size_t)(t + 1) * kstep;
            const char* a2 = last ? nA : cA + (size_t)(t + 2) * kstep; const char* b2 = last ? nB : cB + (size_t)(t + 2) * kstep;
            const char* a3 = a2 + kstep; const char* b3 = b2 + kstep;
            PG8_LDB(B0, 0, 0); PG8_LDB(B1, 0, 1); PG8_SCHED; PG8_LDA(At, 0, 0); PG8_STAGE(PG8_SA(1, 1), a1 + hstepA, voffA);
            PG8_WAIT_V(8); PG8_WAIT_L(0); PG8_BAR; PG8_MMA(0, 0, At, B0); PG8_MMA(0, 1, At, B1); PG8_BAR; PG8_SCHED;
            PG8_LDA(At, 0, 1); PG8_STAGE(PG8_SB(0, 0), b2, voffB); PG8_STAGE(PG8_SB(0, 1), b2 + hstepB, voffB); PG8_STAGE(PG8_SA(0, 0), a2, voffA);
            PG8_WAIT_V(8); PG8_WAIT_L(0); PG8_BAR; PG8_MMA(1, 0, At, B0); PG8_MMA(1, 1, At, B1); PG8_BAR; PG8_SCHED;
            PG8_LDB(B0, 1, 0); PG8_LDB(B1, 1, 1); PG8_SCHED; PG8_LDA(At, 1, 0); PG8_STAGE(PG8_SA(0, 1), a2 + hstepA, voffA);
            PG8_WAIT_V(8); PG8_WAIT_L(0); PG8_BAR; PG8_MMA(0, 0, At, B0); PG8_MMA(0, 1, At, B1); PG8_BAR; PG8_SCHED;
            PG8_LDA(At, 1, 1); PG8_STAGE(PG8_SB(1, 0), b3, voffB); PG8_STAGE(PG8_SB(1, 1), b3 + hstepB, voffB); PG8_STAGE(PG8_SA(1, 0), a3, voffA);
            PG8_WAIT_V(8); PG8_WAIT_L(0); PG8_BAR; PG8_MMA(1, 0, At, B0); PG8_MMA(1, 1, At, B1); PG8_BAR; PG8_SCHED;
        }
        if constexpr (ALIGN_EPI) { if (wr == 0) PG8_BAR; }
        E(acc, cur, wr, wc, fr, fq);
        if (!has_next) break;
#pragma unroll
        for (int a = 0; a < 2; ++a)
#pragma unroll
            for (int b = 0; b < 2; ++b)
#pragma unroll
                for (int m = 0; m < 4; ++m)
#pragma unroll
                    for (int n = 0; n < 2; ++n) acc[a][b][m][n] = (f32x4){0.f, 0.f, 0.f, 0.f};
        cur = nxt; cA = nA; cB = nB; ++ui;
        if constexpr (ALIGN_EPI) { if (wr == 1) PG8_BAR; }
    }
    PG8_WAIT_V(0);
    if constexpr (!ALIGN_EPI) { if (wr == 0) PG8_BAR; }
    PG8_BAR;
#undef PG8_SA
#undef PG8_SB
#undef PG8_STAGE
#undef PG8_LDA
#undef PG8_LDB
#undef PG8_MMA
#undef PG8_WAIT_V
#undef PG8_WAIT_L
#undef PG8_BAR
#undef PG8_SCHED
}

template <int MODE> struct EpiBf16 {
    static constexpr bool PERM = true;
    bf16* O; int ldc; const float* ss; float ssdiv;
    DI void operator()(const f32x4 (&acc)[2][2][4][2], const Unit& u, int wr, int wc, int fr, int fq) const {
        const int row0 = u.pm * BM + wr * 64 + fr, col0 = u.pn * BM + wc * 32 + 8 * fq;
#pragma unroll
        for (int ai = 0; ai < 2; ++ai)
#pragma unroll
            for (int m = 0; m < 4; ++m) { const int row = row0 + ai * HALF + m * 16; bf16* rowp = O + (size_t)row * ldc + col0;
                float r = 1.f; if (ss) r = __builtin_amdgcn_rsqf(ss[row] * ssdiv + EPS);
#pragma unroll
                for (int bj = 0; bj < 2; ++bj) { f32x4 v0 = acc[ai][bj][m][0] * r, v1 = acc[ai][bj][m][1] * r;
                    if (MODE == 1) {
#pragma unroll
                        for (int j = 0; j < 4; ++j) { const float a = fmaxf(v0[j], 0.f), b = fmaxf(v1[j], 0.f); v0[j] = a * a; v1[j] = b * b; } }
                    u32x4 w; w.x = pk2(v0[0], v0[1]); w.y = pk2(v0[2], v0[3]); w.z = pk2(v1[0], v1[1]); w.w = pk2(v1[2], v1[3]);
                    *(u32x4*)(rowp + bj * HALF) = w; } }
    }
};
struct EpiZ {
    static constexpr bool PERM = true;
    bf16* O; const float* ss; float* ssq;
    DI void operator()(const f32x4 (&acc)[2][2][4][2], const Unit& u, int wr, int wc, int fr, int fq) const {
        const int row0 = u.pm * BM + wr * 64 + fr, col0 = u.pn * BM + wc * 32 + 8 * fq;
#pragma unroll
        for (int ai = 0; ai < 2; ++ai)
#pragma unroll
            for (int m = 0; m < 4; ++m) { const int row = row0 + ai * HALF + m * 16; bf16* rowp = O + (size_t)row * ZW + col0;
                const float r = __builtin_amdgcn_rsqf(ss[row] * (1.f / DM) + EPS);
#pragma unroll
                for (int bj = 0; bj < 2; ++bj) { const f32x4 v0 = acc[ai][bj][m][0] * r, v1 = acc[ai][bj][m][1] * r;
                    u32x4 w; w.x = pk2(v0[0], v0[1]); w.y = pk2(v0[2], v0[3]); w.z = pk2(v1[0], v1[1]); w.w = pk2(v1[2], v1[3]);
                    *(u32x4*)(rowp + bj * HALF) = w;
                    const int blk = u.pn * 2 + bj;
                    if (blk < 5) { float s = ((v0[0] * v0[0] + v0[1] * v0[1]) + (v0[2] * v0[2] + v0[3] * v0[3])) + ((v1[0] * v1[0] + v1[1] * v1[1]) + (v1[2] * v1[2] + v1[3] * v1[3]));
                        s += __shfl_xor(s, 16); s += __shfl_xor(s, 32); if (fq == 0) atomicAdd(ssq + (blk < 3 ? 0 : MT) + row, s); } } }
    }
};
template <int MODE> struct EpiRes {
    static constexpr bool PERM = false;
    const float* base0; const float* base1;
    const bf16* baseb;
    float* H; bf16* XB; float* ssout; const float* ssin; const bf16* PP;
    DI void operator()(const f32x4 (&acc)[2][2][4][2], const Unit& u, int wr, int wc, int fr, int fq) const {
        const int row0 = u.pm * BM + wr * 64 + fr, col0 = u.pn * BM + wc * 32 + 4 * fq;
#pragma unroll
        for (int ai = 0; ai < 2; ++ai)
#pragma unroll
            for (int m = 0; m < 4; ++m) { const int row = row0 + ai * HALF + m * 16;
                const float* bp = (row < MP) ? base0 + (size_t)row * DM : base1 + (size_t)(row - MP) * DM;
                float r = 1.f; if (MODE == 1) r = __builtin_amdgcn_rsqf(ssin[row] * (1.f / DM) + EPS);
                float s = 0.f;
#pragma unroll
                for (int bj = 0; bj < 2; ++bj)
#pragma unroll
                    for (int n = 0; n < 2; ++n) { const int col = col0 + bj * HALF + n * 16;
                        f32x4 v = acc[ai][bj][m][n];
                        if (MODE == 1) { const u32x2 pw = *(const u32x2*)(PP + (size_t)row * DM + col);
                            v[0] = sigmoidf_(v[0] * r) * bflo(pw.x); v[1] = sigmoidf_(v[1] * r) * bfhi(pw.x); v[2] = sigmoidf_(v[2] * r) * bflo(pw.y); v[3] = sigmoidf_(v[3] * r) * bfhi(pw.y); }
                        f32x4 h;
                        if (baseb) { const u32x2 bw = *(const u32x2*)(baseb + (size_t)row * DM + col); h = (f32x4){bflo(bw.x), bfhi(bw.x), bflo(bw.y), bfhi(bw.y)} + v; }
                        else h = *(const f32x4*)(bp + col) + v;
                        if (H) *(f32x4*)(H + (size_t)row * DM + col) = h;
                        if (XB) { u32x2 w; w.x = pk2(h[0], h[1]); w.y = pk2(h[2], h[3]); *(u32x2*)(XB + (size_t)row * DM + col) = w; }
                        s += (h[0] * h[0] + h[1] * h[1]) + (h[2] * h[2] + h[3] * h[3]); }
                if (ssout) { s += __shfl_xor(s, 16); s += __shfl_xor(s, 32); if (fq == 0) atomicAdd(ssout + row, s); } }
    }
};
struct EpiGlu {
    static constexpr bool PERM = false;
    const bf16* baseb; bf16* XB; float* ssout;
    DI void operator()(const f32x4 (&acc)[2][2][4][2], const Unit& u, int wr, int wc, int fr, int fq) const {
        const int row0 = u.pm * BM + wr * 64 + fr, col0 = u.pn * HALF + wc * 32 + 4 * fq;
#pragma unroll
        for (int ai = 0; ai < 2; ++ai)
#pragma unroll
            for (int m = 0; m < 4; ++m) { const int row = row0 + ai * HALF + m * 16; float s = 0.f;
#pragma unroll
                for (int n = 0; n < 2; ++n) { const int col = col0 + n * 16; const f32x4 v = acc[ai][0][m][n], gt = acc[ai][1][m][n];
                    const u32x2 bw = *(const u32x2*)(baseb + (size_t)row * DM + col); f32x4 h = {bflo(bw.x), bfhi(bw.x), bflo(bw.y), bfhi(bw.y)};
#pragma unroll
                    for (int j = 0; j < 4; ++j) h[j] += v[j] * sigmoidf_(gt[j]);
                    u32x2 w; w.x = pk2(h[0], h[1]); w.y = pk2(h[2], h[3]); *(u32x2*)(XB + (size_t)row * DM + col) = w;
                    s += (h[0] * h[0] + h[1] * h[1]) + (h[2] * h[2] + h[3] * h[3]); }
                s += __shfl_xor(s, 16); s += __shfl_xor(s, 32); if (fq == 0) atomicAdd(ssout + row, s); }
    }
};
}
struct Args { const void* in[38]; float* out; unsigned char* ws; int ph_lo, ph_hi; };
enum { I_XP = 0, I_XS, I_CCKV, I_CKPE, I_SGLA, I_S5RE, I_S5IM, I_PT, I_PP, I_PS, I_GNAB, I_WIN, I_GQLAT, I_WUQ, I_GKVLAT, I_WUKV, I_GQH, I_GKH,
       I_WA2, I_BA, I_GGLAO, I_WOUT, I_GNC, I_S5ARE, I_S5AIM, I_S5LDT, I_S5BRE, I_S5BIM, I_S5CRE, I_S5CIM, I_S5D, I_WGLU, I_GNMLP, I_WUP, I_WDN, I_GNPLE, I_WGATE, I_WPROJ };
constexpr int NWAVES = 8, NTHR = 512;
constexpr int LDS_BYTES = 163840;
constexpr int RING_BYTES = 131072;
constexpr int MISC_OFF = 163840 - 256;

struct MapId { DI int operator()(int n) const { return n; } };
struct MapZ {
    DI int operator()(int n) const {
        if (n < 640) return n;
        if (n < 1152) return 672 + (n - 640);
        if (n < 1664) return 1184 + (n - 1152);
        if (n < 2176) return 1696 + (n - 1664);
        if (n < 2688) return 2224 + (n - 2176);
        if (n < 2720) return 640 + (n - 2688);
        if (n < 2736) return 2208 + (n - 2720);
        return -1; }
};
struct MapGlu { DI int operator()(int n) const { const int pn = n >> 8, rr = n & 255; return rr < 128 ? 128 * pn + rr : 1024 + 128 * pn + (rr - 128); } };
template <class Map> DI void transpose_item(const float* W, int K, int N, int Nout, bf16* WT, const float* gain, Map map, LAS float* scr, int item, int lane) {
    const int nblk = Nout / 32, kb = item / nblk, nb = item % nblk, k0 = 64 * kb, n0 = 32 * nb;
    const int n4 = (lane & 7) * 4, kr = lane >> 3, ns = map(n0 + n4);
    f32x4 v[8];
#pragma unroll
    for (int i = 0; i < 8; ++i) { const int kk = kr + 8 * i; v[i] = (f32x4){0.f, 0.f, 0.f, 0.f};
        if (ns >= 0) { v[i] = *(const f32x4*)(W + (size_t)(k0 + kk) * N + ns); if (gain) v[i] = v[i] * gain[k0 + kk]; } }
#pragma unroll
    for (int i = 0; i < 8; ++i) { LAS float* d = scr + (kr + 8 * i) * 33 + n4; d[0] = v[i].x; d[1] = v[i].y; d[2] = v[i].z; d[3] = v[i].w; }
    LDS_WAIT(); asm volatile("" ::: "memory");
    const int c = lane & 7;
#pragma unroll
    for (int j = 0; j < 4; ++j) { const int n = (lane >> 3) + 8 * j; const LAS float* s = scr + (8 * c) * 33 + n;
        u32x4 o; o.x = pk2(s[0 * 33], s[1 * 33]); o.y = pk2(s[2 * 33], s[3 * 33]); o.z = pk2(s[4 * 33], s[5 * 33]); o.w = pk2(s[6 * 33], s[7 * 33]);
        *(u32x4*)(WT + (size_t)(n0 + n) * K + k0 + 8 * c) = o; }
    LDS_WAIT(); asm volatile("" ::: "memory");
}

DI void s5_setup_item(const Args& a, LAS unsigned char* lds, int g, int qt, int tid) {
    LAS float* LPr = (LAS float*)lds;
    LAS float* LPi = LPr + 64 * 34;
    LAS float* BBr = LPi + 64 * 34;
    LAS float* BBi = BBr + 64 * 16;
    LAS float* Cr = BBi + 64 * 16;
    LAS float* Ci = Cr + 16 * 64;
    LAS float* KT = Ci + 16 * 64;
    const float* are = (const float*)a.in[I_S5ARE] + g * 64; const float* aim = (const float*)a.in[I_S5AIM] + g * 64;
    const float dt = expf(((const float*)a.in[I_S5LDT])[g]);
    float* tab = (float*)(a.ws + WS_S5TAB);
    __syncthreads();
    for (int i = tid; i < 64 * 17; i += NTHR) { const int p = i / 17, tau = i % 17;
        const float ar = are[p] * dt * (float)tau, ai = aim[p] * dt * (float)tau, mg = expf(ar);
        LPr[p * 34 + tau] = mg * cosf(ai); LPi[p * 34 + tau] = mg * sinf(ai); }
    for (int i = tid; i < 64 * 16; i += NTHR) { const int p = i >> 4, c = i & 15;
        const float ar = are[p], ai = aim[p], mg = expf(ar * dt), lr = mg * cosf(ai * dt), li = mg * sinf(ai * dt), den = ar * ar + ai * ai;
        const float cr = ((lr - 1.0f) * ar + li * ai) / den, ci = (li * ar - (lr - 1.0f) * ai) / den;
        const float br = ((const float*)a.in[I_S5BRE])[((size_t)g * 64 + p) * 16 + c], bi = ((const float*)a.in[I_S5BIM])[((size_t)g * 64 + p) * 16 + c];
        BBr[i] = cr * br - ci * bi; BBi[i] = cr * bi + ci * br;
        const int co = i >> 6, pp = i & 63;
        Cr[i] = ((const float*)a.in[I_S5CRE])[((size_t)g * 16 + co) * 64 + pp]; Ci[i] = ((const float*)a.in[I_S5CIM])[((size_t)g * 16 + co) * 64 + pp]; }
    __syncthreads();
    if (qt == 0) {
        for (int i = tid; i < 64; i += NTHR) { float* L = tab + ((size_t)g * 64 + i) * 2; L[0] = LPr[i * 34 + 1]; L[1] = LPi[i * 34 + 1];
            float* LT = tab + 8192 + ((size_t)g * 64 + i) * 2; LT[0] = LPr[i * 34 + 16]; LT[1] = LPi[i * 34 + 16]; }
        for (int i = tid; i < 1024; i += NTHR) { float* B = tab + 16384 + ((size_t)g * 1024 + i) * 2; B[0] = BBr[i]; B[1] = BBi[i]; }
    }
    if (tid < 256) { const int tau = tid >> 4, co = tid & 15; float acc[16];
#pragma unroll
        for (int j = 0; j < 16; ++j) acc[j] = 0.f;
        for (int p = 0; p < 64; ++p) { const float lr = LPr[p * 34 + tau], li = LPi[p * 34 + tau], cr = Cr[co * 64 + p], ci = Ci[co * 64 + p];
            const float tr = cr * lr - ci * li, ti = cr * li + ci * lr;
#pragma unroll
            for (int q = 0; q < 4; ++q) { const f32x4 br = *(const LAS f32x4*)(BBr + p * 16 + 4 * q), bi = *(const LAS f32x4*)(BBi + p * 16 + 4 * q);
                acc[4 * q + 0] += tr * br.x - ti * bi.x; acc[4 * q + 1] += tr * br.y - ti * bi.y; acc[4 * q + 2] += tr * br.z - ti * bi.z; acc[4 * q + 3] += tr * br.w - ti * bi.w; } }
#pragma unroll
        for (int j = 0; j < 16; ++j) KT[(tau * 16 + co) * 16 + j] = acc[j]; }
    __syncthreads();
    LAS float* LTr = KT + 32 * 256; LAS float* LTi = LTr + 33 * 68;
    for (int i = tid; i < 64 * 17; i += NTHR) { const int p = i & 63, tau = i >> 6; LTr[tau * 68 + p] = LPr[p * 34 + tau]; LTi[tau * 68 + p] = LPi[p * 34 + tau]; }
    __syncthreads();
    bf16* TN = (bf16*)(a.ws + WS_S5TN) + (size_t)g * 256 * S5K;
    for (int i = tid; i < 64 * 48; i += NTHR) { const int row = 64 * qt + i / 48, kg = i % 48, t = row >> 4, co = row & 15; f32x4 v0 = {0.f, 0.f, 0.f, 0.f}, v1 = {0.f, 0.f, 0.f, 0.f};
        if (kg < 32) { const int sidx = kg >> 1, hf = kg & 1; if (sidx <= t) { const LAS f32x4* kp = (const LAS f32x4*)(KT + ((t - sidx) * 16 + co) * 16 + 8 * hf); v0 = kp[0]; v1 = kp[1]; } }
        else { const int p0 = ((kg - 32) & 7) * 8; const bool im = kg >= 40;
            const LAS f32x4* cr4 = (const LAS f32x4*)(Cr + co * 64 + p0); const LAS f32x4* ci4 = (const LAS f32x4*)(Ci + co * 64 + p0);
            const LAS f32x4* lr4 = (const LAS f32x4*)(LTr + (t + 1) * 68 + p0); const LAS f32x4* li4 = (const LAS f32x4*)(LTi + (t + 1) * 68 + p0);
            if (!im) { v0 = cr4[0] * lr4[0] - ci4[0] * li4[0]; v1 = cr4[1] * lr4[1] - ci4[1] * li4[1]; }
            else { v0 = -(cr4[0] * li4[0] + ci4[0] * lr4[0]); v1 = -(cr4[1] * li4[1] + ci4[1] * lr4[1]); } }
        u32x4 o; o.x = pk2(v0.x, v0.y); o.y = pk2(v0.z, v0.w); o.z = pk2(v1.x, v1.y); o.w = pk2(v1.z, v1.w);
        *(u32x4*)(TN + (size_t)row * S5K + kg * 8) = o; }
    bf16* BD = (bf16*)(a.ws + WS_S5BD) + (size_t)(g >> 1) * 256 * (2 * S5K);
    for (int i = tid; i < 32 * 96; i += NTHR) { const int rr = 32 * qt + i / 96, kg = i % 96, reim = rr >> 6, p = rr & 63, row = (g & 1) * 128 + rr; f32x4 v0 = {0.f, 0.f, 0.f, 0.f}, v1 = {0.f, 0.f, 0.f, 0.f};
        const int kgl = kg - (g & 1) * 48;
        if (kgl >= 0 && kgl < 32) { const int t = kgl >> 1, hf = kgl & 1; const float lr = LPr[p * 34 + 15 - t], li = LPi[p * 34 + 15 - t];
            const LAS f32x4* br4 = (const LAS f32x4*)(BBr + p * 16 + 8 * hf); const LAS f32x4* bi4 = (const LAS f32x4*)(BBi + p * 16 + 8 * hf);
            if (reim) { v0 = br4[0] * li + bi4[0] * lr; v1 = br4[1] * li + bi4[1] * lr; } else { v0 = br4[0] * lr - bi4[0] * li; v1 = br4[1] * lr - bi4[1] * li; } }
        u32x4 o; o.x = pk2(v0.x, v0.y); o.y = pk2(v0.z, v0.w); o.z = pk2(v1.x, v1.y); o.w = pk2(v1.z, v1.w);
        *(u32x4*)(BD + (size_t)row * (2 * S5K) + kg * 8) = o; }
}

DI void p0_prologue(const Args& a, LAS unsigned char* lds, int vcu, int G, int tid, int lane, int wave) {
    LAS float* scr = (LAS float*)(lds + wave * 16384);
    const int gw = vcu * NWAVES + wave, NGW = G * NWAVES;
    unsigned char* ws = a.ws;
    constexpr int I_IN = 16 * (ZW / 32), I_UQ = 6 * 24, I_UKV = 2 * 4 * 32, I_OUT = 16 * 32, I_GLU = 16 * 64, I_UP = 16 * 128, I_DN = 64 * 32, I_GATE = 16 * 32, I_PROJ = 4 * 32;
    constexpr int NITEMS = I_IN + I_UQ + I_UKV + I_OUT + I_GLU + 2 * (I_UP + I_DN + I_GATE + I_PROJ);
    for (int it = gw; it < NITEMS; it += NGW) {
        int r = it;
        if (r < I_IN) { transpose_item((const float*)a.in[I_WIN], DM, 2736, ZW, (bf16*)(ws + WS_WIN), (const float*)a.in[I_GNAB], MapZ(), scr, r, lane); continue; } r -= I_IN;
        if (r < I_UQ) { transpose_item((const float*)a.in[I_WUQ], QL, 768, 768, (bf16*)(ws + WS_WUQ), (const float*)a.in[I_GQLAT], MapId(), scr, r, lane); continue; } r -= I_UQ;
        if (r < I_UKV) { if (r < 128) transpose_item((const float*)a.in[I_WUKV], KVL, 1024, 1024, (bf16*)(ws + WS_WUKV), nullptr, MapId(), scr, r, lane);
            else transpose_item((const float*)a.in[I_WUKV], KVL, 1024, 1024, (bf16*)(ws + WS_WUKVG), (const float*)a.in[I_GKVLAT], MapId(), scr, r - 128, lane); continue; } r -= I_UKV;
        if (r < I_OUT) { transpose_item((const float*)a.in[I_WOUT], DM, DM, DM, (bf16*)(ws + WS_WOUT), nullptr, MapId(), scr, r, lane); continue; } r -= I_OUT;
        if (r < I_GLU) { transpose_item((const float*)a.in[I_WGLU], DM, 2048, 2048, (bf16*)(ws + WS_WGLU), nullptr, MapGlu(), scr, r, lane); continue; } r -= I_GLU;
        const int li = r / (I_UP + I_DN + I_GATE + I_PROJ); r -= li * (I_UP + I_DN + I_GATE + I_PROJ);
        if (r < I_UP) { transpose_item((const float*)a.in[I_WUP] + (size_t)li * DM * FF, DM, FF, FF, (bf16*)(ws + WS_WUP) + (size_t)li * FF * DM, (const float*)a.in[I_GNMLP] + li * DM, MapId(), scr, r, lane); continue; } r -= I_UP;
        if (r < I_DN) { transpose_item((const float*)a.in[I_WDN] + (size_t)li * FF * DM, FF, DM, DM, (bf16*)(ws + WS_WDN) + (size_t)li * DM * FF, nullptr, MapId(), scr, r, lane); continue; } r -= I_DN;
        if (r < I_GATE) { transpose_item((const float*)a.in[I_WGATE] + (size_t)li * DM * DM, DM, DM, DM, (bf16*)(ws + WS_WGATE) + (size_t)li * DM * DM, (const float*)a.in[I_GNPLE] + li * DM, MapId(), scr, r, lane); continue; } r -= I_GATE;
        transpose_item((const float*)a.in[I_WPROJ] + (size_t)li * PLE * DM, PLE, DM, DM, (bf16*)(ws + WS_WPROJ) + (size_t)li * DM * PLE, nullptr, MapId(), scr, r, lane);
    }
    float* ss0 = (float*)(ws + WS_SSQ) + MT;
    for (int m0 = gw; m0 < MT; m0 += 4 * NGW) {
        int mr[4]; const f32x4* xr[4]; f32x4 v[4][4];
#pragma unroll
        for (int q = 0; q < 4; ++q) { mr[q] = (m0 + q * NGW < MT) ? m0 + q * NGW : m0;
            xr[q] = (const f32x4*)((mr[q] < MP) ? (const float*)a.in[I_XP] + (size_t)mr[q] * DM : (const float*)a.in[I_XS] + (size_t)(mr[q] - MP) * DM) + lane; }
#pragma unroll
        for (int q = 0; q < 4; ++q)
#pragma unroll
            for (int j = 0; j < 4; ++j) v[q][j] = xr[q][64 * j];
#pragma unroll
        for (int q = 0; q < 4; ++q) { u32x2* o8 = (u32x2*)((bf16*)(ws + WS_XB0) + (size_t)mr[q] * DM) + lane; float s = 0.f;
#pragma unroll
            for (int j = 0; j < 4; ++j) { const f32x4 t = v[q][j]; s += (t.x * t.x + t.y * t.y) + (t.z * t.z + t.w * t.w); u32x2 w; w.x = pk2(t.x, t.y); w.y = pk2(t.z, t.w); o8[64 * j] = w; }
            s = wave_sum(s); if (lane == 0) ss0[mr[q]] = s; }
    }
    { const int gt = vcu * NTHR + tid, NGT = G * NTHR; constexpr int NV = 2 * MT * PLE / 8;
        for (int i0 = gt; i0 < NV; i0 += 4 * NGT) { f32x4 v0[4], v1[4]; int ii[4];
#pragma unroll
            for (int q = 0; q < 4; ++q) { const int i = (i0 + q * NGT < NV) ? i0 + q * NGT : i0; ii[q] = i; const int li = i / (MT * PLE / 8), r = i % (MT * PLE / 8), row = r / (PLE / 8), c8 = r % (PLE / 8);
                const float* src = (row < MP) ? (const float*)a.in[I_PP] + ((size_t)li * MP + row) * PLE : (const float*)a.in[I_PS] + ((size_t)li * MS + (row - MP)) * PLE;
                v0[q] = *(const f32x4*)(src + c8 * 8); v1[q] = *(const f32x4*)(src + c8 * 8 + 4); }
#pragma unroll
            for (int q = 0; q < 4; ++q) { u32x4 o; o.x = pk2(v0[q].x, v0[q].y); o.y = pk2(v0[q].z, v0[q].w); o.z = pk2(v1[q].x, v1[q].y); o.w = pk2(v1[q].z, v1[q].w);
                *(u32x4*)((bf16*)(ws + WS_PB) + (size_t)ii[q] * 8) = o; } } }
    { const int gt = vcu * NTHR + tid, NGT = G * NTHR; float* rc = (float*)(ws + WS_ROPE); float* rs = rc + 8200 * 16;
        for (int i = gt; i < 8200 * 16; i += NGT) { const int pos = i >> 4, k = i & 15; const float fr = powf(10000.0f, -(float)k / 16.0f), ang = (float)pos * fr; rc[i] = cosf(ang); rs[i] = sinf(ang); } }
    for (int it = vcu; it < 256; it += G) s5_setup_item(a, lds, it >> 2, it & 3, tid);
}
constexpr float QSCALE = 0.10206207261596575f * 1.4426950408889634f;
DI u32x4 prep_vec(u32x4 w, int li, int pos, const float* rc, const float* rs, const f32x4& g0, const f32x4& g1, float scale) {
    float x[8] = {bflo(w.x), bfhi(w.x), bflo(w.y), bfhi(w.y), bflo(w.z), bfhi(w.z), bflo(w.w), bfhi(w.w)};
    float ss = ((x[0] * x[0] + x[1] * x[1]) + (x[2] * x[2] + x[3] * x[3])) + ((x[4] * x[4] + x[5] * x[5]) + (x[6] * x[6] + x[7] * x[7]));
    ss = row16_sum(ss);
    const float r = __builtin_amdgcn_rsqf(ss * (1.f / 96.f) + EPS) ;
    float y[8] = {x[0] * r * g0.x, x[1] * r * g0.y, x[2] * r * g0.z, x[3] * r * g0.w, x[4] * r * g1.x, x[5] * r * g1.y, x[6] * r * g1.z, x[7] * r * g1.w};
    float yo[8];
#pragma unroll
    for (int j = 0; j < 8; ++j) yo[j] = __builtin_bit_cast(float, __builtin_amdgcn_update_dpp(0, __builtin_bit_cast(int, y[j]), 0x4E, 0xf, 0xf, false));
    if (li >= 8) { const f32x4 c0 = *(const f32x4*)(rc + pos * 16 + 8 * (li & 1)), c1 = *(const f32x4*)(rc + pos * 16 + 8 * (li & 1) + 4), s0 = *(const f32x4*)(rs + pos * 16 + 8 * (li & 1)), s1 = *(const f32x4*)(rs + pos * 16 + 8 * (li & 1) + 4);
        const float c[8] = {c0.x, c0.y, c0.z, c0.w, c1.x, c1.y, c1.z, c1.w}, sn[8] = {s0.x, s0.y, s0.z, s0.w, s1.x, s1.y, s1.z, s1.w};
#pragma unroll
        for (int j = 0; j < 8; ++j) y[j] = (li < 10) ? (y[j] * c[j] - yo[j] * sn[j]) : (y[j] * c[j] + yo[j] * sn[j]); }
    u32x4 o; o.x = pk2(y[0] * scale, y[1] * scale); o.y = pk2(y[2] * scale, y[3] * scale); o.z = pk2(y[4] * scale, y[5] * scale); o.w = pk2(y[6] * scale, y[7] * scale);
    return o;
}
DI void p4_attn_prep(const Args& a, LAS unsigned char* lds, int vcu, int G, int tid, int lane, int wave) {
    const bf16* QR = (const bf16*)(a.ws + WS_QRAW); const bf16* KV = (const bf16*)(a.ws + WS_KVRAW); const bf16* Z = (const bf16*)(a.ws + WS_Z);
    bf16* QF = (bf16*)(a.ws + WS_QF); bf16* KF = (bf16*)(a.ws + WS_KF);
    const float* rc = (const float*)(a.ws + WS_ROPE); const float* rs = rc + 8200 * 16;
    const float* gqh = (const float*)a.in[I_GQH]; const float* gkh = (const float*)a.in[I_GKH]; const float* gkv = (const float*)a.in[I_GKVLAT];
    const float* ssckv = (const float*)(a.ws + WS_CTL) + CW_SS + 7 * MT; bf16* ckvb = (bf16*)(a.ws + WS_CKVB);
    const int li = lane & 15, gq = lane >> 4, lic = li < 12 ? li : 11;
    const f32x4 gq0 = *(const f32x4*)(gqh + 8 * lic), gq1 = *(const f32x4*)(gqh + 8 * lic + 4), gk0 = *(const f32x4*)(gkh + 8 * lic), gk1 = *(const f32x4*)(gkh + 8 * lic + 4);
    for (int tile = vcu; tile < MP / 64; tile += G) {
        const int row0 = tile * 64;
#pragma unroll 1
        for (int s4 = 0; s4 < 4; ++s4) { u32x4 w[4];
#pragma unroll
            for (int e = 0; e < 4; ++e) { const int idx = (s4 * 4 + e) * 4 + gq, rl = wave * 8 + (idx >> 3), h = idx & 7; const size_t row = (size_t)row0 + rl;
                const bf16* src = li < 8 ? KV + row * 1024 + h * 128 + 8 * li : Z + row * ZW + ZC_KPE + 8 * (lic - 8);
                w[e] = *(const u32x4*)src; if (li >= 12) w[e] = (u32x4){0u, 0u, 0u, 0u}; }
#pragma unroll
            for (int e = 0; e < 4; ++e) { const int idx = (s4 * 4 + e) * 4 + gq, rl = wave * 8 + (idx >> 3), h = idx & 7; const size_t row = (size_t)row0 + rl; const int pos = (int)(row & (SEQ - 1));
                const u32x4 o = prep_vec(w[e], li, pos, rc, rs, gk0, gk1, 1.f);
                if (li < 12) *(u32x4*)(KF + row * 768 + h * 96 + 8 * li) = o; }
        }
#pragma unroll
        for (int rep = 0; rep < 4; ++rep) { const int i8 = tid + NTHR * rep, rl = i8 >> 5, c8 = (i8 & 31) * 8; const size_t row = (size_t)row0 + rl;
            const float r = __builtin_amdgcn_rsqf(ssckv[row] * (1.f / KVL) + EPS); const u32x4 w = *(const u32x4*)(Z + row * ZW + ZC_CKV + c8); const f32x4 g0 = *(const f32x4*)(gkv + c8), g1 = *(const f32x4*)(gkv + c8 + 4);
            float* o = a.out + O_CKVP + row * KVL + c8;
            *(f32x4*)o = (f32x4){bflo(w.x) * r * g0.x, bfhi(w.x) * r * g0.y, bflo(w.y) * r * g0.z, bfhi(w.y) * r * g0.w}; *(f32x4*)(o + 4) = (f32x4){bflo(w.z) * r * g1.x, bfhi(w.z) * r * g1.y, bflo(w.w) * r * g1.z, bfhi(w.w) * r * g1.w}; }
        if (tid < 256) { const int rl = tid >> 2, c8 = (tid & 3) * 8; const size_t row = (size_t)row0 + rl; const u32x4 w = *(const u32x4*)(Z + row * ZW + ZC_KPE + c8); float* o = a.out + O_KPEP + row * ROPE + c8;
            *(f32x4*)o = (f32x4){bflo(w.x), bfhi(w.x), bflo(w.y), bfhi(w.y)}; *(f32x4*)(o + 4) = (f32x4){bflo(w.z), bfhi(w.z), bflo(w.w), bfhi(w.w)}; }
    }
    for (int sr = 2 * vcu; sr < MS; sr += 2 * G) {
        if (wave < 4) { const int idx = wave * 4 + gq, row = MP + sr + (idx >> 3), h = idx & 7; const int pos = PAST + ((row - MP) & 3);
            u32x4 w = *(const u32x4*)(QR + (size_t)row * 768 + h * 96 + 8 * lic); if (li >= 12) w = (u32x4){0u, 0u, 0u, 0u};
            const u32x4 o = prep_vec(w, li, pos, rc, rs, gq0, gq1, QSCALE);
            if (li < 12) *(u32x4*)(QF + (size_t)row * 768 + h * 96 + 8 * li) = o; }
        if (tid < 64) { const int rl = tid >> 5, c8 = (tid & 31) * 8; const size_t srow = (size_t)sr + rl, grow = MP + srow;
            const float rr = __builtin_amdgcn_rsqf(ssckv[grow] * (1.f / KVL) + EPS); const u32x4 w = *(const u32x4*)(Z + grow * ZW + ZC_CKV + c8); const f32x4 g0 = *(const f32x4*)(gkv + c8), g1 = *(const f32x4*)(gkv + c8 + 4);
            const f32x4 v0 = {bflo(w.x) * rr * g0.x, bfhi(w.x) * rr * g0.y, bflo(w.y) * rr * g0.z, bfhi(w.y) * rr * g0.w}, v1 = {bflo(w.z) * rr * g1.x, bfhi(w.z) * rr * g1.y, bflo(w.w) * rr * g1.z, bfhi(w.w) * rr * g1.w};
            float* oo = a.out + O_CKVS + srow * KVL + c8; *(f32x4*)oo = v0; *(f32x4*)(oo + 4) = v1;
            u32x4 ww; ww.x = pk2(v0.x, v0.y); ww.y = pk2(v0.z, v0.w); ww.z = pk2(v1.x, v1.y); ww.w = pk2(v1.z, v1.w); *(u32x4*)(ckvb + grow * KVL + c8) = ww; }
        else if (tid < 72) { const int j = tid - 64, rl = j >> 2, c8 = (j & 3) * 8; const size_t srow = (size_t)sr + rl, grow = MP + srow; const u32x4 w = *(const u32x4*)(Z + grow * ZW + ZC_KPE + c8); float* oo = a.out + O_KPES + srow * ROPE + c8;
            *(f32x4*)oo = (f32x4){bflo(w.x), bfhi(w.x), bflo(w.y), bfhi(w.y)}; *(f32x4*)(oo + 4) = (f32x4){bflo(w.z), bfhi(w.z), bflo(w.w), bfhi(w.w)}; }
    }
}
#define MFMA32(a, b, c) __builtin_amdgcn_mfma_f32_32x32x16_bf16((a), (b), (c), 0, 0, 0)
#define MFMA16(a, b, c) __builtin_amdgcn_mfma_f32_16x16x32_bf16((a), (b), (c), 0, 0, 0)
DI int crow(int r, int hi) { return (r & 3) + 8 * (r >> 2) + 4 * hi; }
DI bf16x8 pack8(const f32x16& x, int s) {
    u32x4 p; p.x = pk2(x[8 * s + 0], x[8 * s + 1]); p.y = pk2(x[8 * s + 2], x[8 * s + 3]); p.z = pk2(x[8 * s + 4], x[8 * s + 5]); p.w = pk2(x[8 * s + 6], x[8 * s + 7]);
    return __builtin_bit_cast(bf16x8, p);
}
DI bf16x8 cat44(u32x2 lo, u32x2 hi) { u32x4 p = {lo.x, lo.y, hi.x, hi.y}; return __builtin_bit_cast(bf16x8, p); }
constexpr float GQS = 0.08838834764831845f;
DI bf16x8 tr_frag(const LAS bf16* base, int stride, int rowA, int rowB, int col0, int lane) {
    const int q = (lane & 15) >> 2, p = lane & 3, blk = (lane >> 4) & 1;
    const LAS bf16* a = base + (rowA + q) * stride + col0 + 16 * blk + 4 * p; const LAS bf16* b = base + (rowB + q) * stride + col0 + 16 * blk + 4 * p;
    const s16x4 lo = __builtin_bit_cast(s16x4, __builtin_amdgcn_ds_read_tr16_b64_v4i16((LAS v4i16_t*)a)), hi = __builtin_bit_cast(s16x4, __builtin_amdgcn_ds_read_tr16_b64_v4i16((LAS v4i16_t*)b));
    return __builtin_shufflevector(lo, hi, 0, 1, 2, 3, 4, 5, 6, 7);
}

DI void gla_a_phase(const Args& a, LAS unsigned char* lds, int vcu, int G, int tid, int lane, int wave) {
    LAS float* bt = (LAS float*)lds;
    LAS bf16* KB = (LAS bf16*)(lds + 32768);
    LAS bf16* VH = (LAS bf16*)(lds + 32768 + 20480);
    LAS float* gas = (LAS float*)(lds + 32768 + 2 * 20480);
    const float* wa2_ = (const float*)a.in[I_WA2]; const float* ba_ = (const float*)a.in[I_BA]; const bf16* Z = (const bf16*)(a.ws + WS_Z);
    float* GU = (float*)(a.ws + WS_GU); float* GDEC = (float*)(a.ws + WS_GDEC);
    const int r32 = lane & 31, h2 = lane >> 5;
    float wcol[16], bias = 0.f; int hcur = -1;
#pragma unroll
    for (int r = 0; r < 16; ++r) wcol[r] = 0.f;
    for (int u = vcu; u < 1024; u += G) {
        const int b = u >> 7, h = (u >> 5) & 3, c = u & 31, row0 = b * SEQ + c * 64;
        __syncthreads();
        if (tid < 128) { const u32x4 w = *(const u32x4*)(Z + (size_t)(row0 + (tid >> 1)) * ZW + ZC_GA + (tid & 1) * 8); LAS f32x4* gd = (LAS f32x4*)(gas + tid * 8);
            gd[0] = (f32x4){bflo(w.x), bfhi(w.x), bflo(w.y), bfhi(w.y)}; gd[1] = (f32x4){bflo(w.z), bfhi(w.z), bflo(w.w), bfhi(w.w)}; }
        __syncthreads();
        { const int dk = tid & 127, sg = tid >> 7; float s = 0.f;
            if (h != hcur) { hcur = h; bias = ba_[h * 128 + dk];
#pragma unroll
                for (int r = 0; r < 16; ++r) wcol[r] = wa2_[r * 512 + h * 128 + dk]; }
#pragma unroll 4
            for (int t = 0; t < 16; ++t) { const LAS f32x4* gp = (const LAS f32x4*)(gas + (sg * 16 + t) * 16); const f32x4 g0 = gp[0], g1 = gp[1], g2 = gp[2], g3 = gp[3];
                float x = bias + ((g0.x * wcol[0] + g0.y * wcol[1]) + (g0.z * wcol[2] + g0.w * wcol[3])) + ((g1.x * wcol[4] + g1.y * wcol[5]) + (g1.z * wcol[6] + g1.w * wcol[7]))
                               + ((g2.x * wcol[8] + g2.y * wcol[9]) + (g2.z * wcol[10] + g2.w * wcol[11])) + ((g3.x * wcol[12] + g3.y * wcol[13]) + (g3.z * wcol[14] + g3.w * wcol[15]));
                s += (fminf(x, 0.f) - __logf(1.f + __expf(-fabsf(x)))) * (1.f / 16.f); bt[(sg * 16 + t) * 128 + dk] = s; }
            __syncthreads();
            float off = 0.f;
#pragma unroll
            for (int q = 0; q < 3; ++q) if (q < sg) off += bt[(q * 16 + 15) * 128 + dk];
            __syncthreads();
#pragma unroll
            for (int t = 0; t < 16; ++t) bt[(sg * 16 + t) * 128 + dk] += off;
            if (sg == 3) GDEC[(size_t)u * 128 + dk] = __expf(s + off); }
        __syncthreads();
#pragma unroll
        for (int rep = 0; rep < 2; ++rep) { const int i8 = tid + NTHR * rep, t = i8 >> 4, d8 = (i8 & 15) * 8; const bf16* zr = Z + (size_t)(row0 + t) * ZW + h * 128 + d8;
            const u32x4 kw = *(const u32x4*)(zr + ZC_GK), vw = *(const u32x4*)(zr + ZC_GV);
            const f32x4 b0 = *(const LAS f32x4*)(bt + t * 128 + d8), b1 = *(const LAS f32x4*)(bt + t * 128 + d8 + 4), B0 = *(const LAS f32x4*)(bt + 63 * 128 + d8), B1 = *(const LAS f32x4*)(bt + 63 * 128 + d8 + 4);
            u32x4 o; o.x = pk2(bflo(kw.x) * __expf(B0.x - b0.x), bfhi(kw.x) * __expf(B0.y - b0.y)); o.y = pk2(bflo(kw.y) * __expf(B0.z - b0.z), bfhi(kw.y) * __expf(B0.w - b0.w));
            o.z = pk2(bflo(kw.z) * __expf(B1.x - b1.x), bfhi(kw.z) * __expf(B1.y - b1.y)); o.w = pk2(bflo(kw.w) * __expf(B1.z - b1.z), bfhi(kw.w) * __expf(B1.w - b1.w));
            *(LAS u32x4*)(KB + t * 160 + d8) = o; *(LAS u32x4*)(VH + t * 160 + d8) = vw; }
        __syncthreads();
        const int dkb = wave >> 1;
#pragma unroll
        for (int e = 0; e < 2; ++e) { const int dvb = 2 * (wave & 1) + e; f32x16 acc = {};
#pragma unroll
            for (int s = 0; s < 4; ++s) { const bf16x8 af = tr_frag(KB, 160, 16 * s + 8 * h2, 16 * s + 8 * h2 + 4, dkb * 32, lane), bfv = tr_frag(VH, 160, 16 * s + 8 * h2, 16 * s + 8 * h2 + 4, dvb * 32, lane);
                acc = MFMA32(af, bfv, acc); }
            float* o = GU + (size_t)u * 16384 + dvb * 32 + r32;
#pragma unroll
            for (int r = 0; r < 16; ++r) o[(size_t)(dkb * 32 + crow(r, h2)) * 128] = acc[r]; }
    }
}

DI void gla_b_phase(const Args& a, int vcu, int G, int tid) {
    const float* GU = (const float*)(a.ws + WS_GU); const float* GDEC = (const float*)(a.ws + WS_GDEC); bf16* GSP = (bf16*)(a.ws + WS_GSP);
    for (int i = vcu * NTHR + tid; i < 32 * 128 * 32; i += G * NTHR) { const int bh = i >> 12, dk = (i >> 5) & 127, dv = (i & 31) * 4;
        f32x4 S = {0.f, 0.f, 0.f, 0.f};
#pragma unroll 4
        for (int c = 0; c < 32; ++c) { const size_t u = (size_t)bh * 32 + c; const f32x4 U = *(const f32x4*)(GU + u * 16384 + dk * 128 + dv); const float d = GDEC[u * 128 + dk];
            u32x2 w; w.x = pk2(S.x, S.y); w.y = pk2(S.z, S.w); *(u32x2*)(GSP + u * 16384 + dk * 128 + dv) = w;
            S = S * d + U; }
        *(f32x4*)(a.out + O_GLAP + (size_t)bh * 16384 + dk * 128 + dv) = S; }
}

DI void gla_c_phase(const Args& a, LAS unsigned char* lds, int vcu, int G, int tid, int lane, int wave) {
    LAS float* bt = (LAS float*)lds;
    LAS bf16* QH = (LAS bf16*)(lds + 32768);
    LAS bf16* KH = (LAS bf16*)(lds + 32768 + 17408);
    LAS bf16* VH = (LAS bf16*)(lds + 32768 + 2 * 17408);
    LAS bf16* SH = (LAS bf16*)(lds + 32768 + 2 * 17408 + 20480);
    LAS float* RS = (LAS float*)(lds + 32768 + 2 * 17408 + 20480 + 40960);
    LAS float* gas = RS + 256;
    const float* wa2_ = (const float*)a.in[I_WA2]; const float* ba_ = (const float*)a.in[I_BA]; const bf16* Z = (const bf16*)(a.ws + WS_Z); const bf16* GSP = (const bf16*)(a.ws + WS_GSP); bf16* MIX = (bf16*)(a.ws + WS_MIX);
    const float* go = (const float*)a.in[I_GGLAO];
    const int r32 = lane & 31, h2 = lane >> 5, dvb = wave >> 1, tb = wave & 1;
    float wcol[16], bias = 0.f; int hcur = -1;
#pragma unroll
    for (int r = 0; r < 16; ++r) wcol[r] = 0.f;
    for (int u = vcu; u < 1024; u += G) {
        const int b = u >> 7, h = (u >> 5) & 3, c = u & 31, row0 = b * SEQ + c * 64;
        __syncthreads();
        if (tid < 128) { const u32x4 w = *(const u32x4*)(Z + (size_t)(row0 + (tid >> 1)) * ZW + ZC_GA + (tid & 1) * 8); LAS f32x4* gd = (LAS f32x4*)(gas + tid * 8);
            gd[0] = (f32x4){bflo(w.x), bfhi(w.x), bflo(w.y), bfhi(w.y)}; gd[1] = (f32x4){bflo(w.z), bfhi(w.z), bflo(w.w), bfhi(w.w)}; }
        __syncthreads();
        { const int dk = tid & 127, sg = tid >> 7; float s = 0.f;
            if (h != hcur) { hcur = h; bias = ba_[h * 128 + dk];
#pragma unroll
                for (int r = 0; r < 16; ++r) wcol[r] = wa2_[r * 512 + h * 128 + dk]; }
#pragma unroll 4
            for (int t = 0; t < 16; ++t) { const LAS f32x4* gp = (const LAS f32x4*)(gas + (sg * 16 + t) * 16); const f32x4 g0 = gp[0], g1 = gp[1], g2 = gp[2], g3 = gp[3];
                float x = bias + ((g0.x * wcol[0] + g0.y * wcol[1]) + (g0.z * wcol[2] + g0.w * wcol[3])) + ((g1.x * wcol[4] + g1.y * wcol[5]) + (g1.z * wcol[6] + g1.w * wcol[7]))
                               + ((g2.x * wcol[8] + g2.y * wcol[9]) + (g2.z * wcol[10] + g2.w * wcol[11])) + ((g3.x * wcol[12] + g3.y * wcol[13]) + (g3.z * wcol[14] + g3.w * wcol[15]));
                s += (fminf(x, 0.f) - __logf(1.f + __expf(-fabsf(x)))) * (1.f / 16.f); bt[(sg * 16 + t) * 128 + dk] = s; }
            __syncthreads();
            float off = 0.f;
#pragma unroll
            for (int q = 0; q < 3; ++q) if (q < sg) off += bt[(q * 16 + 15) * 128 + dk];
            __syncthreads();
#pragma unroll
            for (int t = 0; t < 16; ++t) bt[(sg * 16 + t) * 128 + dk] += off;
        }
        __syncthreads();
#pragma unroll
        for (int rep = 0; rep < 2; ++rep) { const int i8 = tid + NTHR * rep, t = i8 >> 4, d8 = (i8 & 15) * 8; const bf16* zr = Z + (size_t)(row0 + t) * ZW + h * 128 + d8;
            const u32x4 qw = *(const u32x4*)(zr + ZC_GQ), kw = *(const u32x4*)(zr + ZC_GK), vw = *(const u32x4*)(zr + ZC_GV);
            const f32x4 b0 = *(const LAS f32x4*)(bt + t * 128 + d8), b1 = *(const LAS f32x4*)(bt + t * 128 + d8 + 4);
            const float e0 = __expf(b0.x), e1 = __expf(b0.y), e2 = __expf(b0.z), e3 = __expf(b0.w), e4 = __expf(b1.x), e5 = __expf(b1.y), e6 = __expf(b1.z), e7 = __expf(b1.w);
            u32x4 oq, ok;
            oq.x = pk2(bflo(qw.x) * GQS * e0, bfhi(qw.x) * GQS * e1); oq.y = pk2(bflo(qw.y) * GQS * e2, bfhi(qw.y) * GQS * e3); oq.z = pk2(bflo(qw.z) * GQS * e4, bfhi(qw.z) * GQS * e5); oq.w = pk2(bflo(qw.w) * GQS * e6, bfhi(qw.w) * GQS * e7);
            ok.x = pk2(bflo(kw.x) * __builtin_amdgcn_rcpf(e0), bfhi(kw.x) * __builtin_amdgcn_rcpf(e1)); ok.y = pk2(bflo(kw.y) * __builtin_amdgcn_rcpf(e2), bfhi(kw.y) * __builtin_amdgcn_rcpf(e3));
            ok.z = pk2(bflo(kw.z) * __builtin_amdgcn_rcpf(e4), bfhi(kw.z) * __builtin_amdgcn_rcpf(e5)); ok.w = pk2(bflo(kw.w) * __builtin_amdgcn_rcpf(e6), bfhi(kw.w) * __builtin_amdgcn_rcpf(e7));
            *(LAS u32x4*)(QH + t * 136 + d8) = oq; *(LAS u32x4*)(KH + t * 136 + d8) = ok; *(LAS u32x4*)(VH + t * 160 + d8) = vw; }
#pragma unroll
        for (int rep = 0; rep < 4; ++rep) { const int i8 = tid + NTHR * rep, dk = i8 >> 4, d8 = (i8 & 15) * 8; *(LAS u32x4*)(SH + dk * 160 + d8) = *(const u32x4*)(GSP + (size_t)u * 16384 + dk * 128 + d8); }
        __syncthreads();
        f32x16 o = {};
#pragma unroll
        for (int sb = 0; sb < 2; ++sb) {
            if (sb > tb) continue;
            f32x16 p = {};
#pragma unroll
            for (int k = 0; k < 8; ++k) { const bf16x8 af = *(const LAS bf16x8*)(KH + (sb * 32 + r32) * 136 + 16 * k + 8 * h2), bq = *(const LAS bf16x8*)(QH + (tb * 32 + r32) * 136 + 16 * k + 8 * h2);
                p = MFMA32(af, bq, p); }
            if (sb == tb) {
#pragma unroll
                for (int r = 0; r < 16; ++r) if (crow(r, h2) > r32) p[r] = 0.f; }
#pragma unroll
            for (int sub = 0; sub < 2; ++sub) { const int s4 = sb * 2 + sub; const bf16x8 pf = pack8(p, sub);
                o = MFMA32(tr_frag(VH, 160, 16 * s4 + 4 * h2, 16 * s4 + 8 + 4 * h2, dvb * 32, lane), pf, o); }
        }
#pragma unroll
        for (int k = 0; k < 8; ++k) { const bf16x8 af = tr_frag(SH, 160, 16 * k + 8 * h2, 16 * k + 8 * h2 + 4, dvb * 32, lane), bq = *(const LAS bf16x8*)(QH + (tb * 32 + r32) * 136 + 16 * k + 8 * h2);
            o = MFMA32(af, bq, o); }
        float ss = 0.f;
#pragma unroll
        for (int r = 0; r < 16; ++r) ss += o[r] * o[r];
        ss += __shfl_xor(ss, 32);
        if (h2 == 0) RS[dvb * 64 + tb * 32 + r32] = ss;
        __syncthreads();
        const int t = tb * 32 + r32; const float tot = (RS[t] + RS[64 + t]) + (RS[128 + t] + RS[192 + t]);
        const float rn = __builtin_amdgcn_rsqf(tot * (1.f / 128.f) + EPS);
        const size_t row = (size_t)row0 + t;
#pragma unroll
        for (int q = 0; q < 4; ++q) { const int dv = dvb * 32 + 8 * q + 4 * h2; const f32x4 g4 = *(const f32x4*)(go + dv);
            const u32x2 gw = *(const u32x2*)(Z + row * ZW + ZC_GR + h * 128 + dv); const float g0 = bflo(gw.x), g1 = bfhi(gw.x), g2 = bflo(gw.y), g3 = bfhi(gw.y);
            const float v0 = o[4 * q + 0] * rn * g4.x * g0 * sigmoidf_(g0), v1 = o[4 * q + 1] * rn * g4.y * g1 * sigmoidf_(g1), v2 = o[4 * q + 2] * rn * g4.z * g2 * sigmoidf_(g2), v3 = o[4 * q + 3] * rn * g4.w * g3 * sigmoidf_(g3);
            u32x2 w; w.x = pk2(v0, v1); w.y = pk2(v2, v3); *(u32x2*)(MIX + row * DM + 512 + h * 128 + dv) = w; }
    }
}

DI void gla_sample_phase(const Args& a, LAS unsigned char* lds, int vcu, int G, int tid, int lane, int wave) {
    LAS float* qt = (LAS float*)lds;
    LAS float* kh = qt + 512;
    LAS float* kb = kh + 512;
    LAS float* vs = kb + 512;
    LAS float* dec = vs + 512;
    LAS float* att = dec + 128;
    LAS float* red = att + 16;
    LAS float* rsum = red + 2048;
    const float* wa2_ = (const float*)a.in[I_WA2]; const float* ba_ = (const float*)a.in[I_BA]; const bf16* Z = (const bf16*)(a.ws + WS_Z); bf16* MIX = (bf16*)(a.ws + WS_MIX);
    const float* S0 = (const float*)a.in[I_SGLA]; const float* go = (const float*)a.in[I_GGLAO];
    for (int it = vcu; it < DB * GH; it += G) { const int bd = it >> 2, h = it & 3; const size_t row0 = (size_t)MP + bd * 4;
        __syncthreads();
        if (tid < 128) { float bs[4], s = 0.f;
#pragma unroll
            for (int t = 0; t < 4; ++t) { float x = ba_[h * 128 + tid];
#pragma unroll
                for (int r = 0; r < 16; ++r) x += bf2f(Z[(row0 + t) * ZW + ZC_GA + r]) * wa2_[r * 512 + h * 128 + tid];
                s += (fminf(x, 0.f) - __logf(1.f + __expf(-fabsf(x)))) * (1.f / 16.f); bs[t] = s; }
            dec[tid] = __expf(s);
#pragma unroll
            for (int t = 0; t < 4; ++t) { const bf16* zr = Z + (row0 + t) * ZW + h * 128 + tid; const float q = bf2f(zr[ZC_GQ]) * GQS, k = bf2f(zr[ZC_GK]);
                qt[t * 128 + tid] = q * __expf(bs[t]); kh[t * 128 + tid] = k * __expf(-bs[t]); kb[t * 128 + tid] = k * __expf(s - bs[t]); } }
        else if (tid < 256) { const int d = tid - 128;
#pragma unroll
            for (int t = 0; t < 4; ++t) vs[t * 128 + d] = bf2f(Z[(row0 + t) * ZW + ZC_GV + h * 128 + d]); }
        __syncthreads();
#pragma unroll
        for (int e = 0; e < 2; ++e) { const int pr = wave * 2 + e, t = pr >> 2, s = pr & 3;
            float x = qt[t * 128 + lane] * kh[s * 128 + lane] + qt[t * 128 + 64 + lane] * kh[s * 128 + 64 + lane]; x = wave_sum(x);
            if (lane == 0) att[pr] = (s <= t) ? x : 0.f; }
        { const int part = tid >> 7, dv = tid & 127; float op[4] = {0.f, 0.f, 0.f, 0.f};
            const float v0 = vs[dv], v1 = vs[128 + dv], v2 = vs[256 + dv], v3 = vs[384 + dv];
            const float* sp = S0 + ((size_t)bd * 4 + h) * 16384 + dv; float* so = a.out + O_GLAS + ((size_t)bd * 4 + h) * 16384 + dv;
#pragma unroll 4
            for (int j = 0; j < 32; ++j) { const int dk = part * 32 + j; const float s0 = sp[(size_t)dk * 128];
                op[0] += qt[dk] * s0; op[1] += qt[128 + dk] * s0; op[2] += qt[256 + dk] * s0; op[3] += qt[384 + dk] * s0;
                so[(size_t)dk * 128] = dec[dk] * s0 + ((kb[dk] * v0 + kb[128 + dk] * v1) + (kb[256 + dk] * v2 + kb[384 + dk] * v3)); }
#pragma unroll
            for (int t = 0; t < 4; ++t) red[(part * 4 + t) * 128 + dv] = op[t]; }
        __syncthreads();
        { const int t = tid >> 7, dv = tid & 127; float o = (red[(0 * 4 + t) * 128 + dv] + red[(1 * 4 + t) * 128 + dv]) + (red[(2 * 4 + t) * 128 + dv] + red[(3 * 4 + t) * 128 + dv]);
#pragma unroll
            for (int s = 0; s < 4; ++s) o += att[t * 4 + s] * vs[s * 128 + dv];
            float ss = wave_sum(o * o); if (lane == 0) rsum[wave] = ss;
            __syncthreads();
            const float tot = rsum[2 * t] + rsum[2 * t + 1]; const float rn = __builtin_amdgcn_rsqf(tot * (1.f / 128.f) + EPS);
            const float g = bf2f(Z[(row0 + t) * ZW + ZC_GR + h * 128 + dv]);
            MIX[(row0 + t) * DM + 512 + h * 128 + dv] = (bf16)f2bf(o * rn * go[dv] * g * sigmoidf_(g)); }
    }
}
namespace sk {
DI void glds16(const void* gsrc, unsigned lds_dst) { unsigned keep;
    asm volatile("s_mov_b32 %0, m0\n\ts_mov_b32 m0, %2\n\ts_nop 0\n\tglobal_load_lds_dwordx4 %1, off\n\ts_mov_b32 m0, %0" : "=&s"(keep) : "v"(gsrc), "s"(lds_dst) : "memory"); }
struct BMapLin { DI int operator()(int tn, int rr) const { return tn * 32 + rr; } };
struct BMapGlu { DI int operator()(int tn, int rr) const { const int c0 = tn * 16, r0 = (c0 >> 7) * 256 + (c0 & 127); return rr < 16 ? r0 + rr : r0 + 128 + (rr - 16); } };
constexpr int SLOT = 24576, ABYTES = 16384;
template <class Epi, class BMap>
DI void skinny_gemm(LAS unsigned char* lds, const bf16* A, int lda, const bf16* Bt, int ldb, int K, int ntn, const Epi& E, const BMap& bmap, int cu, int G, int tid, int lane, int wave) {
    const unsigned lds0 = (unsigned)(uintptr_t)lds;
    const int mi = wave & 3, ni = wave >> 2, fr = lane & 15, fq = lane >> 4;
    const int S = K / 128, ntiles = 8 * ntn;
    const int drow = lane >> 4, dpc = lane & 15;
    for (int t = cu; t < ntiles; t += G) { const int tm = t & 7, tn = t >> 3;
        const int ar0 = 8 * wave + drow, ar1 = ar0 + 4, br = 4 * wave + drow;
        const bf16* pa0 = A + (size_t)(tm * 64 + ar0) * lda + ((dpc ^ (ar0 & 15)) * 8);
        const bf16* pa1 = A + (size_t)(tm * 64 + ar1) * lda + ((dpc ^ (ar1 & 15)) * 8);
        const bf16* pb = Bt + (size_t)bmap(tn, br) * ldb + ((dpc ^ (br & 15)) * 8);
        const unsigned da0 = lds0 + (8 * wave) * 256, da1 = da0 + 1024, db = lds0 + ABYTES + (4 * wave) * 256;
#define SK_ISSUE(s_) do { const unsigned so_ = (unsigned)((s_) & 3) * SLOT; const int ko_ = (s_) * 128; \
        glds16(pa0 + ko_, (unsigned)__builtin_amdgcn_readfirstlane(da0 + so_)); glds16(pa1 + ko_, (unsigned)__builtin_amdgcn_readfirstlane(da1 + so_)); glds16(pb + ko_, (unsigned)__builtin_amdgcn_readfirstlane(db + so_)); } while (0)
        asm volatile("s_waitcnt vmcnt(0) lgkmcnt(0)\n\ts_barrier" ::: "memory");
        SK_ISSUE(0); if (S > 1) SK_ISSUE(1); if (S > 2) SK_ISSUE(2);
        f32x4 acc = {0.f, 0.f, 0.f, 0.f}, acc1 = {0.f, 0.f, 0.f, 0.f};
#pragma unroll 1
        for (int s = 0; s < S; ++s) {
            const int ahead = (S - 1 - s) < 2 ? (S - 1 - s) : 2;
            if (ahead == 2) asm volatile("s_waitcnt vmcnt(6)\n\ts_barrier" ::: "memory");
            else if (ahead == 1) asm volatile("s_waitcnt vmcnt(3)\n\ts_barrier" ::: "memory");
            else asm volatile("s_waitcnt vmcnt(0)\n\ts_barrier" ::: "memory");
            if (s + 3 < S) SK_ISSUE(s + 3);
            const LAS unsigned char* sa = lds + (s & 3) * SLOT + (16 * mi + fr) * 256; const LAS unsigned char* sb = lds + (s & 3) * SLOT + ABYTES + (16 * ni + fr) * 256;
#pragma unroll
            for (int ks = 0; ks < 4; ++ks) { const int pc = (4 * ks + fq) ^ fr;
                const bf16x8 af = *(const LAS bf16x8*)(sa + pc * 16), bfv = *(const LAS bf16x8*)(sb + pc * 16);
                if (ks & 1) acc1 = MFMA16(bfv, af, acc1); else acc = MFMA16(bfv, af, acc); }
            asm volatile("s_waitcnt lgkmcnt(0)" ::: "memory");
        }
        acc = acc + acc1;
        E(lds, tm * 64 + 16 * mi + fr, tn, ni, fq, acc, tid);
#undef SK_ISSUE
    }
}
template <class Epi>
DI void skinny_gemm4(LAS unsigned char* lds, const bf16* A, int lda, const bf16* Bt, int ldb, int K, int ntn, const Epi& E, int cu, int G, int tid, int lane, int wave) {
    const unsigned lds0 = (unsigned)(uintptr_t)lds;
    const int mi = wave & 3, ni = wave >> 2, fr = lane & 15, fq = lane >> 4;
    const int S = K / 64, ntiles = 8 * ntn;
    const int drow = lane >> 3, dpc = lane & 7;
    for (int t = cu; t < ntiles; t += G) { const int tm = t & 7, tn = t >> 3;
        const int ar = 8 * wave + drow, br0 = 16 * wave + drow, br1 = br0 + 8;
        const bf16* pa = A + (size_t)(tm * 64 + ar) * lda + ((dpc ^ (ar & 7)) * 8);
        const bf16* pb0 = Bt + (size_t)(tn * 128 + br0) * ldb + ((dpc ^ (br0 & 7)) * 8);
        const bf16* pb1 = Bt + (size_t)(tn * 128 + br1) * ldb + ((dpc ^ (br1 & 7)) * 8);
        const unsigned da = lds0 + (8 * wave) * 128, db0 = lds0 + 8192 + (16 * wave) * 128, db1 = db0 + 1024;
#define SK4_ISSUE(s_) do { const unsigned so_ = (unsigned)((s_) & 3) * SLOT; const int ko_ = (s_) * 64; \
        glds16(pa + ko_, (unsigned)__builtin_amdgcn_readfirstlane(da + so_)); glds16(pb0 + ko_, (unsigned)__builtin_amdgcn_readfirstlane(db0 + so_)); glds16(pb1 + ko_, (unsigned)__builtin_amdgcn_readfirstlane(db1 + so_)); } while (0)
        asm volatile("s_waitcnt vmcnt(0) lgkmcnt(0)\n\ts_barrier" ::: "memory");
        SK4_ISSUE(0); if (S > 1) SK4_ISSUE(1); if (S > 2) SK4_ISSUE(2);
        f32x4 acc[4] = {};
#pragma unroll 1
        for (int s = 0; s < S; ++s) {
            const int ahead = (S - 1 - s) < 2 ? (S - 1 - s) : 2;
            if (ahead == 2) asm volatile("s_waitcnt vmcnt(6)\n\ts_barrier" ::: "memory");
            else if (ahead == 1) asm volatile("s_waitcnt vmcnt(3)\n\ts_barrier" ::: "memory");
            else asm volatile("s_waitcnt vmcnt(0)\n\ts_barrier" ::: "memory");
            if (s + 3 < S) SK4_ISSUE(s + 3);
            const LAS unsigned char* sa = lds + (s & 3) * SLOT + (16 * mi + fr) * 128; const LAS unsigned char* sb = lds + (s & 3) * SLOT + 8192 + (64 * ni + fr) * 128;
#pragma unroll
            for (int ks = 0; ks < 2; ++ks) { const int pc = (4 * ks + fq) ^ (fr & 7);
                const bf16x8 af = *(const LAS bf16x8*)(sa + pc * 16);
#pragma unroll
                for (int b = 0; b < 4; ++b) { const bf16x8 bfv = *(const LAS bf16x8*)(sb + b * 2048 + pc * 16); acc[b] = MFMA16(bfv, af, acc[b]); } }
            asm volatile("s_waitcnt lgkmcnt(0)" ::: "memory");
        }
#pragma unroll
        for (int b = 0; b < 4; ++b) E.at(tm * 64 + 16 * mi + fr, tn * 128 + 64 * ni + 16 * b + 4 * fq, fq, acc[b]);
#undef SK4_ISSUE
    }
}
template <int MODE> struct SkBf16 {
    bf16* O; int ldc; const float* ss; float ssdiv;
    DI void operator()(LAS unsigned char*, int row, int tn, int ni, int fq, f32x4 v, int) const {
        const int grow = MP + row, col = tn * 32 + 16 * ni + 4 * fq; float r = 1.f; if (ss) r = __builtin_amdgcn_rsqf(ss[grow] * ssdiv + EPS);
        v = v * r;
        if (MODE == 1) {
#pragma unroll
            for (int j = 0; j < 4; ++j) { const float a = fmaxf(v[j], 0.f); v[j] = a * a; } }
        u32x2 w; w.x = pk2(v[0], v[1]); w.y = pk2(v[2], v[3]); *(u32x2*)(O + (size_t)grow * ldc + col) = w;
    }
    DI void at(int row, int col, int fq, f32x4 v) const {
        const int grow = MP + row; float r = 1.f; if (ss) r = __builtin_amdgcn_rsqf(ss[grow] * ssdiv + EPS);
        v = v * r;
        if (MODE == 1) {
#pragma unroll
            for (int j = 0; j < 4; ++j) { const float a = fmaxf(v[j], 0.f); v[j] = a * a; } }
        u32x2 w; w.x = pk2(v[0], v[1]); w.y = pk2(v[2], v[3]); *(u32x2*)(O + (size_t)grow * ldc + col) = w; (void)fq;
    }
};
struct SkZ {
    bf16* O; const float* ss; float* ssq;
    DI void operator()(LAS unsigned char*, int row, int tn, int ni, int fq, f32x4 v, int) const {
        const int grow = MP + row, col = tn * 32 + 16 * ni + 4 * fq; const float r = __builtin_amdgcn_rsqf(ss[grow] * (1.f / DM) + EPS);
        v = v * r;
        u32x2 w; w.x = pk2(v[0], v[1]); w.y = pk2(v[2], v[3]); *(u32x2*)(O + (size_t)grow * ZW + col) = w;
        const int blk = tn >> 2;
        if (blk < 5) { float s = (v[0] * v[0] + v[1] * v[1]) + (v[2] * v[2] + v[3] * v[3]); s += __shfl_xor(s, 16); s += __shfl_xor(s, 32); if (fq == 0) atomicAdd(ssq + (blk < 3 ? 0 : MT) + grow, s); }
    }
    DI void at(int row, int col, int fq, f32x4 v) const {
        const int grow = MP + row; const float r = __builtin_amdgcn_rsqf(ss[grow] * (1.f / DM) + EPS);
        v = v * r;
        u32x2 w; w.x = pk2(v[0], v[1]); w.y = pk2(v[2], v[3]); *(u32x2*)(O + (size_t)grow * ZW + col) = w;
        const int blk = col >> 7;
        if (blk < 5) { float s = (v[0] * v[0] + v[1] * v[1]) + (v[2] * v[2] + v[3] * v[3]); s += __shfl_xor(s, 16); s += __shfl_xor(s, 32); if (fq == 0) atomicAdd(ssq + (blk < 3 ? 0 : MT) + grow, s); }
    }
};
template <int MODE> struct SkRes {
    const float* basef; const bf16* baseb; float* H; bf16* XB; float* ssout; const float* ssin; const bf16* PP;
    DI void operator()(LAS unsigned char*, int row, int tn, int ni, int fq, f32x4 v, int) const {
        const int grow = MP + row, col = tn * 32 + 16 * ni + 4 * fq;
        if (MODE == 1) { const float r = __builtin_amdgcn_rsqf(ssin[grow] * (1.f / DM) + EPS); const u32x2 pw = *(const u32x2*)(PP + (size_t)grow * DM + col);
            v[0] = sigmoidf_(v[0] * r) * bflo(pw.x); v[1] = sigmoidf_(v[1] * r) * bfhi(pw.x); v[2] = sigmoidf_(v[2] * r) * bflo(pw.y); v[3] = sigmoidf_(v[3] * r) * bfhi(pw.y); }
        f32x4 h;
        if (baseb) { const u32x2 bw = *(const u32x2*)(baseb + (size_t)grow * DM + col); h = (f32x4){bflo(bw.x), bfhi(bw.x), bflo(bw.y), bfhi(bw.y)} + v; }
        else h = *(const f32x4*)(basef + (size_t)row * DM + col) + v;
        if (H) *(f32x4*)(H + (size_t)grow * DM + col) = h;
        if (XB) { u32x2 w; w.x = pk2(h[0], h[1]); w.y = pk2(h[2], h[3]); *(u32x2*)(XB + (size_t)grow * DM + col) = w; }
        if (ssout) { float s = (h[0] * h[0] + h[1] * h[1]) + (h[2] * h[2] + h[3] * h[3]); s += __shfl_xor(s, 16); s += __shfl_xor(s, 32); if (fq == 0) atomicAdd(ssout + grow, s); }
    }
};
struct SkGlu {
    const bf16* baseb; bf16* XB; float* ssout;
    DI void operator()(LAS unsigned char* lds, int row, int tn, int ni, int fq, f32x4 v, int tid) const {
        LAS f32x4* X = (LAS f32x4*)(lds + 4 * SLOT);
        const int lr = row & 63;
        if (ni == 1) X[lr * 4 + fq] = v;
        asm volatile("s_waitcnt lgkmcnt(0)\n\ts_barrier" ::: "memory");
        if (ni == 0) { const f32x4 gt = X[lr * 4 + fq]; const int grow = MP + row, col = tn * 16 + 4 * fq;
            const u32x2 bw = *(const u32x2*)(baseb + (size_t)grow * DM + col); f32x4 h = {bflo(bw.x), bfhi(bw.x), bflo(bw.y), bfhi(bw.y)};
#pragma unroll
            for (int j = 0; j < 4; ++j) h[j] += v[j] * sigmoidf_(gt[j]);
            u32x2 w; w.x = pk2(h[0], h[1]); w.y = pk2(h[2], h[3]); *(u32x2*)(XB + (size_t)grow * DM + col) = w;
            float s = (h[0] * h[0] + h[1] * h[1]) + (h[2] * h[2] + h[3] * h[3]); s += __shfl_xor(s, 16); s += __shfl_xor(s, 32); if (fq == 0) atomicAdd(ssout + grow, s); }
    }
};
}
DI float score_bound(const Args& a, int lane) {
    const float* gq = (const float*)a.in[I_GQH]; const float* gk = (const float*)a.in[I_GKH];
    float mq = fmaxf(fabsf(gq[lane]), (lane < 32) ? fabsf(gq[64 + lane]) : 0.f), mk = fmaxf(fabsf(gk[lane]), (lane < 32) ? fabsf(gk[64 + lane]) : 0.f);
#pragma unroll
    for (int o = 1; o < 64; o <<= 1) { mq = fmaxf(mq, __shfl_xor(mq, o)); mk = fmaxf(mk, __shfl_xor(mk, o)); }
    return 96.f * QSCALE * mq * mk;
}
DI void attn_prompt_unit(const Args& a, LAS unsigned char* lds, int b, int h, int qb, float cB, int tid, int lane, int wave) {
    const bf16* KF = (const bf16*)(a.ws + WS_KF); const bf16* KVR = (const bf16*)(a.ws + WS_KVRAW); bf16* MIX = (bf16*)(a.ws + WS_MIX);
    LAS bf16* Ks = (LAS bf16*)lds;
    LAS bf16* Vs = (LAS bf16*)(lds + 26624);
    const int r32 = lane & 31, h2 = lane >> 5;
    const int qloc = qb * 256 + wave * 32 + r32;
    const size_t qrow = (size_t)b * SEQ + qloc;
    bf16x8 qf[6];
    { const bf16* QR = (const bf16*)(a.ws + WS_QRAW); const float* gq = (const float*)a.in[I_GQH]; const float* rc = (const float*)(a.ws + WS_ROPE); const float* rs = rc + 8200 * 16;
        u32x4 wq[6]; float ss = 0.f;
#pragma unroll
        for (int s = 0; s < 6; ++s) { wq[s] = *(const u32x4*)(QR + qrow * 768 + h * 96 + 16 * s + 8 * h2);
            const float e0 = bflo(wq[s].x), e1 = bfhi(wq[s].x), e2 = bflo(wq[s].y), e3 = bfhi(wq[s].y), e4 = bflo(wq[s].z), e5 = bfhi(wq[s].z), e6 = bflo(wq[s].w), e7 = bfhi(wq[s].w);
            ss += ((e0 * e0 + e1 * e1) + (e2 * e2 + e3 * e3)) + ((e4 * e4 + e5 * e5) + (e6 * e6 + e7 * e7)); }
        ss += __shfl_xor(ss, 32);
        const float r = __builtin_amdgcn_rsqf(ss * (1.f / 96.f) + EPS) * QSCALE;
#pragma unroll
        for (int s = 0; s < 4; ++s) { const f32x4 g0 = *(const f32x4*)(gq + 16 * s + 8 * h2) * r, g1 = *(const f32x4*)(gq + 16 * s + 8 * h2 + 4) * r;
            u32x4 o; o.x = pk2(bflo(wq[s].x) * g0.x, bfhi(wq[s].x) * g0.y); o.y = pk2(bflo(wq[s].y) * g0.z, bfhi(wq[s].y) * g0.w); o.z = pk2(bflo(wq[s].z) * g1.x, bfhi(wq[s].z) * g1.y); o.w = pk2(bflo(wq[s].w) * g1.z, bfhi(wq[s].w) * g1.w);
            qf[s] = __builtin_bit_cast(bf16x8, o); }
        { const f32x4 ga0 = *(const f32x4*)(gq + 64 + 8 * h2) * r, ga1 = *(const f32x4*)(gq + 64 + 8 * h2 + 4) * r, gb0 = *(const f32x4*)(gq + 80 + 8 * h2) * r, gb1 = *(const f32x4*)(gq + 80 + 8 * h2 + 4) * r;
            const f32x4 c0 = *(const f32x4*)(rc + qloc * 16 + 8 * h2), c1 = *(const f32x4*)(rc + qloc * 16 + 8 * h2 + 4), s0 = *(const f32x4*)(rs + qloc * 16 + 8 * h2), s1 = *(const f32x4*)(rs + qloc * 16 + 8 * h2 + 4);
            const f32x4 xa0 = (f32x4){bflo(wq[4].x), bfhi(wq[4].x), bflo(wq[4].y), bfhi(wq[4].y)} * ga0, xa1 = (f32x4){bflo(wq[4].z), bfhi(wq[4].z), bflo(wq[4].w), bfhi(wq[4].w)} * ga1;
            const f32x4 xb0 = (f32x4){bflo(wq[5].x), bfhi(wq[5].x), bflo(wq[5].y), bfhi(wq[5].y)} * gb0, xb1 = (f32x4){bflo(wq[5].z), bfhi(wq[5].z), bflo(wq[5].w), bfhi(wq[5].w)} * gb1;
            const f32x4 ra0 = xa0 * c0 - xb0 * s0, ra1 = xa1 * c1 - xb1 * s1, rb0 = xb0 * c0 + xa0 * s0, rb1 = xb1 * c1 + xa1 * s1;
            u32x4 o4, o5; o4.x = pk2(ra0.x, ra0.y); o4.y = pk2(ra0.z, ra0.w); o4.z = pk2(ra1.x, ra1.y); o4.w = pk2(ra1.z, ra1.w); o5.x = pk2(rb0.x, rb0.y); o5.y = pk2(rb0.z, rb0.w); o5.z = pk2(rb1.x, rb1.y); o5.w = pk2(rb1.z, rb1.w);
            qf[4] = __builtin_bit_cast(bf16x8, o4); qf[5] = __builtin_bit_cast(bf16x8, o5); } }
    const int NT = 4 * (qb + 1);
    const int kr0 = tid / 12, kp0 = tid % 12, kr1 = (tid + 512) / 12, kp1 = (tid + 512) % 12; const bool k1 = tid < 256;
    const bf16* kbase = KF + ((size_t)b * SEQ) * 768 + h * 96;
    const bf16* vbase = KVR + ((size_t)b * SEQ + (tid >> 3)) * 1024 + h * 128 + 64 + (tid & 7) * 8;
    u32x4 kst0, kst1 = {0u, 0u, 0u, 0u}, vst;
    kst0 = *(const u32x4*)(kbase + (size_t)kr0 * 768 + kp0 * 8); if (k1) kst1 = *(const u32x4*)(kbase + (size_t)kr1 * 768 + kp1 * 8); vst = *(const u32x4*)(vbase);
    __syncthreads();
    *(LAS u32x4*)(Ks + kr0 * 104 + kp0 * 8) = kst0; if (k1) *(LAS u32x4*)(Ks + kr1 * 104 + kp1 * 8) = kst1;
    *(LAS u32x4*)(Vs + (tid >> 3) * 96 + (tid & 7) * 8) = vst;
    __syncthreads();
    f32x16 o0 = {}, o1 = {}; float lsum = 0.f;
    const int qmax_w = qb * 256 + wave * 32 + 31;
    for (int t = 0; t < NT; ++t) {
        const int buf = t & 1;
        if (t + 1 < NT) { const size_t kv1 = (size_t)(t + 1) * 64;
            kst0 = *(const u32x4*)(kbase + (kv1 + kr0) * 768 + kp0 * 8); if (k1) kst1 = *(const u32x4*)(kbase + (kv1 + kr1) * 768 + kp1 * 8); vst = *(const u32x4*)(vbase + kv1 * 1024); }
        if (t * 64 <= qmax_w) {
            const LAS bf16* Kb = Ks + buf * 6656; const LAS bf16* Vb = Vs + buf * 6144;
            f32x16 p0, p1;
#pragma unroll
            for (int r = 0; r < 16; ++r) { p0[r] = -cB; p1[r] = -cB; }
#pragma unroll
            for (int s = 0; s < 6; ++s) { const bf16x8 k0 = *(const LAS bf16x8*)(Kb + r32 * 104 + 16 * s + 8 * h2), k1f = *(const LAS bf16x8*)(Kb + (32 + r32) * 104 + 16 * s + 8 * h2);
                p0 = MFMA32(k0, qf[s], p0); p1 = MFMA32(k1f, qf[s], p1); }
            const bool diag = (t * 64 + 63 > qb * 256 + wave * 32);
#pragma unroll
            for (int r = 0; r < 16; ++r) { const int kv = t * 64 + crow(r, h2);
                float e0 = __builtin_amdgcn_exp2f(p0[r]), e1 = __builtin_amdgcn_exp2f(p1[r]);
                if (diag) { if (kv > qloc) e0 = 0.f; if (kv + 32 > qloc) e1 = 0.f; }
                p0[r] = e0; p1[r] = e1; lsum += e0 + e1; }
#pragma unroll
            for (int s4 = 0; s4 < 4; ++s4) { const bf16x8 pf = (s4 < 2) ? pack8(p0, s4 & 1) : pack8(p1, s4 & 1);
                o0 = MFMA32(tr_frag(Vb, 96, 16 * s4 + 4 * h2, 16 * s4 + 8 + 4 * h2, 0, lane), pf, o0); o1 = MFMA32(tr_frag(Vb, 96, 16 * s4 + 4 * h2, 16 * s4 + 8 + 4 * h2, 32, lane), pf, o1); }
        }
        if (t + 1 < NT) { LAS bf16* Kn = Ks + (buf ^ 1) * 6656; LAS bf16* Vn = Vs + (buf ^ 1) * 6144;
            *(LAS u32x4*)(Kn + kr0 * 104 + kp0 * 8) = kst0; if (k1) *(LAS u32x4*)(Kn + kr1 * 104 + kp1 * 8) = kst1;
            *(LAS u32x4*)(Vn + (tid >> 3) * 96 + (tid & 7) * 8) = vst; }
        __syncthreads();
    }
    lsum += __shfl_xor(lsum, 32);
    const float inv = 1.f / lsum;
    bf16* op = MIX + qrow * DM + h * 64;
#pragma unroll
    for (int q = 0; q < 4; ++q) { const int dv = 8 * q + 4 * h2;
        u32x2 w0, w1; w0.x = pk2(o0[4 * q] * inv, o0[4 * q + 1] * inv); w0.y = pk2(o0[4 * q + 2] * inv, o0[4 * q + 3] * inv);
        w1.x = pk2(o1[4 * q] * inv, o1[4 * q + 1] * inv); w1.y = pk2(o1[4 * q + 2] * inv, o1[4 * q + 3] * inv);
        *(u32x2*)(op + dv) = w0; *(u32x2*)(op + 32 + dv) = w1; }
}
DI void attn_prompt_phase(const Args& a, LAS unsigned char* lds, int vcu, int G, int tid, int lane, int wave) {
    const float cB = score_bound(a, lane);
    for (int pi = vcu; pi < 256; pi += G) { const int bh = pi >> 2, s = pi & 3;
        attn_prompt_unit(a, lds, bh >> 3, bh & 7, 7 - s, cB, tid, lane, wave);
        attn_prompt_unit(a, lds, bh >> 3, bh & 7, s, cB, tid, lane, wave); }
}
constexpr int CSW = 296;
DI void p4b_sample_q(const Args& a, LAS unsigned char* lds, int vcu, int G, int tid, int lane, int wave) {
    LAS float* qs = (LAS float*)lds;
    const bf16* QF = (const bf16*)(a.ws + WS_QF); bf16* QS = (bf16*)(a.ws + WS_QS);
    const float* W = (const float*)a.in[I_WUKV]; const float* gk = (const float*)a.in[I_GKH];
    for (int it = vcu; it < 256; it += G) { const int h = it >> 5, rg = it & 31;
        __syncthreads();
        for (int i = tid; i < 16 * 96; i += NTHR) { const int r = i / 96, d = i % 96; qs[i] = bf2f(QF[((size_t)MP + rg * 16 + r) * 768 + h * 96 + d]); }
        __syncthreads();
        if (tid < 256) { float w[64];
#pragma unroll
            for (int d4 = 0; d4 < 16; ++d4) { const f32x4 v = *(const f32x4*)(W + (size_t)tid * 1024 + h * 128 + d4 * 4), g = *(const f32x4*)(gk + d4 * 4); w[4 * d4] = v.x * g.x; w[4 * d4 + 1] = v.y * g.y; w[4 * d4 + 2] = v.z * g.z; w[4 * d4 + 3] = v.w * g.w; }
#pragma unroll 1
            for (int r = 0; r < 16; ++r) { float s = 0.f;
#pragma unroll
                for (int d4 = 0; d4 < 16; ++d4) { const f32x4 qv = *(const LAS f32x4*)(qs + r * 96 + 4 * d4); s += (w[4 * d4] * qv.x + w[4 * d4 + 1] * qv.y) + (w[4 * d4 + 2] * qv.z + w[4 * d4 + 3] * qv.w); }
                const int srow = rg * 16 + r, bd = srow >> 2, t = srow & 3;
                QS[((size_t)bd * 32 + h * 4 + t) * CSW + tid] = (bf16)f2bf(s); } }
        else { for (int i = tid - 256; i < 16 * 40; i += 256) { const int r = i / 40, d = i % 40; const int srow = rg * 16 + r, bd = srow >> 2, t = srow & 3;
                QS[((size_t)bd * 32 + h * 4 + t) * CSW + 256 + d] = (d < 32) ? (bf16)f2bf(qs[r * 96 + 64 + d]) : (bf16)0; } }
    }
}

DI void glds16(const void* gsrc, unsigned lds_dst) { unsigned keep;
    asm volatile("s_mov_b32 %0, m0\n\ts_mov_b32 m0, %2\n\ts_nop 0\n\tglobal_load_lds_dwordx4 %1, off\n\ts_mov_b32 m0, %0" : "=&s"(keep) : "v"(gsrc), "s"(lds_dst) : "memory"); }
#define BAR_LDS() asm volatile("s_waitcnt lgkmcnt(0)\n\ts_barrier" ::: "memory")
#define BAR_ALL() asm volatile("s_waitcnt vmcnt(0) lgkmcnt(0)\n\ts_barrier" ::: "memory")
DI void attn_sample_phase(const Args& a, LAS unsigned char* lds, int vcu, int G, int tid, int lane, int wave) {
    LAS bf16* Cs = (LAS bf16*)lds;
    LAS unsigned char* C8 = lds + 56832;
    LAS bf16* Qs = (LAS bf16*)(lds + 74240);
    LAS bf16* PT = (LAS bf16*)(lds + 93184);
    LAS float* RI = (LAS float*)(lds + 95744);
    LAS float* SSPE = (LAS float*)(lds + 96768);
    LAS float* LRED = (LAS float*)(lds + 97024);
    LAS int* PG = (LAS int*)(lds + 97152);
    const float cB = score_bound(a, lane);
    const bf16* Wt = (const bf16*)(a.ws + WS_WUKV);
    const bf16* QS = (const bf16*)(a.ws + WS_QS);
    const float* cckv = (const float*)a.in[I_CCKV]; const float* ckpe = (const float*)a.in[I_CKPE]; const int* ptab = (const int*)a.in[I_PT];
    const float* rc = (const float*)(a.ws + WS_ROPE); const float* rs = rc + 8200 * 16; const float* gk = (const float*)a.in[I_GKH];
    float* SPART = (float*)(a.ws + WS_SPART); float* SL = (float*)(a.ws + WS_SL);
    const int r16 = lane & 15, q4 = lane >> 4, r32 = lane & 31, h2 = lane >> 5;
    typedef int v8i_t __attribute__((ext_vector_type(8)));
    v8i_t wf8[4][2];
#pragma unroll
    for (int nb = 0; nb < 4; ++nb)
#pragma unroll
        for (int ks = 0; ks < 2; ++ks) { const bf16* wp = Wt + (size_t)(wave * 128 + nb * 16 + r16) * 256 + 128 * ks + 32 * q4;
#pragma unroll
            for (int i = 0; i < 4; ++i) { const u32x4 w = *(const u32x4*)(wp + 8 * i); int lo = 0, hi = 0;
                lo = __builtin_amdgcn_cvt_pk_fp8_f32(bflo(w.x) * 16.f, bfhi(w.x) * 16.f, lo, false); lo = __builtin_amdgcn_cvt_pk_fp8_f32(bflo(w.y) * 16.f, bfhi(w.y) * 16.f, lo, true);
                hi = __builtin_amdgcn_cvt_pk_fp8_f32(bflo(w.z) * 16.f, bfhi(w.z) * 16.f, hi, false); hi = __builtin_amdgcn_cvt_pk_fp8_f32(bflo(w.w) * 16.f, bfhi(w.w) * 16.f, hi, true);
                wf8[nb][ks][2 * i] = lo; wf8[nb][ks][2 * i + 1] = hi; } }
    const bool kthr = tid >= 256; const int krow = (tid >> 3) & 31, kp = tid & 7;
    const f32x2 gpa = *(const f32x2*)(gk + 64 + 2 * kp), gpb = *(const f32x2*)(gk + 80 + 2 * kp);
    const f32x2 cd = *(const f32x2*)(rc + 32 * 16 + 2 * kp), sd = *(const f32x2*)(rs + 32 * 16 + 2 * kp);
    const int lrow = tid >> 6, lpc = tid & 63;
    f32x4 a0, a1, a2, a3; f32x2 aka = {0.f, 0.f}, akb = {0.f, 0.f};
#define SA_LOAD(jj, v0, v1, v2, v3, ka, kb) do { const int phys_ = __builtin_amdgcn_readfirstlane(PG[(jj) >> 2]); const size_t key0_ = (size_t)phys_ * PAGE + ((jj) & 3) * 32; \
        const float* src_ = cckv + (key0_ + lrow) * KVL + lpc * 4; v0 = *(const f32x4*)src_; v1 = *(const f32x4*)(src_ + 8 * KVL); v2 = *(const f32x4*)(src_ + 16 * KVL); v3 = *(const f32x4*)(src_ + 24 * KVL); \
        if (kthr) { const float* ks_ = ckpe + (key0_ + krow) * ROPE + 2 * kp; ka = *(const f32x2*)ks_; kb = *(const f32x2*)(ks_ + 16); } } while (0)
#define SA_CONV1(v, i_, cb, c8b) do { const int row_ = lrow + 8 * (i_); u32x2 w_; w_.x = pk2(v.x, v.y); w_.y = pk2(v.z, v.w); *(LAS u32x2*)(cb + row_ * CSW + lpc * 4) = w_; \
        int f8_ = 0; f8_ = __builtin_amdgcn_cvt_pk_fp8_f32(v.x, v.y, f8_, false); f8_ = __builtin_amdgcn_cvt_pk_fp8_f32(v.z, v.w, f8_, true); *(LAS int*)(c8b + row_ * 272 + lpc * 4) = f8_; } while (0)
#define SA_CONVERT(jj, cb3, v0, v1, v2, v3, ka, kb) do { LAS bf16* cb_ = Cs + (cb3) * (32 * CSW); LAS unsigned char* c8_ = C8 + ((jj) & 1) * 8704; \
        SA_CONV1(v0, 0, cb_, c8_); SA_CONV1(v1, 1, cb_, c8_); SA_CONV1(v2, 2, cb_, c8_); SA_CONV1(v3, 3, cb_, c8_); \
        if (kthr) { const float ss_ = row8_sum((ka.x * ka.x + ka.y * ka.y) + (kb.x * kb.x + kb.y * kb.y)); if (kp == 0) SSPE[((jj) & 1) * 32 + krow] = ss_; \
            const f32x2 ya_ = ka * gpa, yb_ = kb * gpb; const f32x2 r1_ = ya_ * rcur - yb_ * rsur, r2_ = yb_ * rcur + ya_ * rsur; \
            *(LAS unsigned*)(cb_ + krow * CSW + 256 + 2 * kp) = pk2(r1_.x, r1_.y); *(LAS unsigned*)(cb_ + krow * CSW + 272 + 2 * kp) = pk2(r2_.x, r2_.y); \
            const f32x2 nc_ = rcur * cd - rsur * sd, ns_ = rsur * cd + rcur * sd; rcur = nc_; rsur = ns_; } } while (0)
#define SA_PV(cb3) do { const LAS bf16* cb_ = Cs + (cb3) * (32 * CSW); const int q_ = (lane & 15) >> 2, p_ = lane & 3, blk_ = (lane >> 4) & 1; \
        _Pragma("unroll") for (int s4 = 0; s4 < 2; ++s4) { const LAS bf16* ap = cb_ + (16 * s4 + 8 * h2 + q_) * CSW + 32 * wave + 16 * blk_ + 4 * p_; \
            const s16x4 lo = __builtin_bit_cast(s16x4, __builtin_amdgcn_ds_read_tr16_b64_v4i16((LAS v4i16_t*)ap)), hi = __builtin_bit_cast(s16x4, __builtin_amdgcn_ds_read_tr16_b64_v4i16((LAS v4i16_t*)(ap + 4 * CSW))); \
            const bf16x8 af = __builtin_shufflevector(lo, hi, 0, 1, 2, 3, 4, 5, 6, 7); const bf16x8 bp = *(const LAS bf16x8*)(PT + r32 * 40 + 16 * s4 + 8 * h2); \
            accT = MFMA32(af, bp, accT); } } while (0)
    for (int it = vcu; it < 2 * DB; it += G) { const int bd = it >> 1, split = it & 1;
        __syncthreads();
        if (tid < 32) { PG[tid] = ptab[bd * NPAGES + split * 32 + tid]; LRED[tid] = 0.f; }
        bf16x8 qfr[9];
#pragma unroll
        for (int s9 = 0; s9 < 9; ++s9) qfr[s9] = *(const bf16x8*)(QS + ((size_t)bd * 32 + (wave & 1) * 16 + r16) * CSW + 32 * s9 + 8 * q4);
        f32x2 rcur = *(const f32x2*)(rc + (split * 4096 + krow) * 16 + 2 * kp), rsur = *(const f32x2*)(rs + (split * 4096 + krow) * 16 + 2 * kp);
        __syncthreads();
        SA_LOAD(0, a0, a1, a2, a3, aka, akb);
        SA_CONVERT(0, 0, a0, a1, a2, a3, aka, akb);
        SA_LOAD(1, a0, a1, a2, a3, aka, akb);
        __syncthreads();
        f32x16 accT = {}; float lsum = 0.f; int c3 = 0;
#pragma unroll 1
        for (int j = 0; j < 128; ++j) {
            const int c3n = (c3 == 2) ? 0 : c3 + 1, c3p = (c3 == 0) ? 2 : c3 - 1;
            if (j > 0) SA_PV(c3p);
            { const LAS unsigned char* c8b = C8 + (j & 1) * 8704; const LAS float* spe = SSPE + (j & 1) * 32;
#pragma unroll
                for (int kb = 0; kb < 2; ++kb) { f32x4 acc[4] = {};
#pragma unroll
                    for (int ks = 0; ks < 2; ++ks) { const LAS unsigned char* ap = c8b + (kb * 16 + r16) * 272 + 128 * ks + 32 * q4;
                        const u32x4 x0 = *(const LAS u32x4*)ap, x1 = *(const LAS u32x4*)(ap + 16);
                        const v8i_t af = {(int)x0.x, (int)x0.y, (int)x0.z, (int)x0.w, (int)x1.x, (int)x1.y, (int)x1.z, (int)x1.w};
#pragma unroll
                        for (int nb = 0; nb < 4; ++nb) acc[nb] = __builtin_amdgcn_mfma_scale_f32_16x16x128_f8f6f4(af, wf8[nb][ks], acc[nb], 0, 0, 0, 0x7F7F7F7F, 0, 0x7F7F7F7F); }
                    f32x4 sq = (acc[0] * acc[0] + acc[1] * acc[1] + acc[2] * acc[2] + acc[3] * acc[3]) * (1.f / 256.f);
                    sq.x = row16_sum(sq.x); sq.y = row16_sum(sq.y); sq.z = row16_sum(sq.z); sq.w = row16_sum(sq.w);
                    if (r16 == 0) { const f32x4 pe = *(const LAS f32x4*)(spe + kb * 16 + 4 * q4); f32x4 r;
                        r.x = __builtin_amdgcn_rsqf((sq.x + pe.x) * (1.f / 96.f) + EPS); r.y = __builtin_amdgcn_rsqf((sq.y + pe.y) * (1.f / 96.f) + EPS);
                        r.z = __builtin_amdgcn_rsqf((sq.z + pe.z) * (1.f / 96.f) + EPS); r.w = __builtin_amdgcn_rsqf((sq.w + pe.w) * (1.f / 96.f) + EPS);
                        *(LAS f32x4*)(RI + wave * 32 + kb * 16 + 4 * q4) = r; } } }
            f32x4 sa = {0.f, 0.f, 0.f, 0.f};
            if (wave < 4) { const int kb = wave >> 1, nb2 = wave & 1; const LAS bf16* cb = Cs + c3 * (32 * CSW);
#pragma unroll
                for (int s9 = 0; s9 < 9; ++s9) { const bf16x8 af = *(const LAS bf16x8*)(cb + (kb * 16 + r16) * CSW + 32 * s9 + 8 * q4);
                    sa = MFMA16(af, qfr[s9], sa); } (void)nb2; }
            if (j + 1 < 128) { SA_CONVERT(j + 1, c3n, a0, a1, a2, a3, aka, akb); if (j + 2 < 128) SA_LOAD(j + 2, a0, a1, a2, a3, aka, akb); }
            __syncthreads();
            if (wave < 4) { const int kb = wave >> 1, nb2 = wave & 1; const int row = nb2 * 16 + r16, hrow = row >> 2; const f32x4 ri = *(const LAS f32x4*)(RI + hrow * 32 + kb * 16 + 4 * q4);
                const float p0 = __builtin_amdgcn_exp2f(sa.x * ri.x - cB), p1 = __builtin_amdgcn_exp2f(sa.y * ri.y - cB), p2 = __builtin_amdgcn_exp2f(sa.z * ri.z - cB), p3 = __builtin_amdgcn_exp2f(sa.w * ri.w - cB);
                lsum += (p0 + p1) + (p2 + p3);
                u32x2 w; w.x = pk2(p0, p1); w.y = pk2(p2, p3); *(LAS u32x2*)(PT + row * 40 + kb * 16 + 4 * q4) = w; }
            __syncthreads();
            c3 = c3n;
        }
        SA_PV(((c3 == 0) ? 2 : c3 - 1));
        lsum += __shfl_xor(lsum, 16); lsum += __shfl_xor(lsum, 32);
        if (wave < 4 && q4 == 0) (void)__hip_atomic_fetch_add(LRED + (wave & 1) * 16 + r16, lsum, __ATOMIC_RELAXED, __HIP_MEMORY_SCOPE_WORKGROUP);
        __syncthreads();
        if (tid < 32) SL[(size_t)it * 32 + tid] = LRED[tid];
        float* sp = SPART + ((size_t)it * 32 + r32) * 256 + 32 * wave;
#pragma unroll
        for (int r = 0; r < 16; ++r) sp[crow(r, h2)] = accT[r];
    }
#undef SA_LOAD
#undef SA_CONV1
#undef SA_CONVERT
#undef SA_PV
}

DI void attn_sample_final(const Args& a, LAS unsigned char* lds, int vcu, int G, int tid, int lane, int wave) {
    LAS float* lat = (LAS float*)lds;
    LAS float* cn = lat + 1024;
    LAS float* kper = cn + 1024;
    LAS float* rinv = kper + 128;
    LAS float* pw = rinv + 4;
    LAS float* lt = pw + 16;
    LAS float* red = lt + 4;
    const float cB = score_bound(a, lane);
    const bf16* CKVB = (const bf16*)(a.ws + WS_CKVB); const bf16* Z = (const bf16*)(a.ws + WS_Z); const bf16* KV = (const bf16*)(a.ws + WS_KVRAW); const bf16* QS = (const bf16*)(a.ws + WS_QS);
    const float* SPART = (const float*)(a.ws + WS_SPART); const float* SL = (const float*)(a.ws + WS_SL); bf16* MIX = (bf16*)(a.ws + WS_MIX);
    const float* rc = (const float*)(a.ws + WS_ROPE); const float* rs = rc + 8200 * 16; const float* gk = (const float*)a.in[I_GKH]; const float* W = (const float*)a.in[I_WUKV];
    for (int it = vcu; it < DB * NH; it += G) { const int bd = it >> 3, h = it & 7; const size_t row0 = (size_t)MP + bd * 4;
        __syncthreads();
        for (int i = tid; i < 1024; i += NTHR) { const int t = i >> 8, c = i & 255; cn[i] = bf2f(CKVB[(row0 + t) * KVL + c]);
            lat[i] = SPART[(((size_t)bd * 2 + 0) * 32 + h * 4 + t) * 256 + c] + SPART[(((size_t)bd * 2 + 1) * 32 + h * 4 + t) * 256 + c]; }
        if (tid < 128) { const int t = tid >> 5, d = tid & 31; const float x = bf2f(Z[(row0 + t) * ZW + ZC_KPE + d]); const float y = x * gk[64 + d], yo = __shfl_xor(y, 16);
            const int pos = PAST + t; const float c = rc[pos * 16 + (d & 15)], s = rs[pos * 16 + (d & 15)];
            kper[tid] = (d < 16) ? (y * c - yo * s) : (y * c + yo * s);
            float ss = x * x;
            const float k0 = bf2f(KV[(row0 + t) * 1024 + h * 128 + d]), k1 = bf2f(KV[(row0 + t) * 1024 + h * 128 + 32 + d]); ss += k0 * k0 + k1 * k1;
#pragma unroll
            for (int o = 1; o < 32; o <<= 1) ss += __shfl_xor(ss, o);
            if (d == 0) rinv[t] = __builtin_amdgcn_rsqf(ss * (1.f / 96.f) + EPS); }
        __syncthreads();
#pragma unroll
        for (int e = 0; e < 2; ++e) { const int pr = wave * 2 + e, t = pr >> 2, tp = pr & 3; const bf16* q = QS + ((size_t)bd * 32 + h * 4 + t) * CSW;
            float s = 0.f;
#pragma unroll
            for (int j = 0; j < 4; ++j) s += bf2f(q[j * 64 + lane]) * cn[tp * 256 + j * 64 + lane];
            if (lane < 32) s += bf2f(q[256 + lane]) * kper[tp * 32 + lane];
            s = wave_sum(s);
            if (lane == 0) pw[pr] = (tp <= t) ? __builtin_amdgcn_exp2f(s * rinv[tp] - cB) : 0.f; }
        __syncthreads();
        for (int i = tid; i < 1024; i += NTHR) { const int t = i >> 8, c = i & 255; lat[i] += (pw[t * 4] * cn[c] + pw[t * 4 + 1] * cn[256 + c]) + (pw[t * 4 + 2] * cn[512 + c] + pw[t * 4 + 3] * cn[768 + c]); }
        if (tid < 4) lt[tid] = SL[((size_t)bd * 2 + 0) * 32 + h * 4 + tid] + SL[((size_t)bd * 2 + 1) * 32 + h * 4 + tid] + (pw[tid * 4] + pw[tid * 4 + 1]) + (pw[tid * 4 + 2] + pw[tid * 4 + 3]);
        __syncthreads();
        { const int half = tid >> 8, t = (tid >> 6) & 3, dv = tid & 63; float s = 0.f; const float* wp = W + (size_t)(half * 128) * 1024 + h * 128 + 64 + dv;
#pragma unroll 8
            for (int c = 0; c < 128; ++c) s += lat[t * 256 + half * 128 + c] * wp[(size_t)c * 1024];
            red[(half * 4 + t) * 64 + dv] = s; }
        __syncthreads();
        if (tid < 256) { const int t = tid >> 6, dv = tid & 63; const float o = (red[t * 64 + dv] + red[(4 + t) * 64 + dv]) / lt[t];
            MIX[(row0 + t) * DM + h * 64 + dv] = (bf16)f2bf(o); }
    }
}
DI float gelu_tanh(float x) { const float u = 1.5957691216057308f * (x + 0.044715f * x * x * x); return x * sigmoidf_(u); }
DI void s5_norm_phase(const Args& a, int vcu, int G, int lane, int wave) {
    const bf16* XB = (const bf16*)(a.ws + WS_XB1); const float* SS3 = (const float*)(a.ws + WS_CTL) + CW_SS + 3 * MT; bf16* U2 = (bf16*)(a.ws + WS_U2);
    const float* gn = (const float*)a.in[I_GNC];
    const int gw = vcu * NWAVES + wave, NGW = G * NWAVES;
    { f32x4 g0 = *(const f32x4*)(gn + lane * 16), g1 = *(const f32x4*)(gn + lane * 16 + 4), g2 = *(const f32x4*)(gn + lane * 16 + 8), g3 = *(const f32x4*)(gn + lane * 16 + 12);
        for (int m = gw; m < MP; m += NGW) { const float r = __builtin_amdgcn_rsqf(SS3[m] * (1.f / DM) + EPS);
            const u32x4 w0 = *(const u32x4*)(XB + (size_t)m * DM + lane * 16), w1 = *(const u32x4*)(XB + (size_t)m * DM + lane * 16 + 8);
            u32x4 o0, o1;
            o0.x = pk2(bflo(w0.x) * r * g0.x, bfhi(w0.x) * r * g0.y); o0.y = pk2(bflo(w0.y) * r * g0.z, bfhi(w0.y) * r * g0.w); o0.z = pk2(bflo(w0.z) * r * g1.x, bfhi(w0.z) * r * g1.y); o0.w = pk2(bflo(w0.w) * r * g1.z, bfhi(w0.w) * r * g1.w);
            o1.x = pk2(bflo(w1.x) * r * g2.x, bfhi(w1.x) * r * g2.y); o1.y = pk2(bflo(w1.y) * r * g2.z, bfhi(w1.y) * r * g2.w); o1.z = pk2(bflo(w1.z) * r * g3.x, bfhi(w1.z) * r * g3.y); o1.w = pk2(bflo(w1.w) * r * g3.z, bfhi(w1.w) * r * g3.w);
            bf16* dst = U2 + ((size_t)(m >> 4) * S5G + lane) * S5K + (m & 15) * 16;
            *(u32x4*)dst = o0; *(u32x4*)(dst + 8) = o1; } }
}
DI void s5_sample_phase(const Args& a, LAS unsigned char* lds, int gw, int NGW, int it_lo, int it_hi, int lane, int wave) {
    const bf16* XB = (const bf16*)(a.ws + WS_XB1); const float* SS3 = (const float*)(a.ws + WS_CTL) + CW_SS + 3 * MT; bf16* GG = (bf16*)(a.ws + WS_GG);
    const float* gn = (const float*)a.in[I_GNC];
    LAS float* us = (LAS float*)lds + wave * 2688;
    LAS float* xr = us + 64;
    LAS float* xi = xr + 256;
    LAS float* cs = xi + 256;
    const float* tab = (const float*)(a.ws + WS_S5TAB);
    const float* x0r = (const float*)a.in[I_S5RE]; const float* x0i = (const float*)a.in[I_S5IM]; const float* dd = (const float*)a.in[I_S5D];
    float lr = 0.f, li = 0.f; f32x4 bbv[8]; int gcur = -1;
#pragma unroll
    for (int q = 0; q < 8; ++q) bbv[q] = (f32x4){0.f, 0.f, 0.f, 0.f};
    for (int it = it_lo + gw; it < it_hi; it += NGW) { const int g = it & 63, bd = it >> 6; const size_t row0 = (size_t)MP + bd * 4;
        if (g != gcur) { gcur = g; lr = tab[((size_t)g * 64 + lane) * 2]; li = tab[((size_t)g * 64 + lane) * 2 + 1];
            const f32x4* bb = (const f32x4*)(tab + 16384 + ((size_t)g * 1024 + lane * 16) * 2);
#pragma unroll
            for (int q = 0; q < 8; ++q) bbv[q] = bb[q];
            LDS_WAIT(); asm volatile("" ::: "memory");
            const float* cre = (const float*)a.in[I_S5CRE] + (size_t)g * 1024; const float* cim = (const float*)a.in[I_S5CIM] + (size_t)g * 1024;
#pragma unroll 4
            for (int i = 0; i < 16; ++i) { cs[(i * 64 + lane) * 2] = cre[i * 64 + lane]; cs[(i * 64 + lane) * 2 + 1] = cim[i * 64 + lane]; } }
        { const int t = lane >> 4, c = lane & 15; const size_t row = row0 + t; const float r = __builtin_amdgcn_rsqf(SS3[row] * (1.f / DM) + EPS);
            us[lane] = bf2f(XB[row * DM + g * 16 + c]) * r * gn[g * 16 + c]; }
        LDS_WAIT(); asm volatile("" ::: "memory");
        { float sr = x0r[((size_t)bd * 64 + g) * 64 + lane], si = x0i[((size_t)bd * 64 + g) * 64 + lane];
#pragma unroll
            for (int t = 0; t < 4; ++t) { float br = 0.f, bi = 0.f;
#pragma unroll
                for (int q = 0; q < 4; ++q) { const f32x4 u4 = *(const LAS f32x4*)(us + t * 16 + 4 * q); const f32x4 b0 = bbv[2 * q], b1 = bbv[2 * q + 1];
                    br += (b0.x * u4.x + b0.z * u4.y) + (b1.x * u4.z + b1.z * u4.w); bi += (b0.y * u4.x + b0.w * u4.y) + (b1.y * u4.z + b1.w * u4.w); }
                const float nr = lr * sr - li * si + br, ni = lr * si + li * sr + bi; sr = nr; si = ni; xr[t * 64 + lane] = sr; xi[t * 64 + lane] = si; }
            a.out[O_S5RS + ((size_t)bd * 64 + g) * 64 + lane] = sr; a.out[O_S5IS + ((size_t)bd * 64 + g) * 64 + lane] = si; }
        LDS_WAIT(); asm volatile("" ::: "memory");
        { const int t = lane >> 4, co = lane & 15; const LAS f32x2* cp = (const LAS f32x2*)(cs + co * 128);
            float y = dd[g * 16 + co] * us[t * 16 + co];
#pragma unroll 8
            for (int p = 0; p < 64; ++p) { const f32x2 cc = cp[p]; y += cc.x * xr[t * 64 + p] - cc.y * xi[t * 64 + p]; }
            GG[(row0 + t) * DM + g * 16 + co] = (bf16)f2bf(gelu_tanh(y)); }
        LDS_WAIT(); asm volatile("" ::: "memory");
    }
}
struct EpiS5E {
    static constexpr bool PERM = false;
    float* E;
    DI void operator()(const f32x4 (&acc)[2][2][4][2], const pg8::Unit& u, int wr, int wc, int fr, int fq) const {
        const int j = (int)(u.aoff / (2 * S5K * 2)); const int row0 = u.pm * 256 + wr * 64 + fr, col0 = wc * 32 + 4 * fq;
#pragma unroll
        for (int ai = 0; ai < 2; ++ai)
#pragma unroll
            for (int m = 0; m < 4; ++m) { const int n = row0 + ai * 128 + m * 16;
#pragma unroll
                for (int bj = 0; bj < 2; ++bj)
#pragma unroll
                    for (int nn = 0; nn < 2; ++nn) *(f32x4*)(E + ((size_t)n * S5G + 2 * j + bj) * 128 + col0 + nn * 16) = acc[ai][bj][m][nn]; }
    }
};
DI void s5_scan_units(const Args& a, int bx, int G, int tid) {
    const float* E = (const float*)(a.ws + WS_S5E); bf16* U2 = (bf16*)(a.ws + WS_U2); const float* tab = (const float*)(a.ws + WS_S5TAB);
    for (int L = bx; L < 256; L += G) { const int g = L >> 2, pm = L & 3;
        if (tid < 128) { const int p = tid & 63, b = 2 * pm + (tid >> 6);
            const float lr = tab[8192 + ((size_t)g * 64 + p) * 2], li = tab[8192 + ((size_t)g * 64 + p) * 2 + 1];
            float sr = 0.f, si = 0.f;
#pragma unroll 4
            for (int c = 0; c < S5NC; ++c) { const size_t n = (size_t)b * S5NC + c; const float er = E[(n * S5G + g) * 128 + p], ei = E[(n * S5G + g) * 128 + 64 + p];
                bf16* up = U2 + (n * S5G + g) * S5K + 256; up[p] = (bf16)f2bf(sr); up[64 + p] = (bf16)f2bf(si);
                const float nr = lr * sr - li * si + er, ni = lr * si + li * sr + ei; sr = nr; si = ni; }
            const size_t i = ((size_t)b * 64 + g) * 64 + p; a.out[O_S5RP + i] = sr; a.out[O_S5IP + i] = si; } }
    asm volatile("s_waitcnt vmcnt(0)" ::: "memory");
    __syncthreads();
}
struct EpiS5Y {
    static constexpr bool PERM = false;
    const bf16* U2; const float* D; bf16* GG;
    DI void operator()(const f32x4 (&acc)[2][2][4][2], const pg8::Unit& u, int wr, int wc, int fr, int fq) const {
        const int g = (int)(u.aoff / (S5K * 2)); const int row0 = u.pm * 256 + wr * 64 + fr, col0 = wc * 32 + 4 * fq;
#pragma unroll
        for (int ai = 0; ai < 2; ++ai)
#pragma unroll
            for (int m = 0; m < 4; ++m) { const int n = row0 + ai * 128 + m * 16;
#pragma unroll
                for (int bj = 0; bj < 2; ++bj)
#pragma unroll
                    for (int nn = 0; nn < 2; ++nn) { const int col = col0 + bj * 128 + nn * 16, t = col >> 4, co = col & 15;
                        const u32x2 uw = *(const u32x2*)(U2 + ((size_t)n * S5G + g) * S5K + col); const f32x4 d4 = *(const f32x4*)(D + g * 16 + co); const f32x4 v = acc[ai][bj][m][nn];
                        const float y0 = gelu_tanh(v[0] + d4.x * bflo(uw.x)), y1 = gelu_tanh(v[1] + d4.y * bfhi(uw.x)), y2 = gelu_tanh(v[2] + d4.z * bflo(uw.y)), y3 = gelu_tanh(v[3] + d4.w * bfhi(uw.y));
                        u32x2 w; w.x = pk2(y0, y1); w.y = pk2(y2, y3); *(u32x2*)(GG + ((size_t)n * S5T + t) * DM + g * 16 + co) = w; }
                asm volatile("" ::: "memory"); }
    }
};
#ifndef MK_N_LAUNCHES
#define MK_N_LAUNCHES 1
#endif
constexpr int N_PHASES = 21;
__global__ void __launch_bounds__(NTHR, 2) mega_fwd(Args args) {
    extern __shared__ __attribute__((aligned(16))) unsigned char lds_raw[];
    LAS unsigned char* lds = (LAS unsigned char*)lds_raw;
    volatile LAS unsigned* MISC = (volatile LAS unsigned*)(lds + MISC_OFF);
    const int tid = threadIdx.x, lane = tid & 63, wave = __builtin_amdgcn_readfirstlane(tid >> 6);
    const int G = gridDim.x; const int bx = blockIdx.x; const int vcu = (G % 8 == 0) ? (bx % 8) * (G / 8) + bx / 8 : bx;
    unsigned char* ws = args.ws;
    unsigned* ctl = (unsigned*)(ws + WS_CTL);
    if (tid < 64) MISC[tid] = 0u;
    __syncthreads();
    const int lo = args.ph_lo, hi = args.ph_hi;
    XcdBarrier bar; bar.bar = ctl + CW_BAR; bar.x = 0; bar.st = nullptr;
    if (hi - lo > 1) bar = xcd_barrier_post(ctl + CW_BAR, MISC + 8);
#ifndef PHMASK
#define PHMASK 0xffffffffu
#endif
#define IN(k) (((PHMASK >> (k)) & 1u) && lo <= (k) && (k) < hi)
#define SEAM(k) do { if (IN(k) && IN((k) + 1)) xcd_barrier(bar); } while (0)
    const int rcu = G - 1 - bx;
    float* SS = (float*)(ctl + CW_SS);
    float* H = args.out + O_Y;
    bf16* XB0 = (bf16*)(ws + WS_XB0); bf16* XB1 = (bf16*)(ws + WS_XB1);
    const float* ss0 = (const float*)(ws + WS_SSQ) + MT;

    if (IN(0)) { _Pragma("unroll 1") for (int rep_ = 0; rep_ < REPS(0); ++rep_) { __syncthreads(); p0_prologue(args, lds, vcu, G, tid, lane, wave); } } SEAM(0);
    if (IN(1)) {
        pg8::Gemm g{XB0, (const bf16*)(ws + WS_WIN), DM, DM, DM}; pg8::GridOrder S; S.init(MP / 256, ZW / 256, G, bx);
        pg8::EpiZ E{(bf16*)(ws + WS_Z), ss0, SS + 6 * MT};
        pg8::gemm_phase<pg8::EpiZ, pg8::GridOrder, true>(lds, g, S, E);
        sk::skinny_gemm4(lds, XB0 + (size_t)MP * DM, DM, (const bf16*)(ws + WS_WIN), DM, DM, ZW / 128, sk::SkZ{(bf16*)(ws + WS_Z), ss0, SS + 6 * MT}, G == 256 ? (bx >= 192 ? bx - 192 : (1 << 20)) : rcu, G == 256 ? 64 : G, tid, lane, wave);
    } SEAM(1);
    if (IN(3)) { _Pragma("unroll 1") for (int rep_ = 0; rep_ < REPS(3); ++rep_) {
        { pg8::Gemm g{(const bf16*)(ws + WS_Z) + ZC_CQ, (const bf16*)(ws + WS_WUQ), ZW, QL, QL}; pg8::GridOrder S; S.init(MP / 256, 3, G, bx);
          pg8::EpiBf16<0> E{(bf16*)(ws + WS_QRAW), 768, SS + 6 * MT, 1.f / QL};
          pg8::gemm_phase<pg8::EpiBf16<0>, pg8::GridOrder, true>(lds, g, S, E); }
        sk::skinny_gemm(lds, (const bf16*)(ws + WS_Z) + (size_t)MP * ZW + ZC_CQ, ZW, (const bf16*)(ws + WS_WUQ), QL, QL, 24, sk::SkBf16<0>{(bf16*)(ws + WS_QRAW), 768, SS + 6 * MT, 1.f / QL}, sk::BMapLin(), G == 256 ? (bx >= 192 ? bx - 192 : (1 << 20)) : rcu, G == 256 ? 64 : G, tid, lane, wave);
        __syncthreads();
        { pg8::Gemm g{(const bf16*)(ws + WS_Z) + ZC_CKV, (const bf16*)(ws + WS_WUKVG), ZW, KVL, KVL}; pg8::GridOrder S; S.init(MP / 256, 4, G, bx);
          pg8::EpiBf16<0> E{(bf16*)(ws + WS_KVRAW), 1024, SS + 7 * MT, 1.f / KVL};
          pg8::gemm_phase<pg8::EpiBf16<0>, pg8::GridOrder, true>(lds, g, S, E); }
        sk::skinny_gemm(lds, (const bf16*)(ws + WS_Z) + (size_t)MP * ZW + ZC_CKV, ZW, (const bf16*)(ws + WS_WUKVG), KVL, KVL, 32, sk::SkBf16<0>{(bf16*)(ws + WS_KVRAW), 1024, SS + 7 * MT, 1.f / KVL}, sk::BMapLin(), rcu, G, tid, lane, wave);
        __syncthreads();
#pragma unroll 1
        for (int li = 0; li < 2; ++li) { pg8::Gemm g{(const bf16*)(ws + WS_PB) + (size_t)li * MT * PLE, (const bf16*)(ws + WS_WPROJ) + (size_t)li * DM * PLE, PLE, PLE, PLE}; pg8::GridOrder S; S.init(MP / 256, 4, G, bx);
          pg8::EpiBf16<0> E{(bf16*)(ws + WS_PP) + (size_t)li * MT * DM, DM, nullptr, 0.f};
          pg8::gemm_phase<pg8::EpiBf16<0>, pg8::GridOrder, true>(lds, g, S, E); }
#pragma unroll 1
        for (int li = 0; li < 2; ++li) sk::skinny_gemm(lds, (const bf16*)(ws + WS_PB) + ((size_t)li * MT + MP) * PLE, PLE, (const bf16*)(ws + WS_WPROJ) + (size_t)li * DM * PLE, PLE, PLE, 32, sk::SkBf16<0>{(bf16*)(ws + WS_PP) + (size_t)li * MT * DM, DM, nullptr, 0.f}, sk::BMapLin(), rcu, G, tid, lane, wave);
    }
    } if (IN(3) && IN(5)) xcd_barrier(bar);
    if (IN(5)) { p4_attn_prep(args, lds, vcu, G, tid, lane, wave); gla_a_phase(args, lds, vcu, G, tid, lane, wave); gla_sample_phase(args, lds, vcu, G, tid, lane, wave); } SEAM(5);
    if (IN(6)) { gla_b_phase(args, vcu, G, tid); p4b_sample_q(args, lds, vcu, G, tid, lane, wave); } SEAM(6);
    if (IN(7)) { _Pragma("unroll 1") for (int rep_ = 0; rep_ < REPS(70); ++rep_) { attn_prompt_phase(args, lds, vcu, G, tid, lane, wave); } _Pragma("unroll 1") for (int rep_ = 0; rep_ < REPS(71); ++rep_) { gla_c_phase(args, lds, vcu, G, tid, lane, wave); } _Pragma("unroll 1") for (int rep_ = 0; rep_ < REPS(72); ++rep_) { attn_sample_phase(args, lds, vcu, G, tid, lane, wave); } } SEAM(7);
    if (IN(8)) { _Pragma("unroll 1") for (int rep_ = 0; rep_ < REPS(8); ++rep_) { attn_sample_final(args, lds, vcu, G, tid, lane, wave); } } SEAM(8);
    if (IN(9)) {
        pg8::Gemm g{(const bf16*)(ws + WS_MIX), (const bf16*)(ws + WS_WOUT), DM, DM, DM}; pg8::GridOrder S; S.init(MP / 256, 4, G, bx);
        pg8::EpiRes<0> E{(const float*)args.in[I_XP], (const float*)args.in[I_XS], nullptr, nullptr, XB1, SS + 1 * MT, nullptr, nullptr};
        pg8::gemm_phase<pg8::EpiRes<0>, pg8::GridOrder, true>(lds, g, S, E);
        sk::skinny_gemm(lds, (const bf16*)(ws + WS_MIX) + (size_t)MP * DM, DM, (const bf16*)(ws + WS_WOUT), DM, DM, 32, sk::SkRes<0>{(const float*)args.in[I_XS], nullptr, nullptr, XB1, SS + 1 * MT, nullptr, nullptr}, sk::BMapLin(), rcu, G, tid, lane, wave);
    } SEAM(9);
#define LAYER_TAIL(li) do { \
        constexpr int pb = 10 + 8 * (li); \
        bf16* xin = (li) == 0 ? (bf16*)(args.ws + WS_XB1) : (bf16*)(args.ws + WS_XB0); bf16* xmid = (li) == 0 ? (bf16*)(args.ws + WS_XB0) : (bf16*)(args.ws + WS_XB1); \
        if (IN(pb)) { \
            pg8::Gemm g{xin, (const bf16*)(args.ws + WS_WUP) + (size_t)(li) * FF * DM, DM, DM, DM}; pg8::GridOrder S; S.init(MP / 256, FF / 256, G, bx); \
            pg8::EpiBf16<1> E{(bf16*)(args.ws + WS_A1), FF, (float*)((unsigned*)(args.ws + WS_CTL) + CW_SS) + ((li) == 0 ? 1 : 4) * MT, 1.f / DM}; \
            pg8::gemm_phase<pg8::EpiBf16<1>, pg8::GridOrder, true>(lds, g, S, E); \
            sk::skinny_gemm4(lds, xin + (size_t)MP * DM, DM, (const bf16*)(args.ws + WS_WUP) + (size_t)(li) * FF * DM, DM, DM, FF / 128, sk::SkBf16<1>{(bf16*)(args.ws + WS_A1), FF, (float*)((unsigned*)(args.ws + WS_CTL) + CW_SS) + ((li) == 0 ? 1 : 4) * MT, 1.f / DM}, rcu, G, tid, lane, wave); \
        } SEAM(pb); \
        if (IN(pb + 1)) { \
            float* Hh = args.out + O_Y; \
            pg8::Gemm g{(const bf16*)(args.ws + WS_A1), (const bf16*)(args.ws + WS_WDN) + (size_t)(li) * DM * FF, FF, FF, FF}; pg8::GridOrder S; S.init(MP / 256, 4, G, bx); \
            pg8::EpiRes<0> E{nullptr, nullptr, xin, nullptr, xmid, (float*)((unsigned*)(args.ws + WS_CTL) + CW_SS) + ((li) == 0 ? 2 : 5) * MT, nullptr, nullptr}; (void)Hh; \
            pg8::gemm_phase<pg8::EpiRes<0>, pg8::GridOrder, true>(lds, g, S, E); \
            sk::skinny_gemm(lds, (const bf16*)(args.ws + WS_A1) + (size_t)MP * FF, FF, (const bf16*)(args.ws + WS_WDN) + (size_t)(li) * DM * FF, FF, FF, 32, sk::SkRes<0>{nullptr, xin, nullptr, xmid, (float*)((unsigned*)(args.ws + WS_CTL) + CW_SS) + ((li) == 0 ? 2 : 5) * MT, nullptr, nullptr}, sk::BMapLin(), rcu, G, tid, lane, wave); \
        } SEAM(pb + 1); \
        if (IN(pb + 2)) { \
            float* Hh = args.out + O_Y; float* SSb = (float*)((unsigned*)(args.ws + WS_CTL) + CW_SS); \
            pg8::Gemm g{xmid, (const bf16*)(args.ws + WS_WGATE) + (size_t)(li) * DM * DM, DM, DM, DM}; pg8::GridOrder S; S.init(MP / 256, 4, G, bx); \
            pg8::EpiRes<1> E{nullptr, nullptr, xmid, (li) == 0 ? nullptr : Hh, (li) == 0 ? xin : nullptr, (li) == 0 ? SSb + 3 * MT : nullptr, SSb + ((li) == 0 ? 2 : 5) * MT, (const bf16*)(args.ws + WS_PP) + (size_t)(li) * MT * DM}; \
            pg8::gemm_phase<pg8::EpiRes<1>, pg8::GridOrder, true>(lds, g, S, E); \
            sk::skinny_gemm(lds, xmid + (size_t)MP * DM, DM, (const bf16*)(args.ws + WS_WGATE) + (size_t)(li) * DM * DM, DM, DM, 32, sk::SkRes<1>{nullptr, xmid, (li) == 0 ? nullptr : Hh, (li) == 0 ? xin : nullptr, (li) == 0 ? SSb + 3 * MT : nullptr, SSb + ((li) == 0 ? 2 : 5) * MT, (const bf16*)(args.ws + WS_PP) + (size_t)(li) * MT * DM}, sk::BMapLin(), rcu, G, tid, lane, wave); \
        } SEAM(pb + 2); } while (0)
    LAYER_TAIL(0);
    const int s5_split = (G > 128) ? (DB * S5G) / 2 : DB * S5G;
    if (IN(13)) { s5_norm_phase(args, vcu, G, lane, wave); s5_sample_phase(args, lds, vcu * NWAVES + wave, G * NWAVES, 0, s5_split, lane, wave); } SEAM(13);
    if (IN(14)) {
        pg8::Gemm g{(const bf16*)(args.ws + WS_U2), (const bf16*)(args.ws + WS_S5BD), S5G * S5K, 2 * S5K, 2 * S5K}; pg8::BatchOrder S; S.init(32, S5N / 256, 1, (size_t)2 * S5K * 2, (size_t)256 * 2 * S5K * 2, G, bx);
        EpiS5E E{(float*)(args.ws + WS_S5E)};
        pg8::gemm_phase<EpiS5E, pg8::BatchOrder, true, true>(lds, g, S, E);
        if (bx >= 128) s5_sample_phase(args, lds, (bx - 128) * NWAVES + wave, (G - 128) * NWAVES, s5_split, DB * S5G, lane, wave);
    } if (IN(14) && IN(16)) xcd_barrier(bar);
    if (IN(16)) {
        _Pragma("unroll 1") for (int rep_ = 0; rep_ < REPS(16); ++rep_) s5_scan_units(args, bx, G, tid);
        pg8::Gemm g{(const bf16*)(args.ws + WS_U2), (const bf16*)(args.ws + WS_S5TN), S5G * S5K, S5K, S5K}; pg8::BatchOrder S; S.init(64, S5N / 256, 1, (size_t)S5K * 2, (size_t)256 * S5K * 2, G, bx);
        EpiS5Y E{(const bf16*)(args.ws + WS_U2), (const float*)args.in[I_S5D], (bf16*)(args.ws + WS_GG)};
        pg8::gemm_phase<EpiS5Y, pg8::BatchOrder, true, true>(lds, g, S, E);
    } SEAM(16);
    if (IN(17)) {
        pg8::Gemm g{(const bf16*)(args.ws + WS_GG), (const bf16*)(args.ws + WS_WGLU), DM, DM, DM}; pg8::GridOrder S; S.init(MP / 256, 8, G, bx);
        pg8::EpiGlu E{(const bf16*)(args.ws + WS_XB1), (bf16*)(args.ws + WS_XB0), (float*)((unsigned*)(args.ws + WS_CTL) + CW_SS) + 4 * MT};
        pg8::gemm_phase<pg8::EpiGlu, pg8::GridOrder, true>(lds, g, S, E);
        sk::skinny_gemm(lds, (const bf16*)(args.ws + WS_GG) + (size_t)MP * DM, DM, (const bf16*)(args.ws + WS_WGLU), DM, DM, 64, sk::SkGlu{(const bf16*)(args.ws + WS_XB1), (bf16*)(args.ws + WS_XB0), (float*)((unsigned*)(args.ws + WS_CTL) + CW_SS) + 4 * MT}, sk::BMapGlu(), rcu, G, tid, lane, wave);
    } SEAM(17);
    LAYER_TAIL(1);
#undef LAYER_TAIL
#undef IN
#undef SEAM
}

extern "C" void kernel_launch(void* const* d_in, const int* in_sizes, int n_in, void* d_out, int out_size, void* d_ws, size_t ws_size, hipStream_t stream) {
    static int grid = 0;
    if (grid == 0) {
        if (n_in != 38 || out_size != (int)O_END || ws_size < WS_END) { fprintf(stderr, "kernel_launch: unexpected shapes (n_in %d, out %d, ws %zu); nothing launched\n", n_in, out_size, ws_size); grid = -1; return; }
        int dev = 0, cus = 0, per_cu = 0;
        if (hipGetDevice(&dev) != hipSuccess || hipDeviceGetAttribute(&cus, hipDeviceAttributeMultiprocessorCount, dev) != hipSuccess) { grid = -1; return; }
        if (hipFuncSetAttribute((const void*)mega_fwd, hipFuncAttributeMaxDynamicSharedMemorySize, LDS_BYTES) != hipSuccess) { fprintf(stderr, "kernel_launch: hipFuncSetAttribute failed\n"); grid = -1; return; }
        if (hipOccupancyMaxActiveBlocksPerMultiprocessor(&per_cu, (const void*)mega_fwd, NTHR, LDS_BYTES) != hipSuccess || per_cu < 1) { fprintf(stderr, "kernel_launch: occupancy query reports %d\n", per_cu); (void)hipGetLastError(); per_cu = 1; }
        grid = cus;
    }
    if (grid < 0) return;
    if (hipMemsetAsync((char*)d_ws + WS_CTL, 0, CTL_ZERO_BYTES, stream) != hipSuccess) return;
    Args a{};
    for (int i = 0; i < 38; ++i) a.in[i] = d_in[i];
    a.out = (float*)d_out; a.ws = (unsigned char*)d_ws;
#if MK_N_LAUNCHES == 1
    a.ph_lo = 0; a.ph_hi = N_PHASES;
    hipLaunchKernelGGL(mega_fwd, dim3(grid), dim3(NTHR), LDS_BYTES, stream, a);
#else
    for (int p = 0; p < N_PHASES; ++p) { a.ph_lo = p; a.ph_hi = p + 1; hipLaunchKernelGGL(mega_fwd, dim3(grid), dim3(NTHR), LDS_BYTES, stream, a); }
#endif
}
```

```cpp
#include <hip/hip_runtime.h>
#include <cstdio>
#include <cstdint>

#ifndef PROBE_PHASE
#define PROBE_PHASE -1
#endif
#define REPS(k) (PROBE_PHASE == (k) ? 2 : 1)
#define GAS __attribute__((address_space(1)))
#define LAS __attribute__((address_space(3)))
#define DI __device__ __forceinline__
typedef unsigned short bf16;
typedef short bf16x8 __attribute__((ext_vector_type(8)));
typedef short s16x4 __attribute__((ext_vector_type(4)));
typedef short v4i16_t __attribute__((ext_vector_type(4)));
typedef float f32x2 __attribute__((ext_vector_type(2)));
typedef float f32x4 __attribute__((ext_vector_type(4)));
typedef float f32x16 __attribute__((ext_vector_type(16)));
typedef unsigned u32x2 __attribute__((ext_vector_type(2)));
typedef unsigned u32x4 __attribute__((ext_vector_type(4)));
typedef __bf16 bf16x2_t __attribute__((ext_vector_type(2)));

constexpr int DM = 1024, NB = 8, SEQ = 2048, MP = NB * SEQ, DB = 128, DT = 4, MS = DB * DT, MT = MP + MS;
constexpr int NPAGES = 64, PAGE = 128, PAST = NPAGES * PAGE;
constexpr int QL = 384, KVL = 256, ROPE = 32, NOPE = 64, QK = 96, VD = 64, NH = 8;
constexpr int GH = 4, GDK = 128, GDV = 128, GRK = 16;
constexpr int ZW = 2816;
constexpr int FF = 4096, PLE = 256;
constexpr int S5G = 64, S5P = 64, S5C = 16, S5T = 16, S5NC = SEQ / S5T, S5K = 384, S5N = NB * S5NC;
constexpr float EPS = 1e-6f;
constexpr int ZC_CQ = 0, ZC_CKV = 384, ZC_GQ = 640, ZC_GK = 1152, ZC_GV = 1664, ZC_GR = 2176, ZC_KPE = 2688, ZC_GA = 2720, ZC_END = 2736;

constexpr size_t O_Y = 0;
constexpr size_t O_CKVP = (size_t)MT * DM;
constexpr size_t O_KPEP = O_CKVP + (size_t)MP * KVL;
constexpr size_t O_GLAP = O_KPEP + (size_t)MP * ROPE;
constexpr size_t O_S5RP = O_GLAP + (size_t)NB * GH * GDK * GDV;
constexpr size_t O_S5IP = O_S5RP + (size_t)NB * S5G * S5P;
constexpr size_t O_CKVS = O_S5IP + (size_t)NB * S5G * S5P;
constexpr size_t O_KPES = O_CKVS + (size_t)MS * KVL;
constexpr size_t O_GLAS = O_KPES + (size_t)MS * ROPE;
constexpr size_t O_S5RS = O_GLAS + (size_t)DB * GH * GDK * GDV;
constexpr size_t O_S5IS = O_S5RS + (size_t)DB * S5G * S5P;
constexpr size_t O_END = O_S5IS + (size_t)DB * S5G * S5P;
static_assert(O_END == 32194560, "output size");

constexpr size_t MiB = 1u << 20;
constexpr size_t WS_CTL = 0, CTL_ZERO_BYTES = 2 * MiB;
constexpr int CW_BAR = 1024;
constexpr int CW_SS = 8192;
static_assert((CW_SS + 8 * MT) * 4 <= (int)CTL_ZERO_BYTES, "ctl");
constexpr size_t WS_WIN = 2 * MiB;
constexpr size_t WS_WUQ = 8 * MiB;
constexpr size_t WS_WUKV = 9 * MiB;
constexpr size_t WS_WUKVG = 9 * MiB + 512 * 1024;
constexpr size_t WS_WOUT = 10 * MiB;
constexpr size_t WS_WGLU = 12 * MiB;
constexpr size_t WS_WUP = 16 * MiB;
constexpr size_t WS_WDN = 32 * MiB;
constexpr size_t WS_WGATE = 48 * MiB;
constexpr size_t WS_WPROJ = 52 * MiB;
constexpr size_t WS_ROPE = 54 * MiB;
constexpr size_t WS_S5TAB = 56 * MiB;
constexpr size_t WS_S5TN = 58 * MiB;
constexpr size_t WS_S5BD = 98 * MiB;
constexpr size_t WS_PB = 118 * MiB;
constexpr size_t WS_XB0 = 136 * MiB;
constexpr size_t WS_XB1 = 170 * MiB;
constexpr size_t WS_Z = 204 * MiB;
constexpr size_t WS_CKVB = 296 * MiB;
constexpr size_t WS_SSQ = 305 * MiB;
constexpr size_t WS_LG = 306 * MiB;
constexpr size_t WS_QRAW = 340 * MiB;
constexpr size_t WS_KVRAW = 366 * MiB;
constexpr size_t WS_QF = 400 * MiB;
constexpr size_t WS_KF = 426 * MiB;
constexpr size_t WS_VT = 452 * MiB;
constexpr size_t WS_MIX = 470 * MiB;
constexpr size_t WS_A1 = 504 * MiB;
constexpr size_t WS_PP = 638 * MiB;
constexpr size_t WS_GU = 706 * MiB;
constexpr size_t WS_GDEC = 771 * MiB;
constexpr size_t WS_GSP = 772 * MiB;
constexpr size_t WS_U2 = 920 * MiB;
constexpr size_t WS_S5E = 970 * MiB;
constexpr size_t WS_GG = 866 * MiB;
constexpr size_t WS_QS = 900 * MiB;
constexpr size_t WS_SPART = 904 * MiB;
constexpr size_t WS_SL = 913 * MiB;
constexpr size_t WS_END = 1004 * MiB;

DI unsigned f2bf(float f) { unsigned u = __builtin_bit_cast(unsigned, f); return (u + 0x7fffu + ((u >> 16) & 1u)) >> 16; }
DI unsigned pk2(float lo, float hi) { f32x2 v = {lo, hi}; bf16x2_t b = __builtin_convertvector(v, bf16x2_t); return __builtin_bit_cast(unsigned, b); }
DI float bf2f(unsigned short b) { return __builtin_bit_cast(float, (unsigned)b << 16); }
DI float bflo(unsigned u) { return __builtin_bit_cast(float, u << 16); }
DI float bfhi(unsigned u) { return __builtin_bit_cast(float, u & 0xffff0000u); }
DI float wave_sum(float v) {
#pragma unroll
    for (int o = 1; o < 64; o <<= 1) v += __shfl_xor(v, o);
    return v;
}
DI float sigmoidf_(float x) { return 1.f / (1.f + __expf(-x)); }
DI float row16_sum(float v) {
    v += __builtin_bit_cast(float, __builtin_amdgcn_update_dpp(0, __builtin_bit_cast(int, v), 0x128, 0xf, 0xf, false));
    v += __builtin_bit_cast(float, __builtin_amdgcn_update_dpp(0, __builtin_bit_cast(int, v), 0x124, 0xf, 0xf, false));
    v += __builtin_bit_cast(float, __builtin_amdgcn_update_dpp(0, __builtin_bit_cast(int, v), 0x4E, 0xf, 0xf, false));
    v += __builtin_bit_cast(float, __builtin_amdgcn_update_dpp(0, __builtin_bit_cast(int, v), 0xB1, 0xf, 0xf, false));
    return v; }
DI float row8_sum(float v) {
    v += __builtin_bit_cast(float, __builtin_amdgcn_update_dpp(0, __builtin_bit_cast(int, v), 0xB1, 0xf, 0xf, false));
    v += __builtin_bit_cast(float, __builtin_amdgcn_update_dpp(0, __builtin_bit_cast(int, v), 0x4E, 0xf, 0xf, false));
    v += __builtin_bit_cast(float, __builtin_amdgcn_update_dpp(0, __builtin_bit_cast(int, v), 0x141, 0xf, 0xf, false));
    return v; }
#define LDS_WAIT() asm volatile("s_waitcnt lgkmcnt(0)" ::: "memory")
#define VM_WAIT() asm volatile("s_waitcnt vmcnt(0)" ::: "memory")

#define XB_TMO      128
#define XB_XCNT(j)  (256  + 64 * (j))
#define XB_XSUB(j)  (1280 + 64 * (j))
#define XB_XGEN(j)  (2304 + 64 * (j))
#define XB_TOP      3328
#define XB_TOPGEN   3392
#define XCD_BAR_WORDS 3456
#define XB_SPIN_CAP (1u << 18)
static_assert(CW_BAR + XCD_BAR_WORDS <= CW_SS, "ctl map");
DI unsigned xb_ld(unsigned* p)              { return __hip_atomic_load(p, __ATOMIC_RELAXED, __HIP_MEMORY_SCOPE_AGENT); }
DI unsigned xb_add(unsigned* p, unsigned v) { return __hip_atomic_fetch_add(p, v, __ATOMIC_RELAXED, __HIP_MEMORY_SCOPE_AGENT); }
DI unsigned xb_xcc_id() { return (unsigned)__builtin_amdgcn_s_getreg((3 << 11) | 20) & 0xFu; }
#define XB_SPIN(cond, bar) do { unsigned _sp = 0; while (cond) { __builtin_amdgcn_s_sleep(1); \
    if ((++_sp & 255u) == 0u) { if (xb_ld(&(bar)[XB_TMO])) break; if (_sp > XB_SPIN_CAP) { atomicAdd(&(bar)[XB_TMO], 1u); break; } } } } while (0)
struct XcdBarrier { unsigned* bar; unsigned x; volatile LAS unsigned* st; };
DI XcdBarrier xcd_barrier_post(unsigned* bar, volatile LAS unsigned* st) {
    XcdBarrier b; b.bar = bar; b.x = xb_xcc_id(); b.st = st;
    if (threadIdx.x == 0) (void)xb_add(&bar[XB_XCNT(b.x)], 1u);
    return b;
}
DI void xcd_barrier_complete(unsigned* bar, unsigned x, unsigned& nloc, unsigned& nx) {
    const unsigned G = gridDim.x * gridDim.y * gridDim.z;
    unsigned sum, cnt, mine, sp = 0u;
    for (;;) {
        sum = 0u; cnt = 0u; mine = 0u;
#pragma unroll
        for (unsigned j = 0; j < 16; ++j) { const unsigned c = xb_ld(&bar[XB_XCNT(j)]); sum += c; cnt += (c > 0u) ? 1u : 0u; mine = (j == x) ? c : mine; }
        if (sum == G) break;
        __builtin_amdgcn_s_sleep(1);
        if ((++sp & 255u) == 0u) { if (xb_ld(&bar[XB_TMO])) break; if (sp > XB_SPIN_CAP) { atomicAdd(&bar[XB_TMO], 1u); break; } }
    }
    nloc = mine > 0u ? mine : 1u; nx = cnt > 0u ? cnt : 1u;
}
DI void xcd_barrier(const XcdBarrier& b) {
    asm volatile("s_waitcnt vmcnt(0)" ::: "memory");
    __syncthreads();
    if (threadIdx.x == 0) {
        unsigned* bar = b.bar;
        __builtin_amdgcn_s_waitcnt(0);
        unsigned nloc = b.st[0], nx = b.st[1];
        if (nloc == 0u) { xcd_barrier_complete(bar, b.x, nloc, nx); b.st[0] = nloc; b.st[1] = nx; }
        const unsigned old = xb_add(&bar[XB_XSUB(b.x)], 1u);
        const unsigned gen = old / nloc;
        if (old + 1u == (gen + 1u) * nloc) {
            __builtin_amdgcn_fence(__ATOMIC_RELEASE, "agent");
            asm volatile("s_waitcnt vmcnt(0)" ::: "memory");
            const unsigned og = xb_add(&bar[XB_TOP], 1u);
            const unsigned tg = og / nx;
            if (og + 1u == (tg + 1u) * nx) xb_add(&bar[XB_TOPGEN], 1u);
            else XB_SPIN(xb_ld(&bar[XB_TOPGEN]) == tg, bar);
            __builtin_amdgcn_fence(__ATOMIC_ACQUIRE, "agent");
            xb_add(&bar[XB_XGEN(b.x)], 1u);
            asm volatile("s_waitcnt vmcnt(0)" ::: "memory");
        } else {
            XB_SPIN(xb_ld(&bar[XB_XGEN(b.x)]) == gen, bar);
            __builtin_amdgcn_fence(__ATOMIC_ACQUIRE, "agent");
            asm volatile("s_waitcnt vmcnt(0)" ::: "memory");
        }
    }
    __syncthreads();
}
namespace pg8 {
constexpr int BM = 256, BK = 64, HALF = 128, HTB = HALF * BK * 2, STAGE_BYTES = 8 * HTB, NXCD = 8, WGM = 4;
__host__ __device__ __forceinline__ int lds_byte(int r, int c) { const int st = (r >> 4) * 2 + (c >> 5), rr = r & 15, cc = c & 31, ob = rr * 64 + cc * 2; return st * 1024 + (ob ^ (((ob >> 9) & 1) << 5)); }
__host__ __device__ __forceinline__ void stage_rc(int b, int& R, int& C) { const int st = b / 1024, sb = b % 1024, swz = sb ^ (((sb >> 9) & 1) << 5); R = (st >> 1) * 16 + swz / 64; C = (st & 1) * 32 + (swz % 64) / 2; }
__host__ __device__ __forceinline__ int perm32(int rho) { const int n = rho >> 4, i = rho & 15; return 8 * (i >> 2) + 4 * n + (i & 3); }

struct Unit { int pm, pn; size_t aoff, boff; };
struct Gemm { const bf16* A; const bf16* Bt; int lda, ldb, K; };

struct GridOrder {
    int nM, nN, nwg, G, c;
    DI void init(int nM_, int nN_, int G_, int c_) { nM = nM_; nN = nN_; nwg = nM * nN; G = G_; c = c_; }
    DI bool next(int i, Unit& u) const {
        const long L = (long)i * G + c; if (L >= nwg) return false;
        int wgid = (int)L; { const int q = nwg / NXCD, r = nwg % NXCD, xcd = wgid % NXCD, off = wgid / NXCD; wgid = (xcd < r ? xcd * (q + 1) : r * (q + 1) + (xcd - r) * q) + off; }
        const int nig = WGM * nN, gid = wgid / nig, fm = gid * WGM, gsz = (nM - fm) < WGM ? (nM - fm) : WGM;
        u.pm = fm + ((wgid % nig) % gsz); u.pn = (wgid % nig) / gsz; u.aoff = 0; u.boff = 0; return true;
    }
};
struct BatchOrder {
    int nM, nN, nb, G, c; size_t astride, bstride;
    DI void init(int nb_, int nM_, int nN_, size_t as_, size_t bs_, int G_, int c_) { nb = nb_; nM = nM_; nN = nN_; astride = as_; bstride = bs_; G = G_; c = c_; }
    DI bool next(int i, Unit& u) const {
        const long L = (long)i * G + c; if (L >= (long)nb * nM * nN) return false;
        const int per = nM * nN, b = (int)(L / per), r = (int)(L % per);
        u.pm = r / nN; u.pn = r % nN; u.aoff = (size_t)b * astride; u.boff = (size_t)b * bstride; return true;
    }
};

template <class Epi, class Sched, bool ALIGN_EPI = false, bool KUNROLL1 = false>
DI void gemm_phase(LAS unsigned char* lds, const Gemm g, const Sched& S, const Epi& E) {
    const int tid = threadIdx.x, wid = __builtin_amdgcn_readfirstlane(tid >> 6), lane = tid & 63, wr = wid >> 2, wc = wid & 3, fr = lane & 15, fq = lane >> 4;
    const int K = g.K, nt = K / BK;
    unsigned voffA[2], voffB[2];
#pragma unroll
    for (int i = 0; i < 2; ++i) { int R, C; stage_rc(tid * 16 + i * 8192, R, C); const int Rb = Epi::PERM ? ((R & ~31) + perm32(R & 31)) : R;
        voffA[i] = (unsigned)(R * g.lda + C) * 2u; voffB[i] = (unsigned)(Rb * g.ldb + C) * 2u; }
    const size_t kstep = (size_t)(BK * 2);
    const size_t hstepA = (size_t)HALF * g.lda * 2, hstepB = (size_t)HALF * g.ldb * 2;
    const size_t tstepA = 2 * hstepA, tstepB = 2 * hstepB;
    const unsigned ldsw = (unsigned)wid * 1024u;
    const int aoff = lds_byte(wr * 64 + fr, fq * 8), boff = lds_byte(wc * 32 + fr, fq * 8);
#define PG8_SA(b, h) (((b) * 2 + (h)) * HTB)
#define PG8_SB(b, h) ((4 + (b) * 2 + (h)) * HTB)
#define PG8_STAGE(bufoff, gbase, voff) do { _Pragma("unroll") for (int _i = 0; _i < 2; ++_i) \
        __builtin_amdgcn_global_load_lds((const unsigned*)((const char*)(gbase) + (voff)[_i]), (LAS unsigned*)(lds + (bufoff) + ldsw + _i * 8192), 16, 0, 0); } while (0)
#define PG8_LDA(dst, b, h) do { _Pragma("unroll") for (int m = 0; m < 4; ++m) _Pragma("unroll") for (int k = 0; k < 2; ++k) dst[m][k] = *(const LAS bf16x8*)(lds + PG8_SA(b, h) + aoff + m * 2048 + k * 1024); } while (0)
#define PG8_LDB(dst, b, h) do { _Pragma("unroll") for (int n = 0; n < 2; ++n) _Pragma("unroll") for (int k = 0; k < 2; ++k) dst[n][k] = *(const LAS bf16x8*)(lds + PG8_SB(b, h) + boff + n * 2048 + k * 1024); } while (0)
#define PG8_MMA(ai, bj, At, Bt) do { __builtin_amdgcn_s_setprio(1); _Pragma("unroll") for (int m = 0; m < 4; ++m) _Pragma("unroll") for (int n = 0; n < 2; ++n) _Pragma("unroll") for (int k = 0; k < 2; ++k) \
        acc[ai][bj][m][n] = __builtin_amdgcn_mfma_f32_16x16x32_bf16(Bt[n][k], At[m][k], acc[ai][bj][m][n], 0, 0, 0); __builtin_amdgcn_s_setprio(0); } while (0)
#define PG8_WAIT_V(n) asm volatile("s_waitcnt vmcnt(" #n ")" ::: "memory")
#define PG8_WAIT_L(n) asm volatile("s_waitcnt lgkmcnt(" #n ")" ::: "memory")
#define PG8_BAR __builtin_amdgcn_s_barrier()
#define PG8_SCHED __builtin_amdgcn_sched_barrier(0)
    Unit cur, nxt; int ui = 0;
    if (!S.next(0, cur)) return;
    f32x4 acc[2][2][4][2];
#pragma unroll
    for (int a = 0; a < 2; ++a)
#pragma unroll
        for (int b = 0; b < 2; ++b)
#pragma unroll
            for (int m = 0; m < 4; ++m)
#pragma unroll
                for (int n = 0; n < 2; ++n) acc[a][b][m][n] = (f32x4){0.f, 0.f, 0.f, 0.f};
    bf16x8 At[4][2], B0[2][2], B1[2][2];
    const char* cA = (const char*)g.A + cur.aoff + (size_t)cur.pm * tstepA; const char* cB = (const char*)g.Bt + cur.boff + (size_t)cur.pn * tstepB;
    PG8_STAGE(PG8_SB(0, 0), cB, voffB); PG8_STAGE(PG8_SB(0, 1), cB + hstepB, voffB); PG8_STAGE(PG8_SA(0, 0), cA, voffA); PG8_STAGE(PG8_SA(0, 1), cA + hstepA, voffA);
    if (wr == 1) PG8_BAR;
    PG8_WAIT_V(2); PG8_BAR;
    PG8_STAGE(PG8_SB(1, 0), cB + kstep, voffB); PG8_STAGE(PG8_SA(1, 0), cA + kstep, voffA); PG8_STAGE(PG8_SB(1, 1), cB + hstepB + kstep, voffB);
    PG8_WAIT_V(6); PG8_BAR;
    for (;;) {
        const bool has_next = S.next(ui + 1, nxt);
        const char* nA = has_next ? (const char*)g.A + nxt.aoff + (size_t)nxt.pm * tstepA : cA; const char* nB = has_next ? (const char*)g.Bt + nxt.boff + (size_t)nxt.pn * tstepB : cB;
        int nt_ = nt; if constexpr (KUNROLL1) asm volatile("" : "+s"(nt_));
        for (int t = 0; t < nt_; t += 2) {
            const bool last = (t == nt_ - 2);
            const char* a1 = cA + (size_t)(t + 1) * kstep;
            const char* a2 = last ? nA : cA + (size_t)(t + 2) * kstep; const char* b2 = last ? nB : cB + (size_t)(t + 2) * kstep;
            const char* a3 = a2 + kstep; const char* b3 = b2 + kstep;
            PG8_LDB(B0, 0, 0); PG8_LDB(B1, 0, 1); PG8_SCHED; PG8_LDA(At, 0, 0); PG8_STAGE(PG8_SA(1, 1), a1 + hstepA, voffA);
            PG8_WAIT_V(8); PG8_WAIT_L(0); PG8_BAR; PG8_MMA(0, 0, At, B0); PG8_MMA(0, 1, At, B1); PG8_BAR; PG8_SCHED;
            PG8_LDA(At, 0, 1); PG8_STAGE(PG8_SB(0, 0), b2, voffB); PG8_STAGE(PG8_SB(0, 1), b2 + hstepB, voffB); PG8_STAGE(PG8_SA(0, 0), a2, voffA);
            PG8_WAIT_V(8); PG8_WAIT_L(0); PG8_BAR; PG8_MMA(1, 0, At, B0); PG8_MMA(1, 1, At, B1); PG8_BAR; PG8_SCHED;
            PG8_LDB(B0, 1, 0); PG8_LDB(B1, 1, 1); PG8_SCHED; PG8_LDA(At, 1, 0); PG8_STAGE(PG8_SA(0, 1), a2 + hstepA, voffA);
            PG8_WAIT_V(8); PG8_WAIT_L(0); PG8_BAR; PG8_MMA(0, 0, At, B0); PG8_MMA(0, 1, At, B1); PG8_BAR; PG8_SCHED;
            PG8_LDA(At, 1, 1); PG8_STAGE(PG8_SB(1, 0), b3, voffB); PG8_STAGE(PG8_SB(1, 1), b3 + hstepB, voffB); PG8_STAGE(PG8_SA(1, 0), a3, voffA);
            PG8_WAIT_V(8); PG8_WAIT_L(0); PG8_BAR; PG8_MMA(1, 0, At, B0); PG8_MMA(1, 1, At, B1); PG8_BAR; PG8_SCHED;
        }
        if constexpr (ALIGN_EPI) { if (wr == 0) PG8_BAR; }
        E(acc, cur, wr, wc, fr, fq);
        if (!has_next) break;
#pragma unroll
        for (int a = 0; a < 2; ++a)
#pragma unroll
            for (int b = 0; b < 2; ++b)
#pragma unroll
                for (int m = 0; m < 4; ++m)
#pragma unroll
                    for (int n = 0; n < 2; ++n) acc[a][b][m][n] = (f32x4){0.f, 0.f, 0.f, 0.f};
        cur = nxt; cA = nA; cB = nB; ++ui;
        if constexpr (ALIGN_EPI) { if (wr == 1) PG8_BAR; }
    }
    PG8_WAIT_V(0);
    if constexpr (!ALIGN_EPI) { if (wr == 0) PG8_BAR; }
    PG8_BAR;
#undef PG8_SA
#undef PG8_SB
#undef PG8_STAGE
#undef PG8_LDA
#undef PG8_LDB
#undef PG8_MMA
#undef PG8_WAIT_V
#undef PG8_WAIT_L
#undef PG8_BAR
#undef PG8_SCHED
}

template <int MODE> struct EpiBf16 {
    static constexpr bool PERM = true;
    bf16* O; int ldc; const float* ss; float ssdiv;
    DI void operator()(const f32x4 (&acc)[2][2][4][2], const Unit& u, int wr, int wc, int fr, int fq) const {
        const int row0 = u.pm * BM + wr * 64 + fr, col0 = u.pn * BM + wc * 32 + 8 * fq;
#pragma unroll
        for (int ai = 0; ai < 2; ++ai)
#pragma unroll
            for (int m = 0; m < 4; ++m) { const int row = row0 + ai * HALF + m * 16; bf16* rowp = O + (size_t)row * ldc + col0;
                float r = 1.f; if (ss) r = __builtin_amdgcn_rsqf(ss[row] * ssdiv + EPS);
#pragma unroll
                for (int bj = 0; bj < 2; ++bj) { f32x4 v0 = acc[ai][bj][m][0] * r, v1 = acc[ai][bj][m][1] * r;
                    if (MODE == 1) {
#pragma unroll
                        for (int j = 0; j < 4; ++j) { const float a = fmaxf(v0[j], 0.f), b = fmaxf(v1[j], 0.f); v0[j] = a * a; v1[j] = b * b; } }
                    u32x4 w; w.x = pk2(v0[0], v0[1]); w.y = pk2(v0[2], v0[3]); w.z = pk2(v1[0], v1[1]); w.w = pk2(v1[2], v1[3]);
                    *(u32x4*)(rowp + bj * HALF) = w; } }
    }
};
struct EpiZ {
    static constexpr bool PERM = true;
    bf16* O; const float* ss; float* ssq;
    DI void operator()(const f32x4 (&acc)[2][2][4][2], const Unit& u, int wr, int wc, int fr, int fq) const {
        const int row0 = u.pm * BM + wr * 64 + fr, col0 = u.pn * BM + wc * 32 + 8 * fq;
#pragma unroll
        for (int ai = 0; ai < 2; ++ai)
#pragma unroll
            for (int m = 0; m < 4; ++m) { const int row = row0 + ai * HALF + m * 16; bf16* rowp = O + (size_t)row * ZW + col0;
                const float r = __builtin_amdgcn_rsqf(ss[row] * (1.f / DM) + EPS);
#pragma unroll
                for (int bj = 0; bj < 2; ++bj) { const f32x4 v0 = acc[ai][bj][m][0] * r, v1 = acc[ai][bj][m][1] * r;
                    u32x4 w; w.x = pk2(v0[0], v0[1]); w.y = pk2(v0[2], v0[3]); w.z = pk2(v1[0], v1[1]); w.w = pk2(v1[2], v1[3]);
                    *(u32x4*)(rowp + bj * HALF) = w;
                    const int blk = u.pn * 2 + bj;
                    if (blk < 5) { float s = ((v0[0] * v0[0] + v0[1] * v0[1]) + (v0[2] * v0[2] + v0[3] * v0[3])) + ((v1[0] * v1[0] + v1[1] * v1[1]) + (v1[2] * v1[2] + v1[3] * v1[3]));
                        s += __shfl_xor(s, 16); s += __shfl_xor(s, 32); if (fq == 0) atomicAdd(ssq + (blk < 3 ? 0 : MT) + row, s); } } }
    }
};
template <int MODE> struct EpiRes {
    static constexpr bool PERM = false;
    const float* base0; const float* base1;
    const bf16* baseb;
    float* H; bf16* XB; float* ssout; const float* ssin; const bf16* PP;
    DI void operator()(const f32x4 (&acc)[2][2][4][2], const Unit& u, int wr, int wc, int fr, int fq) const {
        const int row0 = u.pm * BM + wr * 64 + fr, col0 = u.pn * BM + wc * 32 + 4 * fq;
#pragma unroll
        for (int ai = 0; ai < 2; ++ai)
#pragma unroll
            for (int m = 0; m < 4; ++m) { const int row = row0 + ai * HALF + m * 16;
                const float* bp = (row < MP) ? base0 + (size_t)row * DM : base1 + (size_t)(row - MP) * DM;
                float r = 1.f; if (MODE == 1) r = __builtin_amdgcn_rsqf(ssin[row] * (1.f / DM) + EPS);
                float s = 0.f;
#pragma unroll
                for (int bj = 0; bj < 2; ++bj)
#pragma unroll
                    for (int n = 0; n < 2; ++n) { const int col = col0 + bj * HALF + n * 16;
                        f32x4 v = acc[ai][bj][m][n];
                        if (MODE == 1) { const u32x2 pw = *(const u32x2*)(PP + (size_t)row * DM + col);
                            v[0] = sigmoidf_(v[0] * r) * bflo(pw.x); v[1] = sigmoidf_(v[1] * r) * bfhi(pw.x); v[2] = sigmoidf_(v[2] * r) * bflo(pw.y); v[3] = sigmoidf_(v[3] * r) * bfhi(pw.y); }
                        f32x4 h;
                        if (baseb) { const u32x2 bw = *(const u32x2*)(baseb + (size_t)row * DM + col); h = (f32x4){bflo(bw.x), bfhi(bw.x), bflo(bw.y), bfhi(bw.y)} + v; }
                        else h = *(const f32x4*)(bp + col) + v;
                        if (H) *(f32x4*)(H + (size_t)row * DM + col) = h;
                        if (XB) { u32x2 w; w.x = pk2(h[0], h[1]); w.y = pk2(h[2], h[3]); *(u32x2*)(XB + (size_t)row * DM + col) = w; }
                        s += (h[0] * h[0] + h[1] * h[1]) + (h[2] * h[2] + h[3] * h[3]); }
                if (ssout) { s += __shfl_xor(s, 16); s += __shfl_xor(s, 32); if (fq == 0) atomicAdd(ssout + row, s); } }
    }
};
struct EpiGlu {
    static constexpr bool PERM = false;
    const bf16* baseb; bf16* XB; float* ssout;
    DI void operator()(const f32x4 (&acc)[2][2][4][2], const Unit& u, int wr, int wc, int fr, int fq) const {
        const int row0 = u.pm * BM + wr * 64 + fr, col0 = u.pn * HALF + wc * 32 + 4 * fq;
#pragma unroll
        for (int ai = 0; ai < 2; ++ai)
#pragma unroll
            for (int m = 0; m < 4; ++m) { const int row = row0 + ai * HALF + m * 16; float s = 0.f;
#pragma unroll
                for (int n = 0; n < 2; ++n) { const int col = col0 + n * 16; const f32x4 v = acc[ai][0][m][n], gt = acc[ai][1][m][n];
                    const u32x2 bw = *(const u32x2*)(baseb + (size_t)row * DM + col); f32x4 h = {bflo(bw.x), bfhi(bw.x), bflo(bw.y), bfhi(bw.y)};
#pragma unroll
                    for (int j = 0; j < 4; ++j) h[j] += v[j] * sigmoidf_(gt[j]);
                    u32x2 w; w.x = pk2(h[0], h[1]); w.y = pk2(h[2], h[3]); *(u32x2*)(XB + (size_t)row * DM + col) = w;
                    s += (h[0] * h[0] + h[1] * h[1]) + (h[2] * h[2] + h[3] * h[3]); }
                s += __shfl_xor(s, 16); s += __shfl_xor(s, 32); if (fq == 0) atomicAdd(ssout + row, s); }
    }
};
}
struct Args { const void* in[38]; float* out; unsigned char* ws; int ph_lo, ph_hi; };
enum { I_XP = 0, I_XS, I_CCKV, I_CKPE, I_SGLA, I_S5RE, I_S5IM, I_PT, I_PP, I_PS, I_GNAB, I_WIN, I_GQLAT, I_WUQ, I_GKVLAT, I_WUKV, I_GQH, I_GKH,
       I_WA2, I_BA, I_GGLAO, I_WOUT, I_GNC, I_S5ARE, I_S5AIM, I_S5LDT, I_S5BRE, I_S5BIM, I_S5CRE, I_S5CIM, I_S5D, I_WGLU, I_GNMLP, I_WUP, I_WDN, I_GNPLE, I_WGATE, I_WPROJ };
constexpr int NWAVES = 8, NTHR = 512;
constexpr int LDS_BYTES = 163840;
constexpr int RING_BYTES = 131072;
constexpr int MISC_OFF = 163840 - 256;

struct MapId { DI int operator()(int n) const { return n; } };
struct MapZ {
    DI int operator()(int n) const {
        if (n < 640) return n;
        if (n < 1152) return 672 + (n - 640);
        if (n < 1664) return 1184 + (n - 1152);
        if (n < 2176) return 1696 + (n - 1664);
        if (n < 2688) return 2224 + (n - 2176);
        if (n < 2720) return 640 + (n - 2688);
        if (n < 2736) return 2208 + (n - 2720);
        return -1; }
};
struct MapGlu { DI int operator()(int n) const { const int pn = n >> 8, rr = n & 255; return rr < 128 ? 128 * pn + rr : 1024 + 128 * pn + (rr - 128); } };
template <class Map> DI void transpose_item(const float* W, int K, int N, int Nout, bf16* WT, const float* gain, Map map, LAS float* scr, int item, int lane) {
    const int nblk = Nout / 32, kb = item / nblk, nb = item % nblk, k0 = 64 * kb, n0 = 32 * nb;
    const int n4 = (lane & 7) * 4, kr = lane >> 3, ns = map(n0 + n4);
    f32x4 v[8];
#pragma unroll
    for (int i = 0; i < 8; ++i) { const int kk = kr + 8 * i; v[i] = (f32x4){0.f, 0.f, 0.f, 0.f};
        if (ns >= 0) { v[i] = __builtin_nontemporal_load((const f32x4*)(W + (size_t)(k0 + kk) * N + ns)); if (gain) v[i] = v[i] * gain[k0 + kk]; } }
#pragma unroll
    for (int i = 0; i < 8; ++i) { LAS float* d = scr + (kr + 8 * i) * 33 + n4; d[0] = v[i].x; d[1] = v[i].y; d[2] = v[i].z; d[3] = v[i].w; }
    LDS_WAIT(); asm volatile("" ::: "memory");
    const int c = lane & 7;
#pragma unroll
    for (int j = 0; j < 4; ++j) { const int n = (lane >> 3) + 8 * j; const LAS float* s = scr + (8 * c) * 33 + n;
        u32x4 o; o.x = pk2(s[0 * 33], s[1 * 33]); o.y = pk2(s[2 * 33], s[3 * 33]); o.z = pk2(s[4 * 33], s[5 * 33]); o.w = pk2(s[6 * 33], s[7 * 33]);
        *(u32x4*)(WT + (size_t)(n0 + n) * K + k0 + 8 * c) = o; }
    LDS_WAIT(); asm volatile("" ::: "memory");
}

DI void s5_setup_item(const Args& a, LAS unsigned char* lds, int g, int qt, int tid) {
    LAS float* LPr = (LAS float*)lds;
    LAS float* LPi = LPr + 64 * 34;
    LAS float* BBr = LPi + 64 * 34;
    LAS float* BBi = BBr + 64 * 16;
    LAS float* Cr = BBi + 64 * 16;
    LAS float* Ci = Cr + 16 * 64;
    LAS float* KT = Ci + 16 * 64;
    const float* are = (const float*)a.in[I_S5ARE] + g * 64; const float* aim = (const float*)a.in[I_S5AIM] + g * 64;
    const float dt = expf(((const float*)a.in[I_S5LDT])[g]);
    float* tab = (float*)(a.ws + WS_S5TAB);
    __syncthreads();
    for (int i = tid; i < 64 * 17; i += NTHR) { const int p = i / 17, tau = i % 17;
        const float ar = are[p] * dt * (float)tau, ai = aim[p] * dt * (float)tau, mg = expf(ar);
        LPr[p * 34 + tau] = mg * cosf(ai); LPi[p * 34 + tau] = mg * sinf(ai); }
    for (int i = tid; i < 64 * 16; i += NTHR) { const int p = i >> 4, c = i & 15;
        const float ar = are[p], ai = aim[p], mg = expf(ar * dt), lr = mg * cosf(ai * dt), li = mg * sinf(ai * dt), den = ar * ar + ai * ai;
        const float cr = ((lr - 1.0f) * ar + li * ai) / den, ci = (li * ar - (lr - 1.0f) * ai) / den;
        const float br = ((const float*)a.in[I_S5BRE])[((size_t)g * 64 + p) * 16 + c], bi = ((const float*)a.in[I_S5BIM])[((size_t)g * 64 + p) * 16 + c];
        BBr[i] = cr * br - ci * bi; BBi[i] = cr * bi + ci * br;
        const int co = i >> 6, pp = i & 63;
        Cr[i] = ((const float*)a.in[I_S5CRE])[((size_t)g * 16 + co) * 64 + pp]; Ci[i] = ((const float*)a.in[I_S5CIM])[((size_t)g * 16 + co) * 64 + pp]; }
    __syncthreads();
    if (qt == 0) {
        for (int i = tid; i < 64; i += NTHR) { float* L = tab + ((size_t)g * 64 + i) * 2; L[0] = LPr[i * 34 + 1]; L[1] = LPi[i * 34 + 1];
            float* LT = tab + 8192 + ((size_t)g * 64 + i) * 2; LT[0] = LPr[i * 34 + 16]; LT[1] = LPi[i * 34 + 16]; }
        for (int i = tid; i < 1024; i += NTHR) { float* B = tab + 16384 + ((size_t)g * 1024 + i) * 2; B[0] = BBr[i]; B[1] = BBi[i]; }
    }
    if (tid < 256) { const int tau = tid >> 4, co = tid & 15; float acc[16];
#pragma unroll
        for (int j = 0; j < 16; ++j) acc[j] = 0.f;
        for (int p = 0; p < 64; ++p) { const float lr = LPr[p * 34 + tau], li = LPi[p * 34 + tau], cr = Cr[co * 64 + p], ci = Ci[co * 64 + p];
            const float tr = cr * lr - ci * li, ti = cr * li + ci * lr;
#pragma unroll
            for (int q = 0; q < 4; ++q) { const f32x4 br = *(const LAS f32x4*)(BBr + p * 16 + 4 * q), bi = *(const LAS f32x4*)(BBi + p * 16 + 4 * q);
                acc[4 * q + 0] += tr * br.x - ti * bi.x; acc[4 * q + 1] += tr * br.y - ti * bi.y; acc[4 * q + 2] += tr * br.z - ti * bi.z; acc[4 * q + 3] += tr * br.w - ti * bi.w; } }
#pragma unroll
        for (int j = 0; j < 16; ++j) KT[(tau * 16 + co) * 16 + j] = acc[j]; }
    __syncthreads();
    LAS float* LTr = KT + 32 * 256; LAS float* LTi = LTr + 33 * 68;
    for (int i = tid; i < 64 * 17; i += NTHR) { const int p = i & 63, tau = i >> 6; LTr[tau * 68 + p] = LPr[p * 34 + tau]; LTi[tau * 68 + p] = LPi[p * 34 + tau]; }
    __syncthreads();
    bf16* TN = (bf16*)(a.ws + WS_S5TN) + (size_t)g * 256 * S5K;
    for (int i = tid; i < 64 * 48; i += NTHR) { const int row = 64 * qt + i / 48, kg = i % 48, t = row >> 4, co = row & 15; f32x4 v0 = {0.f, 0.f, 0.f, 0.f}, v1 = {0.f, 0.f, 0.f, 0.f};
        if (kg < 32) { const int sidx = kg >> 1, hf = kg & 1; if (sidx <= t) { const LAS f32x4* kp = (const LAS f32x4*)(KT + ((t - sidx) * 16 + co) * 16 + 8 * hf); v0 = kp[0]; v1 = kp[1]; } }
        else { const int p0 = ((kg - 32) & 7) * 8; const bool im = kg >= 40;
            const LAS f32x4* cr4 = (const LAS f32x4*)(Cr + co * 64 + p0); const LAS f32x4* ci4 = (const LAS f32x4*)(Ci + co * 64 + p0);
            const LAS f32x4* lr4 = (const LAS f32x4*)(LTr + (t + 1) * 68 + p0); const LAS f32x4* li4 = (const LAS f32x4*)(LTi + (t + 1) * 68 + p0);
            if (!im) { v0 = cr4[0] * lr4[0] - ci4[0] * li4[0]; v1 = cr4[1] * lr4[1] - ci4[1] * li4[1]; }
            else { v0 = -(cr4[0] * li4[0] + ci4[0] * lr4[0]); v1 = -(cr4[1] * li4[1] + ci4[1] * lr4[1]); } }
        u32x4 o; o.x = pk2(v0.x, v0.y); o.y = pk2(v0.z, v0.w); o.z = pk2(v1.x, v1.y); o.w = pk2(v1.z, v1.w);
        *(u32x4*)(TN + (size_t)row * S5K + kg * 8) = o; }
    bf16* BD = (bf16*)(a.ws + WS_S5BD) + (size_t)(g >> 1) * 256 * (2 * S5K);
    for (int i = tid; i < 32 * 96; i += NTHR) { const int rr = 32 * qt + i / 96, kg = i % 96, reim = rr >> 6, p = rr & 63, row = (g & 1) * 128 + rr; f32x4 v0 = {0.f, 0.f, 0.f, 0.f}, v1 = {0.f, 0.f, 0.f, 0.f};
        const int kgl = kg - (g & 1) * 48;
        if (kgl >= 0 && kgl < 32) { const int t = kgl >> 1, hf = kgl & 1; const float lr = LPr[p * 34 + 15 - t], li = LPi[p * 34 + 15 - t];
            const LAS f32x4* br4 = (const LAS f32x4*)(BBr + p * 16 + 8 * hf); const LAS f32x4* bi4 = (const LAS f32x4*)(BBi + p * 16 + 8 * hf);
            if (reim) { v0 = br4[0] * li + bi4[0] * lr; v1 = br4[1] * li + bi4[1] * lr; } else { v0 = br4[0] * lr - bi4[0] * li; v1 = br4[1] * lr - bi4[1] * li; } }
        u32x4 o; o.x = pk2(v0.x, v0.y); o.y = pk2(v0.z, v0.w); o.z = pk2(v1.x, v1.y); o.w = pk2(v1.z, v1.w);
        *(u32x4*)(BD + (size_t)row * (2 * S5K) + kg * 8) = o; }
}

DI void p0_prologue(const Args& a, LAS unsigned char* lds, int vcu, int G, int tid, int lane, int wave) {
    LAS float* scr = (LAS float*)(lds + wave * 16384);
    const int gw = vcu * NWAVES + wave, NGW = G * NWAVES;
    unsigned char* ws = a.ws;
    constexpr int I_IN = 16 * (ZW / 32), I_UQ = 6 * 24, I_UKV = 2 * 4 * 32, I_OUT = 16 * 32, I_GLU = 16 * 64, I_UP = 16 * 128, I_DN = 64 * 32, I_GATE = 16 * 32, I_PROJ = 4 * 32;
    constexpr int NITEMS = I_IN + I_UQ + I_UKV + I_OUT + I_GLU + 2 * (I_UP + I_DN + I_GATE + I_PROJ);
    for (int it = gw; it < NITEMS; it += NGW) {
        int r = it;
        if (r < I_IN) { transpose_item((const float*)a.in[I_WIN], DM, 2736, ZW, (bf16*)(ws + WS_WIN), (const float*)a.in[I_GNAB], MapZ(), scr, r, lane); continue; } r -= I_IN;
        if (r < I_UQ) { transpose_item((const float*)a.in[I_WUQ], QL, 768, 768, (bf16*)(ws + WS_WUQ), (const float*)a.in[I_GQLAT], MapId(), scr, r, lane); continue; } r -= I_UQ;
        if (r < I_UKV) { if (r < 128) transpose_item((const float*)a.in[I_WUKV], KVL, 1024, 1024, (bf16*)(ws + WS_WUKV), nullptr, MapId(), scr, r, lane);
            else transpose_item((const float*)a.in[I_WUKV], KVL, 1024, 1024, (bf16*)(ws + WS_WUKVG), (const float*)a.in[I_GKVLAT], MapId(), scr, r - 128, lane); continue; } r -= I_UKV;
        if (r < I_OUT) { transpose_item((const float*)a.in[I_WOUT], DM, DM, DM, (bf16*)(ws + WS_WOUT), nullptr, MapId(), scr, r, lane); continue; } r -= I_OUT;
        if (r < I_GLU) { transpose_item((const float*)a.in[I_WGLU], DM, 2048, 2048, (bf16*)(ws + WS_WGLU), nullptr, MapGlu(), scr, r, lane); continue; } r -= I_GLU;
        const int li = r / (I_UP + I_DN + I_GATE + I_PROJ); r -= li * (I_UP + I_DN + I_GATE + I_PROJ);
        if (r < I_UP) { transpose_item((const float*)a.in[I_WUP] + (size_t)li * DM * FF, DM, FF, FF, (bf16*)(ws + WS_WUP) + (size_t)li * FF * DM, (const float*)a.in[I_GNMLP] + li * DM, MapId(), scr, r, lane); continue; } r -= I_UP;
        if (r < I_DN) { transpose_item((const float*)a.in[I_WDN] + (size_t)li * FF * DM, FF, DM, DM, (bf16*)(ws + WS_WDN) + (size_t)li * DM * FF, nullptr, MapId(), scr, r, lane); continue; } r -= I_DN;
        if (r < I_GATE) { transpose_item((const float*)a.in[I_WGATE] + (size_t)li * DM * DM, DM, DM, DM, (bf16*)(ws + WS_WGATE) + (size_t)li * DM * DM, (const float*)a.in[I_GNPLE] + li * DM, MapId(), scr, r, lane); continue; } r -= I_GATE;
        transpose_item((const float*)a.in[I_WPROJ] + (size_t)li * PLE * DM, PLE, DM, DM, (bf16*)(ws + WS_WPROJ) + (size_t)li * DM * PLE, nullptr, MapId(), scr, r, lane);
    }
    float* ss0 = (float*)(ws + WS_SSQ) + MT;
    for (int m0 = gw; m0 < MT; m0 += 4 * NGW) {
        int mr[4]; const f32x4* xr[4]; f32x4 v[4][4];
#pragma unroll
        for (int q = 0; q < 4; ++q) { mr[q] = (m0 + q * NGW < MT) ? m0 + q * NGW : m0;
            xr[q] = (const f32x4*)((mr[q] < MP) ? (const float*)a.in[I_XP] + (size_t)mr[q] * DM : (const float*)a.in[I_XS] + (size_t)(mr[q] - MP) * DM) + lane; }
#pragma unroll
        for (int q = 0; q < 4; ++q)
#pragma unroll
            for (int j = 0; j < 4; ++j) v[q][j] = __builtin_nontemporal_load(xr[q] + 64 * j);
#pragma unroll
        for (int q = 0; q < 4; ++q) { u32x2* o8 = (u32x2*)((bf16*)(ws + WS_XB0) + (size_t)mr[q] * DM) + lane; float s = 0.f;
#pragma unroll
            for (int j = 0; j < 4; ++j) { const f32x4 t = v[q][j]; s += (t.x * t.x + t.y * t.y) + (t.z * t.z + t.w * t.w); u32x2 w; w.x = pk2(t.x, t.y); w.y = pk2(t.z, t.w); o8[64 * j] = w; }
            s = wave_sum(s); if (lane == 0) ss0[mr[q]] = s; }
    }
    { const int gt = vcu * NTHR + tid, NGT = G * NTHR; constexpr int NV = 2 * MT * PLE / 8;
        for (int i0 = gt; i0 < NV; i0 += 4 * NGT) { f32x4 v0[4], v1[4]; int ii[4];
#pragma unroll
            for (int q = 0; q < 4; ++q) { const int i = (i0 + q * NGT < NV) ? i0 + q * NGT : i0; ii[q] = i; const int li = i / (MT * PLE / 8), r = i % (MT * PLE / 8), row = r / (PLE / 8), c8 = r % (PLE / 8);
                const float* src = (row < MP) ? (const float*)a.in[I_PP] + ((size_t)li * MP + row) * PLE : (const float*)a.in[I_PS] + ((size_t)li * MS + (row - MP)) * PLE;
                v0[q] = __builtin_nontemporal_load((const f32x4*)(src + c8 * 8)); v1[q] = __builtin_nontemporal_load((const f32x4*)(src + c8 * 8 + 4)); }
#pragma unroll
            for (int q = 0; q < 4; ++q) { u32x4 o; o.x = pk2(v0[q].x, v0[q].y); o.y = pk2(v0[q].z, v0[q].w); o.z = pk2(v1[q].x, v1[q].y); o.w = pk2(v1[q].z, v1[q].w);
                *(u32x4*)((bf16*)(ws + WS_PB) + (size_t)ii[q] * 8) = o; } } }
    { const int gt = vcu * NTHR + tid, NGT = G * NTHR; float* rc = (float*)(ws + WS_ROPE); float* rs = rc + 8200 * 16;
        for (int i = gt; i < 8200 * 16; i += NGT) { const int pos = i >> 4, k = i & 15; const float fr = powf(10000.0f, -(float)k / 16.0f), ang = (float)pos * fr; rc[i] = cosf(ang); rs[i] = sinf(ang); } }
    for (int it = vcu; it < 256; it += G) s5_setup_item(a, lds, it >> 2, it & 3, tid);
}
constexpr float QSCALE = 0.10206207261596575f * 1.4426950408889634f;
DI u32x4 prep_vec(u32x4 w, int li, int pos, const float* rc, const float* rs, const f32x4& g0, const f32x4& g1, float scale) {
    float x[8] = {bflo(w.x), bfhi(w.x), bflo(w.y), bfhi(w.y), bflo(w.z), bfhi(w.z), bflo(w.w), bfhi(w.w)};
    float ss = ((x[0] * x[0] + x[1] * x[1]) + (x[2] * x[2] + x[3] * x[3])) + ((x[4] * x[4] + x[5] * x[5]) + (x[6] * x[6] + x[7] * x[7]));
    ss = row16_sum(ss);
    const float r = __builtin_amdgcn_rsqf(ss * (1.f / 96.f) + EPS) ;
    float y[8] = {x[0] * r * g0.x, x[1] * r * g0.y, x[2] * r * g0.z, x[3] * r * g0.w, x[4] * r * g1.x, x[5] * r * g1.y, x[6] * r * g1.z, x[7] * r * g1.w};
    float yo[8];
#pragma unroll
    for (int j = 0; j < 8; ++j) yo[j] = __builtin_bit_cast(float, __builtin_amdgcn_update_dpp(0, __builtin_bit_cast(int, y[j]), 0x4E, 0xf, 0xf, false));
    if (li >= 8) { const f32x4 c0 = *(const f32x4*)(rc + pos * 16 + 8 * (li & 1)), c1 = *(const f32x4*)(rc + pos * 16 + 8 * (li & 1) + 4), s0 = *(const f32x4*)(rs + pos * 16 + 8 * (li & 1)), s1 = *(const f32x4*)(rs + pos * 16 + 8 * (li & 1) + 4);
        const float c[8] = {c0.x, c0.y, c0.z, c0.w, c1.x, c1.y, c1.z, c1.w}, sn[8] = {s0.x, s0.y, s0.z, s0.w, s1.x, s1.y, s1.z, s1.w};
#pragma unroll
        for (int j = 0; j < 8; ++j) y[j] = (li < 10) ? (y[j] * c[j] - yo[j] * sn[j]) : (y[j] * c[j] + yo[j] * sn[j]); }
    u32x4 o; o.x = pk2(y[0] * scale, y[1] * scale); o.y = pk2(y[2] * scale, y[3] * scale); o.z = pk2(y[4] * scale, y[5] * scale); o.w = pk2(y[6] * scale, y[7] * scale);
    return o;
}
DI void p4_attn_prep(const Args& a, LAS unsigned char* lds, int vcu, int G, int tid, int lane, int wave) {
    const bf16* QR = (const bf16*)(a.ws + WS_QRAW); const bf16* KV = (const bf16*)(a.ws + WS_KVRAW); const bf16* Z = (const bf16*)(a.ws + WS_Z);
    bf16* QF = (bf16*)(a.ws + WS_QF); bf16* KF = (bf16*)(a.ws + WS_KF);
    const float* rc = (const float*)(a.ws + WS_ROPE); const float* rs = rc + 8200 * 16;
    const float* gqh = (const float*)a.in[I_GQH]; const float* gkh = (const float*)a.in[I_GKH]; const float* gkv = (const float*)a.in[I_GKVLAT];
    const float* ssckv = (const float*)(a.ws + WS_CTL) + CW_SS + 7 * MT; bf16* ckvb = (bf16*)(a.ws + WS_CKVB);
    const int li = lane & 15, gq = lane >> 4, lic = li < 12 ? li : 11;
    const f32x4 gq0 = *(const f32x4*)(gqh + 8 * lic), gq1 = *(const f32x4*)(gqh + 8 * lic + 4), gk0 = *(const f32x4*)(gkh + 8 * lic), gk1 = *(const f32x4*)(gkh + 8 * lic + 4);
    for (int tile = vcu; tile < MP / 64; tile += G) {
        const int row0 = tile * 64;
#pragma unroll 1
        for (int s4 = 0; s4 < 4; ++s4) { u32x4 w[4];
#pragma unroll
            for (int e = 0; e < 4; ++e) { const int idx = (s4 * 4 + e) * 4 + gq, rl = wave * 8 + (idx >> 3), h = idx & 7; const size_t row = (size_t)row0 + rl;
                const bf16* src = li < 8 ? KV + row * 1024 + h * 128 + 8 * li : Z + row * ZW + ZC_KPE + 8 * (lic - 8);
                w[e] = *(const u32x4*)src; if (li >= 12) w[e] = (u32x4){0u, 0u, 0u, 0u}; }
#pragma unroll
            for (int e = 0; e < 4; ++e) { const int idx = (s4 * 4 + e) * 4 + gq, rl = wave * 8 + (idx >> 3), h = idx & 7; const size_t row = (size_t)row0 + rl; const int pos = (int)(row & (SEQ - 1));
                const u32x4 o = prep_vec(w[e], li, pos, rc, rs, gk0, gk1, 1.f);
                if (li < 12) *(u32x4*)(KF + row * 768 + h * 96 + 8 * li) = o; }
        }
#pragma unroll
        for (int rep = 0; rep < 4; ++rep) { const int i8 = tid + NTHR * rep, rl = i8 >> 5, c8 = (i8 & 31) * 8; const size_t row = (size_t)row0 + rl;
            const float r = __builtin_amdgcn_rsqf(ssckv[row] * (1.f / KVL) + EPS); const u32x4 w = *(const u32x4*)(Z + row * ZW + ZC_CKV + c8); const f32x4 g0 = *(const f32x4*)(gkv + c8), g1 = *(const f32x4*)(gkv + c8 + 4);
            float* o = a.out + O_CKVP + row * KVL + c8;
            *(f32x4*)o = (f32x4){bflo(w.x) * r * g0.x, bfhi(w.x) * r * g0.y, bflo(w.y) * r * g0.z, bfhi(w.y) * r * g0.w}; *(f32x4*)(o + 4) = (f32x4){bflo(w.z) * r * g1.x, bfhi(w.z) * r * g1.y, bflo(w.w) * r * g1.z, bfhi(w.w) * r * g1.w}; }
        if (tid < 256) { const int rl = tid >> 2, c8 = (tid & 3) * 8; const size_t row = (size_t)row0 + rl; const u32x4 w = *(const u32x4*)(Z + row * ZW + ZC_KPE + c8); float* o = a.out + O_KPEP + row * ROPE + c8;
            *(f32x4*)o = (f32x4){bflo(w.x), bfhi(w.x), bflo(w.y), bfhi(w.y)}; *(f32x4*)(o + 4) = (f32x4){bflo(w.z), bfhi(w.z), bflo(w.w), bfhi(w.w)}; }
    }
    for (int sr = 2 * vcu; sr < MS; sr += 2 * G) {
        if (wave < 4) { const int idx = wave * 4 + gq, row = MP + sr + (idx >> 3), h = idx & 7; const int pos = PAST + ((row - MP) & 3);
            u32x4 w = *(const u32x4*)(QR + (size_t)row * 768 + h * 96 + 8 * lic); if (li >= 12) w = (u32x4){0u, 0u, 0u, 0u};
            const u32x4 o = prep_vec(w, li, pos, rc, rs, gq0, gq1, QSCALE);
            if (li < 12) *(u32x4*)(QF + (size_t)row * 768 + h * 96 + 8 * li) = o; }
        if (tid < 64) { const int rl = tid >> 5, c8 = (tid & 31) * 8; const size_t srow = (size_t)sr + rl, grow = MP + srow;
            const float rr = __builtin_amdgcn_rsqf(ssckv[grow] * (1.f / KVL) + EPS); const u32x4 w = *(const u32x4*)(Z + grow * ZW + ZC_CKV + c8); const f32x4 g0 = *(const f32x4*)(gkv + c8), g1 = *(const f32x4*)(gkv + c8 + 4);
            const f32x4 v0 = {bflo(w.x) * rr * g0.x, bfhi(w.x) * rr * g0.y, bflo(w.y) * rr * g0.z, bfhi(w.y) * rr * g0.w}, v1 = {bflo(w.z) * rr * g1.x, bfhi(w.z) * rr * g1.y, bflo(w.w) * rr * g1.z, bfhi(w.w) * rr * g1.w};
            float* oo = a.out + O_CKVS + srow * KVL + c8; *(f32x4*)oo = v0; *(f32x4*)(oo + 4) = v1;
            u32x4 ww; ww.x = pk2(v0.x, v0.y); ww.y = pk2(v0.z, v0.w); ww.z = pk2(v1.x, v1.y); ww.w = pk2(v1.z, v1.w); *(u32x4*)(ckvb + grow * KVL + c8) = ww; }
        else if (tid < 72) { const int j = tid - 64, rl = j >> 2, c8 = (j & 3) * 8; const size_t srow = (size_t)sr + rl, grow = MP + srow; const u32x4 w = *(const u32x4*)(Z + grow * ZW + ZC_KPE + c8); float* oo = a.out + O_KPES + srow * ROPE + c8;
            *(f32x4*)oo = (f32x4){bflo(w.x), bfhi(w.x), bflo(w.y), bfhi(w.y)}; *(f32x4*)(oo + 4) = (f32x4){bflo(w.z), bfhi(w.z), bflo(w.w), bfhi(w.w)}; }
    }
}
#define MFMA32(a, b, c) __builtin_amdgcn_mfma_f32_32x32x16_bf16((a), (b), (c), 0, 0, 0)
#define MFMA16(a, b, c) __builtin_amdgcn_mfma_f32_16x16x32_bf16((a), (b), (c), 0, 0, 0)
DI int crow(int r, int hi) { return (r & 3) + 8 * (r >> 2) + 4 * hi; }
DI bf16x8 pack8(const f32x16& x, int s) {
    u32x4 p; p.x = pk2(x[8 * s + 0], x[8 * s + 1]); p.y = pk2(x[8 * s + 2], x[8 * s + 3]); p.z = pk2(x[8 * s + 4], x[8 * s + 5]); p.w = pk2(x[8 * s + 6], x[8 * s + 7]);
    return __builtin_bit_cast(bf16x8, p);
}
DI bf16x8 cat44(u32x2 lo, u32x2 hi) { u32x4 p = {lo.x, lo.y, hi.x, hi.y}; return __builtin_bit_cast(bf16x8, p); }
constexpr float GQS = 0.08838834764831845f;
DI bf16x8 tr_frag(const LAS bf16* base, int stride, int rowA, int rowB, int col0, int lane) {
    const int q = (lane & 15) >> 2, p = lane & 3, blk = (lane >> 4) & 1;
    const LAS bf16* a = base + (rowA + q) * stride + col0 + 16 * blk + 4 * p; const LAS bf16* b = base + (rowB + q) * stride + col0 + 16 * blk + 4 * p;
    const s16x4 lo = __builtin_bit_cast(s16x4, __builtin_amdgcn_ds_read_tr16_b64_v4i16((LAS v4i16_t*)a)), hi = __builtin_bit_cast(s16x4, __builtin_amdgcn_ds_read_tr16_b64_v4i16((LAS v4i16_t*)b));
    return __builtin_shufflevector(lo, hi, 0, 1, 2, 3, 4, 5, 6, 7);
}

DI void gla_a_phase(const Args& a, LAS unsigned char* lds, int vcu, int G, int tid, int lane, int wave) {
    LAS float* bt = (LAS float*)lds;
    LAS bf16* KB = (LAS bf16*)(lds + 32768);
    LAS bf16* VH = (LAS bf16*)(lds + 32768 + 20480);
    LAS float* gas = (LAS float*)(lds + 32768 + 2 * 20480);
    const float* wa2_ = (const float*)a.in[I_WA2]; const float* ba_ = (const float*)a.in[I_BA]; const bf16* Z = (const bf16*)(a.ws + WS_Z);
    float* GU = (float*)(a.ws + WS_GU); float* GDEC = (float*)(a.ws + WS_GDEC);
    const int r32 = lane & 31, h2 = lane >> 5;
    float wcol[16], bias = 0.f; int hcur = -1;
#pragma unroll
    for (int r = 0; r < 16; ++r) wcol[r] = 0.f;
    for (int u = vcu; u < 1024; u += G) {
        const int b = u >> 7, h = (u >> 5) & 3, c = u & 31, row0 = b * SEQ + c * 64;
        __syncthreads();
        if (tid < 128) { const u32x4 w = *(const u32x4*)(Z + (size_t)(row0 + (tid >> 1)) * ZW + ZC_GA + (tid & 1) * 8); LAS f32x4* gd = (LAS f32x4*)(gas + tid * 8);
            gd[0] = (f32x4){bflo(w.x), bfhi(w.x), bflo(w.y), bfhi(w.y)}; gd[1] = (f32x4){bflo(w.z), bfhi(w.z), bflo(w.w), bfhi(w.w)}; }
        __syncthreads();
        { const int dk = tid & 127, sg = tid >> 7; float s = 0.f;
            if (h != hcur) { hcur = h; bias = ba_[h * 128 + dk];
#pragma unroll
                for (int r = 0; r < 16; ++r) wcol[r] = wa2_[r * 512 + h * 128 + dk]; }
#pragma unroll 4
            for (int t = 0; t < 16; ++t) { const LAS f32x4* gp = (const LAS f32x4*)(gas + (sg * 16 + t) * 16); const f32x4 g0 = gp[0], g1 = gp[1], g2 = gp[2], g3 = gp[3];
                float x = bias + ((g0.x * wcol[0] + g0.y * wcol[1]) + (g0.z * wcol[2] + g0.w * wcol[3])) + ((g1.x * wcol[4] + g1.y * wcol[5]) + (g1.z * wcol[6] + g1.w * wcol[7]))
                               + ((g2.x * wcol[8] + g2.y * wcol[9]) + (g2.z * wcol[10] + g2.w * wcol[11])) + ((g3.x * wcol[12] + g3.y * wcol[13]) + (g3.z * wcol[14] + g3.w * wcol[15]));
                s += (fminf(x, 0.f) - __logf(1.f + __expf(-fabsf(x)))) * (1.f / 16.f); bt[(sg * 16 + t) * 128 + dk] = s; }
            __syncthreads();
            float off = 0.f;
#pragma unroll
            for (int q = 0; q < 3; ++q) if (q < sg) off += bt[(q * 16 + 15) * 128 + dk];
            __syncthreads();
#pragma unroll
            for (int t = 0; t < 16; ++t) bt[(sg * 16 + t) * 128 + dk] += off;
            if (sg == 3) GDEC[(size_t)u * 128 + dk] = __expf(s + off); }
        __syncthreads();
#pragma unroll
        for (int rep = 0; rep < 2; ++rep) { const int i8 = tid + NTHR * rep, t = i8 >> 4, d8 = (i8 & 15) * 8; const bf16* zr = Z + (size_t)(row0 + t) * ZW + h * 128 + d8;
            const u32x4 kw = *(const u32x4*)(zr + ZC_GK), vw = *(const u32x4*)(zr + ZC_GV);
            const f32x4 b0 = *(const LAS f32x4*)(bt + t * 128 + d8), b1 = *(const LAS f32x4*)(bt + t * 128 + d8 + 4), B0 = *(const LAS f32x4*)(bt + 63 * 128 + d8), B1 = *(const LAS f32x4*)(bt + 63 * 128 + d8 + 4);
            u32x4 o; o.x = pk2(bflo(kw.x) * __expf(B0.x - b0.x), bfhi(kw.x) * __expf(B0.y - b0.y)); o.y = pk2(bflo(kw.y) * __expf(B0.z - b0.z), bfhi(kw.y) * __expf(B0.w - b0.w));
            o.z = pk2(bflo(kw.z) * __expf(B1.x - b1.x), bfhi(kw.z) * __expf(B1.y - b1.y)); o.w = pk2(bflo(kw.w) * __expf(B1.z - b1.z), bfhi(kw.w) * __expf(B1.w - b1.w));
            *(LAS u32x4*)(KB + t * 160 + d8) = o; *(LAS u32x4*)(VH + t * 160 + d8) = vw; }
        __syncthreads();
        const int dkb = wave >> 1;
#pragma unroll
        for (int e = 0; e < 2; ++e) { const int dvb = 2 * (wave & 1) + e; f32x16 acc = {};
#pragma unroll
            for (int s = 0; s < 4; ++s) { const bf16x8 af = tr_frag(KB, 160, 16 * s + 8 * h2, 16 * s + 8 * h2 + 4, dkb * 32, lane), bfv = tr_frag(VH, 160, 16 * s + 8 * h2, 16 * s + 8 * h2 + 4, dvb * 32, lane);
                acc = MFMA32(af, bfv, acc); }
            float* o = GU + (size_t)u * 16384 + dvb * 32 + r32;
#pragma unroll
            for (int r = 0; r < 16; ++r) o[(size_t)(dkb * 32 + crow(r, h2)) * 128] = acc[r]; }
    }
}

DI void gla_b_phase(const Args& a, int vcu, int G, int tid) {
    const float* GU = (const float*)(a.ws + WS_GU); const float* GDEC = (const float*)(a.ws + WS_GDEC); bf16* GSP = (bf16*)(a.ws + WS_GSP);
    for (int i = vcu * NTHR + tid; i < 32 * 128 * 32; i += G * NTHR) { const int bh = i >> 12, dk = (i >> 5) & 127, dv = (i & 31) * 4;
        f32x4 S = {0.f, 0.f, 0.f, 0.f};
#pragma unroll 4
        for (int c = 0; c < 32; ++c) { const size_t u = (size_t)bh * 32 + c; const f32x4 U = *(const f32x4*)(GU + u * 16384 + dk * 128 + dv); const float d = GDEC[u * 128 + dk];
            u32x2 w; w.x = pk2(S.x, S.y); w.y = pk2(S.z, S.w); *(u32x2*)(GSP + u * 16384 + dk * 128 + dv) = w;
            S = S * d + U; }
        *(f32x4*)(a.out + O_GLAP + (size_t)bh * 16384 + dk * 128 + dv) = S; }
}

DI void gla_c_phase(const Args& a, LAS unsigned char* lds, int vcu, int G, int tid, int lane, int wave) {
    LAS float* bt = (LAS float*)lds;
    LAS bf16* QH = (LAS bf16*)(lds + 32768);
    LAS bf16* KH = (LAS bf16*)(lds + 32768 + 17408);
    LAS bf16* VH = (LAS bf16*)(lds + 32768 + 2 * 17408);
    LAS bf16* SH = (LAS bf16*)(lds + 32768 + 2 * 17408 + 20480);
    LAS float* RS = (LAS float*)(lds + 32768 + 2 * 17408 + 20480 + 40960);
    LAS float* gas = RS + 256;
    const float* wa2_ = (const float*)a.in[I_WA2]; const float* ba_ = (const float*)a.in[I_BA]; const bf16* Z = (const bf16*)(a.ws + WS_Z); const bf16* GSP = (const bf16*)(a.ws + WS_GSP); bf16* MIX = (bf16*)(a.ws + WS_MIX);
    const float* go = (const float*)a.in[I_GGLAO];
    const int r32 = lane & 31, h2 = lane >> 5, dvb = wave >> 1, tb = wave & 1;
    float wcol[16], bias = 0.f; int hcur = -1;
#pragma unroll
    for (int r = 0; r < 16; ++r) wcol[r] = 0.f;
    for (int u = vcu; u < 1024; u += G) {
        const int b = u >> 7, h = (u >> 5) & 3, c = u & 31, row0 = b * SEQ + c * 64;
        __syncthreads();
        if (tid < 128) { const u32x4 w = *(const u32x4*)(Z + (size_t)(row0 + (tid >> 1)) * ZW + ZC_GA + (tid & 1) * 8); LAS f32x4* gd = (LAS f32x4*)(gas + tid * 8);
            gd[0] = (f32x4){bflo(w.x), bfhi(w.x), bflo(w.y), bfhi(w.y)}; gd[1] = (f32x4){bflo(w.z), bfhi(w.z), bflo(w.w), bfhi(w.w)}; }
        __syncthreads();
        { const int dk = tid & 127, sg = tid >> 7; float s = 0.f;
            if (h != hcur) { hcur = h; bias = ba_[h * 128 + dk];
#pragma unroll
                for (int r = 0; r < 16; ++r) wcol[r] = wa2_[r * 512 + h * 128 + dk]; }
#pragma unroll 4
            for (int t = 0; t < 16; ++t) { const LAS f32x4* gp = (const LAS f32x4*)(gas + (sg * 16 + t) * 16); const f32x4 g0 = gp[0], g1 = gp[1], g2 = gp[2], g3 = gp[3];
                float x = bias + ((g0.x * wcol[0] + g0.y * wcol[1]) + (g0.z * wcol[2] + g0.w * wcol[3])) + ((g1.x * wcol[4] + g1.y * wcol[5]) + (g1.z * wcol[6] + g1.w * wcol[7]))
                               + ((g2.x * wcol[8] + g2.y * wcol[9]) + (g2.z * wcol[10] + g2.w * wcol[11])) + ((g3.x * wcol[12] + g3.y * wcol[13]) + (g3.z * wcol[14] + g3.w * wcol[15]));
                s += (fminf(x, 0.f) - __logf(1.f + __expf(-fabsf(x)))) * (1.f / 16.f); bt[(sg * 16 + t) * 128 + dk] = s; }
            __syncthreads();
            float off = 0.f;
#pragma unroll
            for (int q = 0; q < 3; ++q) if (q < sg) off += bt[(q * 16 + 15) * 128 + dk];
            __syncthreads();
#pragma unroll
            for (int t = 0; t < 16; ++t) bt[(sg * 16 + t) * 128 + dk] += off;
        }
        __syncthreads();
#pragma unroll
        for (int rep = 0; rep < 2; ++rep) { const int i8 = tid + NTHR * rep, t = i8 >> 4, d8 = (i8 & 15) * 8; const bf16* zr = Z + (size_t)(row0 + t) * ZW + h * 128 + d8;
            const u32x4 qw = *(const u32x4*)(zr + ZC_GQ), kw = *(const u32x4*)(zr + ZC_GK), vw = *(const u32x4*)(zr + ZC_GV);
            const f32x4 b0 = *(const LAS f32x4*)(bt + t * 128 + d8), b1 = *(const LAS f32x4*)(bt + t * 128 + d8 + 4);
            const float e0 = __expf(b0.x), e1 = __expf(b0.y), e2 = __expf(b0.z), e3 = __expf(b0.w), e4 = __expf(b1.x), e5 = __expf(b1.y), e6 = __expf(b1.z), e7 = __expf(b1.w);
            u32x4 oq, ok;
            oq.x = pk2(bflo(qw.x) * GQS * e0, bfhi(qw.x) * GQS * e1); oq.y = pk2(bflo(qw.y) * GQS * e2, bfhi(qw.y) * GQS * e3); oq.z = pk2(bflo(qw.z) * GQS * e4, bfhi(qw.z) * GQS * e5); oq.w = pk2(bflo(qw.w) * GQS * e6, bfhi(qw.w) * GQS * e7);
            ok.x = pk2(bflo(kw.x) * __builtin_amdgcn_rcpf(e0), bfhi(kw.x) * __builtin_amdgcn_rcpf(e1)); ok.y = pk2(bflo(kw.y) * __builtin_amdgcn_rcpf(e2), bfhi(kw.y) * __builtin_amdgcn_rcpf(e3));
            ok.z = pk2(bflo(kw.z) * __builtin_amdgcn_rcpf(e4), bfhi(kw.z) * __builtin_amdgcn_rcpf(e5)); ok.w = pk2(bflo(kw.w) * __builtin_amdgcn_rcpf(e6), bfhi(kw.w) * __builtin_amdgcn_rcpf(e7));
            *(LAS u32x4*)(QH + t * 136 + d8) = oq; *(LAS u32x4*)(KH + t * 136 + d8) = ok; *(LAS u32x4*)(VH + t * 160 + d8) = vw; }
#pragma unroll
        for (int rep = 0; rep < 4; ++rep) { const int i8 = tid + NTHR * rep, dk = i8 >> 4, d8 = (i8 & 15) * 8; *(LAS u32x4*)(SH + dk * 160 + d8) = *(const u32x4*)(GSP + (size_t)u * 16384 + dk * 128 + d8); }
        __syncthreads();
        f32x16 o = {};
#pragma unroll
        for (int sb = 0; sb < 2; ++sb) {
            if (sb > tb) continue;
            f32x16 p = {};
#pragma unroll
            for (int k = 0; k < 8; ++k) { const bf16x8 af = *(const LAS bf16x8*)(KH + (sb * 32 + r32) * 136 + 16 * k + 8 * h2), bq = *(const LAS bf16x8*)(QH + (tb * 32 + r32) * 136 + 16 * k + 8 * h2);
                p = MFMA32(af, bq, p); }
            if (sb == tb) {
#pragma unroll
                for (int r = 0; r < 16; ++r) if (crow(r, h2) > r32) p[r] = 0.f; }
#pragma unroll
            for (int sub = 0; sub < 2; ++sub) { const int s4 = sb * 2 + sub; const bf16x8 pf = pack8(p, sub);
                o = MFMA32(tr_frag(VH, 160, 16 * s4 + 4 * h2, 16 * s4 + 8 + 4 * h2, dvb * 32, lane), pf, o); }
        }
#pragma unroll
        for (int k = 0; k < 8; ++k) { const bf16x8 af = tr_frag(SH, 160, 16 * k + 8 * h2, 16 * k + 8 * h2 + 4, dvb * 32, lane), bq = *(const LAS bf16x8*)(QH + (tb * 32 + r32) * 136 + 16 * k + 8 * h2);
            o = MFMA32(af, bq, o); }
        float ss = 0.f;
#pragma unroll
        for (int r = 0; r < 16; ++r) ss += o[r] * o[r];
        ss += __shfl_xor(ss, 32);
        if (h2 == 0) RS[dvb * 64 + tb * 32 + r32] = ss;
        __syncthreads();
        const int t = tb * 32 + r32; const float tot = (RS[t] + RS[64 + t]) + (RS[128 + t] + RS[192 + t]);
        const float rn = __builtin_amdgcn_rsqf(tot * (1.f / 128.f) + EPS);
        const size_t row = (size_t)row0 + t;
#pragma unroll
        for (int q = 0; q < 4; ++q) { const int dv = dvb * 32 + 8 * q + 4 * h2; const f32x4 g4 = *(const f32x4*)(go + dv);
            const u32x2 gw = *(const u32x2*)(Z + row * ZW + ZC_GR + h * 128 + dv); const float g0 = bflo(gw.x), g1 = bfhi(gw.x), g2 = bflo(gw.y), g3 = bfhi(gw.y);
            const float v0 = o[4 * q + 0] * rn * g4.x * g0 * sigmoidf_(g0), v1 = o[4 * q + 1] * rn * g4.y * g1 * sigmoidf_(g1), v2 = o[4 * q + 2] * rn * g4.z * g2 * sigmoidf_(g2), v3 = o[4 * q + 3] * rn * g4.w * g3 * sigmoidf_(g3);
            u32x2 w; w.x = pk2(v0, v1); w.y = pk2(v2, v3); *(u32x2*)(MIX + row * DM + 512 + h * 128 + dv) = w; }
    }
}

DI void gla_sample_phase(const Args& a, LAS unsigned char* lds, int vcu, int G, int tid, int lane, int wave) {
    LAS float* qt = (LAS float*)lds;
    LAS float* kh = qt + 512;
    LAS float* kb = kh + 512;
    LAS float* vs = kb + 512;
    LAS float* dec = vs + 512;
    LAS float* att = dec + 128;
    LAS float* red = att + 16;
    LAS float* rsum = red + 2048;
    const float* wa2_ = (const float*)a.in[I_WA2]; const float* ba_ = (const float*)a.in[I_BA]; const bf16* Z = (const bf16*)(a.ws + WS_Z); bf16* MIX = (bf16*)(a.ws + WS_MIX);
    const float* S0 = (const float*)a.in[I_SGLA]; const float* go = (const float*)a.in[I_GGLAO];
    for (int it = vcu; it < DB * GH; it += G) { const int bd = it >> 2, h = it & 3; const size_t row0 = (size_t)MP + bd * 4;
        __syncthreads();
        if (tid < 128) { float bs[4], s = 0.f;
#pragma unroll
            for (int t = 0; t < 4; ++t) { float x = ba_[h * 128 + tid];
#pragma unroll
                for (int r = 0; r < 16; ++r) x += bf2f(Z[(row0 + t) * ZW + ZC_GA + r]) * wa2_[r * 512 + h * 128 + tid];
                s += (fminf(x, 0.f) - __logf(1.f + __expf(-fabsf(x)))) * (1.f / 16.f); bs[t] = s; }
            dec[tid] = __expf(s);
#pragma unroll
            for (int t = 0; t < 4; ++t) { const bf16* zr = Z + (row0 + t) * ZW + h * 128 + tid; const float q = bf2f(zr[ZC_GQ]) * GQS, k = bf2f(zr[ZC_GK]);
                qt[t * 128 + tid] = q * __expf(bs[t]); kh[t * 128 + tid] = k * __expf(-bs[t]); kb[t * 128 + tid] = k * __expf(s - bs[t]); } }
        else if (tid < 256) { const int d = tid - 128;
#pragma unroll
            for (int t = 0; t < 4; ++t) vs[t * 128 + d] = bf2f(Z[(row0 + t) * ZW + ZC_GV + h * 128 + d]); }
        __syncthreads();
#pragma unroll
        for (int e = 0; e < 2; ++e) { const int pr = wave * 2 + e, t = pr >> 2, s = pr & 3;
            float x = qt[t * 128 + lane] * kh[s * 128 + lane] + qt[t * 128 + 64 + lane] * kh[s * 128 + 64 + lane]; x = wave_sum(x);
            if (lane == 0) att[pr] = (s <= t) ? x : 0.f; }
        { const int part = tid >> 7, dv = tid & 127; float op[4] = {0.f, 0.f, 0.f, 0.f};
            const float v0 = vs[dv], v1 = vs[128 + dv], v2 = vs[256 + dv], v3 = vs[384 + dv];
            const float* sp = S0 + ((size_t)bd * 4 + h) * 16384 + dv; float* so = a.out + O_GLAS + ((size_t)bd * 4 + h) * 16384 + dv;
#pragma unroll 4
            for (int j = 0; j < 32; ++j) { const int dk = part * 32 + j; const float s0 = sp[(size_t)dk * 128];
                op[0] += qt[dk] * s0; op[1] += qt[128 + dk] * s0; op[2] += qt[256 + dk] * s0; op[3] += qt[384 + dk] * s0;
                so[(size_t)dk * 128] = dec[dk] * s0 + ((kb[dk] * v0 + kb[128 + dk] * v1) + (kb[256 + dk] * v2 + kb[384 + dk] * v3)); }
#pragma unroll
            for (int t = 0; t < 4; ++t) red[(part * 4 + t) * 128 + dv] = op[t]; }
        __syncthreads();
        { const int t = tid >> 7, dv = tid & 127; float o = (red[(0 * 4 + t) * 128 + dv] + red[(1 * 4 + t) * 128 + dv]) + (red[(2 * 4 + t) * 128 + dv] + red[(3 * 4 + t) * 128 + dv]);
#pragma unroll
            for (int s = 0; s < 4; ++s) o += att[t * 4 + s] * vs[s * 128 + dv];
            float ss = wave_sum(o * o); if (lane == 0) rsum[wave] = ss;
            __syncthreads();
            const float tot = rsum[2 * t] + rsum[2 * t + 1]; const float rn = __builtin_amdgcn_rsqf(tot * (1.f / 128.f) + EPS);
            const float g = bf2f(Z[(row0 + t) * ZW + ZC_GR + h * 128 + dv]);
            MIX[(row0 + t) * DM + 512 + h * 128 + dv] = (bf16)f2bf(o * rn * go[dv] * g * sigmoidf_(g)); }
    }
}
namespace sk {
DI void glds16(const void* gsrc, unsigned lds_dst) { unsigned keep;
    asm volatile("s_mov_b32 %0, m0\n\ts_mov_b32 m0, %2\n\ts_nop 0\n\tglobal_load_lds_dwordx4 %1, off\n\ts_mov_b32 m0, %0" : "=&s"(keep) : "v"(gsrc), "s"(lds_dst) : "memory"); }
struct BMapLin { DI int operator()(int tn, int rr) const { return tn * 32 + rr; } };
struct BMapGlu { DI int operator()(int tn, int rr) const { const int c0 = tn * 16, r0 = (c0 >> 7) * 256 + (c0 & 127); return rr < 16 ? r0 + rr : r0 + 128 + (rr - 16); } };
constexpr int SLOT = 24576, ABYTES = 16384;
template <class Epi, class BMap>
DI void skinny_gemm(LAS unsigned char* lds, const bf16* A, int lda, const bf16* Bt, int ldb, int K, int ntn, const Epi& E, const BMap& bmap, int cu, int G, int tid, int lane, int wave) {
    const unsigned lds0 = (unsigned)(uintptr_t)lds;
    const int mi = wave & 3, ni = wave >> 2, fr = lane & 15, fq = lane >> 4;
    const int S = K / 128, ntiles = 8 * ntn;
    const int drow = lane >> 4, dpc = lane & 15;
    for (int t = cu; t < ntiles; t += G) { const int tm = t & 7, tn = t >> 3;
        const int ar0 = 8 * wave + drow, ar1 = ar0 + 4, br = 4 * wave + drow;
        const bf16* pa0 = A + (size_t)(tm * 64 + ar0) * lda + ((dpc ^ (ar0 & 15)) * 8);
        const bf16* pa1 = A + (size_t)(tm * 64 + ar1) * lda + ((dpc ^ (ar1 & 15)) * 8);
        const bf16* pb = Bt + (size_t)bmap(tn, br) * ldb + ((dpc ^ (br & 15)) * 8);
        const unsigned da0 = lds0 + (8 * wave) * 256, da1 = da0 + 1024, db = lds0 + ABYTES + (4 * wave) * 256;
#define SK_ISSUE(s_) do { const unsigned so_ = (unsigned)((s_) & 3) * SLOT; const int ko_ = (s_) * 128; \
        glds16(pa0 + ko_, (unsigned)__builtin_amdgcn_readfirstlane(da0 + so_)); glds16(pa1 + ko_, (unsigned)__builtin_amdgcn_readfirstlane(da1 + so_)); glds16(pb + ko_, (unsigned)__builtin_amdgcn_readfirstlane(db + so_)); } while (0)
        asm volatile("s_waitcnt vmcnt(0) lgkmcnt(0)\n\ts_barrier" ::: "memory");
        SK_ISSUE(0); if (S > 1) SK_ISSUE(1); if (S > 2) SK_ISSUE(2);
        f32x4 acc = {0.f, 0.f, 0.f, 0.f};
#pragma unroll 1
        for (int s = 0; s < S; ++s) {
            const int ahead = (S - 1 - s) < 2 ? (S - 1 - s) : 2;
            if (ahead == 2) asm volatile("s_waitcnt vmcnt(6)\n\ts_barrier" ::: "memory");
            else if (ahead == 1) asm volatile("s_waitcnt vmcnt(3)\n\ts_barrier" ::: "memory");
            else asm volatile("s_waitcnt vmcnt(0)\n\ts_barrier" ::: "memory");
            if (s + 3 < S) SK_ISSUE(s + 3);
            const LAS unsigned char* sa = lds + (s & 3) * SLOT + (16 * mi + fr) * 256; const LAS unsigned char* sb = lds + (s & 3) * SLOT + ABYTES + (16 * ni + fr) * 256;
#pragma unroll
            for (int ks = 0; ks < 4; ++ks) { const int pc = (4 * ks + fq) ^ fr;
                const bf16x8 af = *(const LAS bf16x8*)(sa + pc * 16), bfv = *(const LAS bf16x8*)(sb + pc * 16);
                acc = MFMA16(bfv, af, acc); }
            asm volatile("s_waitcnt lgkmcnt(0)" ::: "memory");
        }
        E(lds, tm * 64 + 16 * mi + fr, tn, ni, fq, acc, tid);
#undef SK_ISSUE
    }
}
template <class Epi>
DI void skinny_gemm4(LAS unsigned char* lds, const bf16* A, int lda, const bf16* Bt, int ldb, int K, int ntn, const Epi& E, int cu, int G, int tid, int lane, int wave) {
    const unsigned lds0 = (unsigned)(uintptr_t)lds;
    const int mi = wave & 3, ni = wave >> 2, fr = lane & 15, fq = lane >> 4;
    const int S = K / 64, ntiles = 8 * ntn;
    const int drow = lane >> 3, dpc = lane & 7;
    for (int t = cu; t < ntiles; t += G) { const int tm = t & 7, tn = t >> 3;
        const int ar = 8 * wave + drow, br0 = 16 * wave + drow, br1 = br0 + 8;
        const bf16* pa = A + (size_t)(tm * 64 + ar) * lda + ((dpc ^ (ar & 7)) * 8);
        const bf16* pb0 = Bt + (size_t)(tn * 128 + br0) * ldb + ((dpc ^ (br0 & 7)) * 8);
        const bf16* pb1 = Bt + (size_t)(tn * 128 + br1) * ldb + ((dpc ^ (br1 & 7)) * 8);
        const unsigned da = lds0 + (8 * wave) * 128, db0 = lds0 + 8192 + (16 * wave) * 128, db1 = db0 + 1024;
#define SK4_ISSUE(s_) do { const unsigned so_ = (unsigned)((s_) & 3) * SLOT; const int ko_ = (s_) * 64; \
        glds16(pa + ko_, (unsigned)__builtin_amdgcn_readfirstlane(da + so_)); glds16(pb0 + ko_, (unsigned)__builtin_amdgcn_readfirstlane(db0 + so_)); glds16(pb1 + ko_, (unsigned)__builtin_amdgcn_readfirstlane(db1 + so_)); } while (0)
        asm volatile("s_waitcnt vmcnt(0) lgkmcnt(0)\n\ts_barrier" ::: "memory");
        SK4_ISSUE(0); if (S > 1) SK4_ISSUE(1); if (S > 2) SK4_ISSUE(2);
        f32x4 acc[4] = {};
#pragma unroll 1
        for (int s = 0; s < S; ++s) {
            const int ahead = (S - 1 - s) < 2 ? (S - 1 - s) : 2;
            if (ahead == 2) asm volatile("s_waitcnt vmcnt(6)\n\ts_barrier" ::: "memory");
            else if (ahead == 1) asm volatile("s_waitcnt vmcnt(3)\n\ts_barrier" ::: "memory");
            else asm volatile("s_waitcnt vmcnt(0)\n\ts_barrier" ::: "memory");
            if (s + 3 < S) SK4_ISSUE(s + 3);
            const LAS unsigned char* sa = lds + (s & 3) * SLOT + (16 * mi + fr) * 128; const LAS unsigned char* sb = lds + (s & 3) * SLOT + 8192 + (64 * ni + fr) * 128;
#pragma unroll
            for (int ks = 0; ks < 2; ++ks) { const int pc = (4 * ks + fq) ^ (fr & 7);
                const bf16x8 af = *(const LAS bf16x8*)(sa + pc * 16);
#pragma unroll
                for (int b = 0; b < 4; ++b) { const bf16x8 bfv = *(const LAS bf16x8*)(sb + b * 2048 + pc * 16); acc[b] = MFMA16(bfv, af, acc[b]); } }
            asm volatile("s_waitcnt lgkmcnt(0)" ::: "memory");
        }
#pragma unroll
        for (int b = 0; b < 4; ++b) E.at(tm * 64 + 16 * mi + fr, tn * 128 + 64 * ni + 16 * b + 4 * fq, fq, acc[b]);
#undef SK4_ISSUE
    }
}
template <int MODE> struct SkBf16 {
    bf16* O; int ldc; const float* ss; float ssdiv;
    DI void operator()(LAS unsigned char*, int row, int tn, int ni, int fq, f32x4 v, int) const {
        const int grow = MP + row, col = tn * 32 + 16 * ni + 4 * fq; float r = 1.f; if (ss) r = __builtin_amdgcn_rsqf(ss[grow] * ssdiv + EPS);
        v = v * r;
        if (MODE == 1) {
#pragma unroll
            for (int j = 0; j < 4; ++j) { const float a = fmaxf(v[j], 0.f); v[j] = a * a; } }
        u32x2 w; w.x = pk2(v[0], v[1]); w.y = pk2(v[2], v[3]); *(u32x2*)(O + (size_t)grow * ldc + col) = w;
    }
    DI void at(int row, int col, int fq, f32x4 v) const {
        const int grow = MP + row; float r = 1.f; if (ss) r = __builtin_amdgcn_rsqf(ss[grow] * ssdiv + EPS);
        v = v * r;
        if (MODE == 1) {
#pragma unroll
            for (int j = 0; j < 4; ++j) { const float a = fmaxf(v[j], 0.f); v[j] = a * a; } }
        u32x2 w; w.x = pk2(v[0], v[1]); w.y = pk2(v[2], v[3]); *(u32x2*)(O + (size_t)grow * ldc + col) = w; (void)fq;
    }
};
struct SkZ {
    bf16* O; const float* ss; float* ssq;
    DI void operator()(LAS unsigned char*, int row, int tn, int ni, int fq, f32x4 v, int) const {
        const int grow = MP + row, col = tn * 32 + 16 * ni + 4 * fq; const float r = __builtin_amdgcn_rsqf(ss[grow] * (1.f / DM) + EPS);
        v = v * r;
        u32x2 w; w.x = pk2(v[0], v[1]); w.y = pk2(v[2], v[3]); *(u32x2*)(O + (size_t)grow * ZW + col) = w;
        const int blk = tn >> 2;
        if (blk < 5) { float s = (v[0] * v[0] + v[1] * v[1]) + (v[2] * v[2] + v[3] * v[3]); s += __shfl_xor(s, 16); s += __shfl_xor(s, 32); if (fq == 0) atomicAdd(ssq + (blk < 3 ? 0 : MT) + grow, s); }
    }
    DI void at(int row, int col, int fq, f32x4 v) const {
        const int grow = MP + row; const float r = __builtin_amdgcn_rsqf(ss[grow] * (1.f / DM) + EPS);
        v = v * r;
        u32x2 w; w.x = pk2(v[0], v[1]); w.y = pk2(v[2], v[3]); *(u32x2*)(O + (size_t)grow * ZW + col) = w;
        const int blk = col >> 7;
        if (blk < 5) { float s = (v[0] * v[0] + v[1] * v[1]) + (v[2] * v[2] + v[3] * v[3]); s += __shfl_xor(s, 16); s += __shfl_xor(s, 32); if (fq == 0) atomicAdd(ssq + (blk < 3 ? 0 : MT) + grow, s); }
    }
};
template <int MODE> struct SkRes {
    const float* basef; const bf16* baseb; float* H; bf16* XB; float* ssout; const float* ssin; const bf16* PP;
    DI void operator()(LAS unsigned char*, int row, int tn, int ni, int fq, f32x4 v, int) const {
        const int grow = MP + row, col = tn * 32 + 16 * ni + 4 * fq;
        if (MODE == 1) { const float r = __builtin_amdgcn_rsqf(ssin[grow] * (1.f / DM) + EPS); const u32x2 pw = *(const u32x2*)(PP + (size_t)grow * DM + col);
            v[0] = sigmoidf_(v[0] * r) * bflo(pw.x); v[1] = sigmoidf_(v[1] * r) * bfhi(pw.x); v[2] = sigmoidf_(v[2] * r) * bflo(pw.y); v[3] = sigmoidf_(v[3] * r) * bfhi(pw.y); }
        f32x4 h;
        if (baseb) { const u32x2 bw = *(const u32x2*)(baseb + (size_t)grow * DM + col); h = (f32x4){bflo(bw.x), bfhi(bw.x), bflo(bw.y), bfhi(bw.y)} + v; }
        else h = *(const f32x4*)(basef + (size_t)row * DM + col) + v;
        if (H) *(f32x4*)(H + (size_t)grow * DM + col) = h;
        if (XB) { u32x2 w; w.x = pk2(h[0], h[1]); w.y = pk2(h[2], h[3]); *(u32x2*)(XB + (size_t)grow * DM + col) = w; }
        if (ssout) { float s = (h[0] * h[0] + h[1] * h[1]) + (h[2] * h[2] + h[3] * h[3]); s += __shfl_xor(s, 16); s += __shfl_xor(s, 32); if (fq == 0) atomicAdd(ssout + grow, s); }
    }
};
struct SkGlu {
    const bf16* baseb; bf16* XB; float* ssout;
    DI void operator()(LAS unsigned char* lds, int row, int tn, int ni, int fq, f32x4 v, int tid) const {
        LAS f32x4* X = (LAS f32x4*)(lds + 4 * SLOT);
        const int lr = row & 63;
        if (ni == 1) X[lr * 4 + fq] = v;
        asm volatile("s_waitcnt lgkmcnt(0)\n\ts_barrier" ::: "memory");
        if (ni == 0) { const f32x4 gt = X[lr * 4 + fq]; const int grow = MP + row, col = tn * 16 + 4 * fq;
            const u32x2 bw = *(const u32x2*)(baseb + (size_t)grow * DM + col); f32x4 h = {bflo(bw.x), bfhi(bw.x), bflo(bw.y), bfhi(bw.y)};
#pragma unroll
            for (int j = 0; j < 4; ++j) h[j] += v[j] * sigmoidf_(gt[j]);
            u32x2 w; w.x = pk2(h[0], h[1]); w.y = pk2(h[2], h[3]); *(u32x2*)(XB + (size_t)grow * DM + col) = w;
            float s = (h[0] * h[0] + h[1] * h[1]) + (h[2] * h[2] + h[3] * h[3]); s += __shfl_xor(s, 16); s += __shfl_xor(s, 32); if (fq == 0) atomicAdd(ssout + grow, s); }
    }
};
}
DI float score_bound(const Args& a, int lane) {
    const float* gq = (const float*)a.in[I_GQH]; const float* gk = (const float*)a.in[I_GKH];
    float mq = fmaxf(fabsf(gq[lane]), (lane < 32) ? fabsf(gq[64 + lane]) : 0.f), mk = fmaxf(fabsf(gk[lane]), (lane < 32) ? fabsf(gk[64 + lane]) : 0.f);
#pragma unroll
    for (int o = 1; o < 64; o <<= 1) { mq = fmaxf(mq, __shfl_xor(mq, o)); mk = fmaxf(mk, __shfl_xor(mk, o)); }
    return 96.f * QSCALE * mq * mk;
}
DI void attn_prompt_unit(const Args& a, LAS unsigned char* lds, int b, int h, int qb, float cB, int tid, int lane, int wave) {
    const bf16* KF = (const bf16*)(a.ws + WS_KF); const bf16* KVR = (const bf16*)(a.ws + WS_KVRAW); bf16* MIX = (bf16*)(a.ws + WS_MIX);
    LAS bf16* Ks = (LAS bf16*)lds;
    LAS bf16* Vs = (LAS bf16*)(lds + 26624);
    const int r32 = lane & 31, h2 = lane >> 5;
    const int qloc = qb * 256 + wave * 32 + r32;
    const size_t qrow = (size_t)b * SEQ + qloc;
    bf16x8 qf[6];
    { const bf16* QR = (const bf16*)(a.ws + WS_QRAW); const float* gq = (const float*)a.in[I_GQH]; const float* rc = (const float*)(a.ws + WS_ROPE); const float* rs = rc + 8200 * 16;
        u32x4 wq[6]; float ss = 0.f;
#pragma unroll
        for (int s = 0; s < 6; ++s) { wq[s] = *(const u32x4*)(QR + qrow * 768 + h * 96 + 16 * s + 8 * h2);
            const float e0 = bflo(wq[s].x), e1 = bfhi(wq[s].x), e2 = bflo(wq[s].y), e3 = bfhi(wq[s].y), e4 = bflo(wq[s].z), e5 = bfhi(wq[s].z), e6 = bflo(wq[s].w), e7 = bfhi(wq[s].w);
            ss += ((e0 * e0 + e1 * e1) + (e2 * e2 + e3 * e3)) + ((e4 * e4 + e5 * e5) + (e6 * e6 + e7 * e7)); }
        ss += __shfl_xor(ss, 32);
        const float r = __builtin_amdgcn_rsqf(ss * (1.f / 96.f) + EPS) * QSCALE;
#pragma unroll
        for (int s = 0; s < 4; ++s) { const f32x4 g0 = *(const f32x4*)(gq + 16 * s + 8 * h2) * r, g1 = *(const f32x4*)(gq + 16 * s + 8 * h2 + 4) * r;
            u32x4 o; o.x = pk2(bflo(wq[s].x) * g0.x, bfhi(wq[s].x) * g0.y); o.y = pk2(bflo(wq[s].y) * g0.z, bfhi(wq[s].y) * g0.w); o.z = pk2(bflo(wq[s].z) * g1.x, bfhi(wq[s].z) * g1.y); o.w = pk2(bflo(wq[s].w) * g1.z, bfhi(wq[s].w) * g1.w);
            qf[s] = __builtin_bit_cast(bf16x8, o); }
        { const f32x4 ga0 = *(const f32x4*)(gq + 64 + 8 * h2) * r, ga1 = *(const f32x4*)(gq + 64 + 8 * h2 + 4) * r, gb0 = *(const f32x4*)(gq + 80 + 8 * h2) * r, gb1 = *(const f32x4*)(gq + 80 + 8 * h2 + 4) * r;
            const f32x4 c0 = *(const f32x4*)(rc + qloc * 16 + 8 * h2), c1 = *(const f32x4*)(rc + qloc * 16 + 8 * h2 + 4), s0 = *(const f32x4*)(rs + qloc * 16 + 8 * h2), s1 = *(const f32x4*)(rs + qloc * 16 + 8 * h2 + 4);
            const f32x4 xa0 = (f32x4){bflo(wq[4].x), bfhi(wq[4].x), bflo(wq[4].y), bfhi(wq[4].y)} * ga0, xa1 = (f32x4){bflo(wq[4].z), bfhi(wq[4].z), bflo(wq[4].w), bfhi(wq[4].w)} * ga1;
            const f32x4 xb0 = (f32x4){bflo(wq[5].x), bfhi(wq[5].x), bflo(wq[5].y), bfhi(wq[5].y)} * gb0, xb1 = (f32x4){bflo(wq[5].z), bfhi(wq[5].z), bflo(wq[5].w), bfhi(wq[5].w)} * gb1;
            const f32x4 ra0 = xa0 * c0 - xb0 * s0, ra1 = xa1 * c1 - xb1 * s1, rb0 = xb0 * c0 + xa0 * s0, rb1 = xb1 * c1 + xa1 * s1;
            u32x4 o4, o5; o4.x = pk2(ra0.x, ra0.y); o4.y = pk2(ra0.z, ra0.w); o4.z = pk2(ra1.x, ra1.y); o4.w = pk2(ra1.z, ra1.w); o5.x = pk2(rb0.x, rb0.y); o5.y = pk2(rb0.z, rb0.w); o5.z = pk2(rb1.x, rb1.y); o5.w = pk2(rb1.z, rb1.w);
            qf[4] = __builtin_bit_cast(bf16x8, o4); qf[5] = __builtin_bit_cast(bf16x8, o5); } }
    const int NT = 4 * (qb + 1);
    const int kr0 = tid / 12, kp0 = tid % 12, kr1 = (tid + 512) / 12, kp1 = (tid + 512) % 12; const bool k1 = tid < 256;
    const bf16* kbase = KF + ((size_t)b * SEQ) * 768 + h * 96;
    const bf16* vbase = KVR + ((size_t)b * SEQ + (tid >> 3)) * 1024 + h * 128 + 64 + (tid & 7) * 8;
    u32x4 kst0, kst1 = {0u, 0u, 0u, 0u}, vst;
    kst0 = *(const u32x4*)(kbase + (size_t)kr0 * 768 + kp0 * 8); if (k1) kst1 = *(const u32x4*)(kbase + (size_t)kr1 * 768 + kp1 * 8); vst = *(const u32x4*)(vbase);
    __syncthreads();
    *(LAS u32x4*)(Ks + kr0 * 104 + kp0 * 8) = kst0; if (k1) *(LAS u32x4*)(Ks + kr1 * 104 + kp1 * 8) = kst1;
    *(LAS u32x4*)(Vs + (tid >> 3) * 96 + (tid & 7) * 8) = vst;
    __syncthreads();
    f32x16 o0 = {}, o1 = {}; float lsum = 0.f;
    const int qmax_w = qb * 256 + wave * 32 + 31;
    for (int t = 0; t < NT; ++t) {
        const int buf = t & 1;
        if (t + 1 < NT) { const size_t kv1 = (size_t)(t + 1) * 64;
            kst0 = *(const u32x4*)(kbase + (kv1 + kr0) * 768 + kp0 * 8); if (k1) kst1 = *(const u32x4*)(kbase + (kv1 + kr1) * 768 + kp1 * 8); vst = *(const u32x4*)(vbase + kv1 * 1024); }
        if (t * 64 <= qmax_w) {
            const LAS bf16* Kb = Ks + buf * 6656; const LAS bf16* Vb = Vs + buf * 6144;
            f32x16 p0, p1;
#pragma unroll
            for (int r = 0; r < 16; ++r) { p0[r] = -cB; p1[r] = -cB; }
#pragma unroll
            for (int s = 0; s < 6; ++s) { const bf16x8 k0 = *(const LAS bf16x8*)(Kb + r32 * 104 + 16 * s + 8 * h2), k1f = *(const LAS bf16x8*)(Kb + (32 + r32) * 104 + 16 * s + 8 * h2);
                p0 = MFMA32(k0, qf[s], p0); p1 = MFMA32(k1f, qf[s], p1); }
            const bool diag = (t * 64 + 63 > qb * 256 + wave * 32);
#pragma unroll
            for (int r = 0; r < 16; ++r) { const int kv = t * 64 + crow(r, h2);
                float e0 = __builtin_amdgcn_exp2f(p0[r]), e1 = __builtin_amdgcn_exp2f(p1[r]);
                if (diag) { if (kv > qloc) e0 = 0.f; if (kv + 32 > qloc) e1 = 0.f; }
                p0[r] = e0; p1[r] = e1; lsum += e0 + e1; }
#pragma unroll
            for (int s4 = 0; s4 < 4; ++s4) { const bf16x8 pf = (s4 < 2) ? pack8(p0, s4 & 1) : pack8(p1, s4 & 1);
                o0 = MFMA32(tr_frag(Vb, 96, 16 * s4 + 4 * h2, 16 * s4 + 8 + 4 * h2, 0, lane), pf, o0); o1 = MFMA32(tr_frag(Vb, 96, 16 * s4 + 4 * h2, 16 * s4 + 8 + 4 * h2, 32, lane), pf, o1); }
        }
        if (t + 1 < NT) { LAS bf16* Kn = Ks + (buf ^ 1) * 6656; LAS bf16* Vn = Vs + (buf ^ 1) * 6144;
            *(LAS u32x4*)(Kn + kr0 * 104 + kp0 * 8) = kst0; if (k1) *(LAS u32x4*)(Kn + kr1 * 104 + kp1 * 8) = kst1;
            *(LAS u32x4*)(Vn + (tid >> 3) * 96 + (tid & 7) * 8) = vst; }
        __syncthreads();
    }
    lsum += __shfl_xor(lsum, 32);
    const float inv = 1.f / lsum;
    bf16* op = MIX + qrow * DM + h * 64;
#pragma unroll
    for (int q = 0; q < 4; ++q) { const int dv = 8 * q + 4 * h2;
        u32x2 w0, w1; w0.x = pk2(o0[4 * q] * inv, o0[4 * q + 1] * inv); w0.y = pk2(o0[4 * q + 2] * inv, o0[4 * q + 3] * inv);
        w1.x = pk2(o1[4 * q] * inv, o1[4 * q + 1] * inv); w1.y = pk2(o1[4 * q + 2] * inv, o1[4 * q + 3] * inv);
        *(u32x2*)(op + dv) = w0; *(u32x2*)(op + 32 + dv) = w1; }
}
DI void attn_prompt_phase(const Args& a, LAS unsigned char* lds, int vcu, int G, int tid, int lane, int wave) {
    const float cB = score_bound(a, lane);
    for (int pi = vcu; pi < 256; pi += G) { const int bh = pi >> 2, s = pi & 3;
        attn_prompt_unit(a, lds, bh >> 3, bh & 7, 7 - s, cB, tid, lane, wave);
        attn_prompt_unit(a, lds, bh >> 3, bh & 7, s, cB, tid, lane, wave); }
}
constexpr int CSW = 296;
DI void p4b_sample_q(const Args& a, LAS unsigned char* lds, int vcu, int G, int tid, int lane, int wave) {
    LAS float* qs = (LAS float*)lds;
    const bf16* QF = (const bf16*)(a.ws + WS_QF); bf16* QS = (bf16*)(a.ws + WS_QS);
    const float* W = (const float*)a.in[I_WUKV]; const float* gk = (const float*)a.in[I_GKH];
    for (int it = vcu; it < 256; it += G) { const int h = it >> 5, rg = it & 31;
        __syncthreads();
        for (int i = tid; i < 16 * 96; i += NTHR) { const int r = i / 96, d = i % 96; qs[i] = bf2f(QF[((size_t)MP + rg * 16 + r) * 768 + h * 96 + d]); }
        __syncthreads();
        if (tid < 256) { float w[64];
#pragma unroll
            for (int d4 = 0; d4 < 16; ++d4) { const f32x4 v = *(const f32x4*)(W + (size_t)tid * 1024 + h * 128 + d4 * 4), g = *(const f32x4*)(gk + d4 * 4); w[4 * d4] = v.x * g.x; w[4 * d4 + 1] = v.y * g.y; w[4 * d4 + 2] = v.z * g.z; w[4 * d4 + 3] = v.w * g.w; }
#pragma unroll 1
            for (int r = 0; r < 16; ++r) { float s = 0.f;
#pragma unroll
                for (int d4 = 0; d4 < 16; ++d4) { const f32x4 qv = *(const LAS f32x4*)(qs + r * 96 + 4 * d4); s += (w[4 * d4] * qv.x + w[4 * d4 + 1] * qv.y) + (w[4 * d4 + 2] * qv.z + w[4 * d4 + 3] * qv.w); }
                const int srow = rg * 16 + r, bd = srow >> 2, t = srow & 3;
                QS[((size_t)bd * 32 + h * 4 + t) * CSW + tid] = (bf16)f2bf(s); } }
        else { for (int i = tid - 256; i < 16 * 40; i += 256) { const int r = i / 40, d = i % 40; const int srow = rg * 16 + r, bd = srow >> 2, t = srow & 3;
                QS[((size_t)bd * 32 + h * 4 + t) * CSW + 256 + d] = (d < 32) ? (bf16)f2bf(qs[r * 96 + 64 + d]) : (bf16)0; } }
    }
}

DI void glds16(const void* gsrc, unsigned lds_dst) { unsigned keep;
    asm volatile("s_mov_b32 %0, m0\n\ts_mov_b32 m0, %2\n\ts_nop 0\n\tglobal_load_lds_dwordx4 %1, off\n\ts_mov_b32 m0, %0" : "=&s"(keep) : "v"(gsrc), "s"(lds_dst) : "memory"); }
#define BAR_LDS() asm volatile("s_waitcnt lgkmcnt(0)\n\ts_barrier" ::: "memory")
#define BAR_ALL() asm volatile("s_waitcnt vmcnt(0) lgkmcnt(0)\n\ts_barrier" ::: "memory")
DI void attn_sample_phase(const Args& a, LAS unsigned char* lds, int vcu, int G, int tid, int lane, int wave) {
    LAS bf16* Cs = (LAS bf16*)lds;
    LAS unsigned char* C8 = lds + 56832;
    LAS bf16* Qs = (LAS bf16*)(lds + 74240);
    LAS bf16* PT = (LAS bf16*)(lds + 93184);
    LAS float* RI = (LAS float*)(lds + 95744);
    LAS float* SSPE = (LAS float*)(lds + 96768);
    LAS float* LRED = (LAS float*)(lds + 97024);
    LAS int* PG = (LAS int*)(lds + 97152);
    const float cB = score_bound(a, lane);
    const bf16* Wt = (const bf16*)(a.ws + WS_WUKV);
    const bf16* QS = (const bf16*)(a.ws + WS_QS);
    const float* cckv = (const float*)a.in[I_CCKV]; const float* ckpe = (const float*)a.in[I_CKPE]; const int* ptab = (const int*)a.in[I_PT];
    const float* rc = (const float*)(a.ws + WS_ROPE); const float* rs = rc + 8200 * 16; const float* gk = (const float*)a.in[I_GKH];
    float* SPART = (float*)(a.ws + WS_SPART); float* SL = (float*)(a.ws + WS_SL);
    const int r16 = lane & 15, q4 = lane >> 4, r32 = lane & 31, h2 = lane >> 5;
    typedef int v8i_t __attribute__((ext_vector_type(8)));
    v8i_t wf8[4][2];
#pragma unroll
    for (int nb = 0; nb < 4; ++nb)
#pragma unroll
        for (int ks = 0; ks < 2; ++ks) { const bf16* wp = Wt + (size_t)(wave * 128 + nb * 16 + r16) * 256 + 128 * ks + 32 * q4;
#pragma unroll
            for (int i = 0; i < 4; ++i) { const u32x4 w = *(const u32x4*)(wp + 8 * i); int lo = 0, hi = 0;
                lo = __builtin_amdgcn_cvt_pk_fp8_f32(bflo(w.x) * 16.f, bfhi(w.x) * 16.f, lo, false); lo = __builtin_amdgcn_cvt_pk_fp8_f32(bflo(w.y) * 16.f, bfhi(w.y) * 16.f, lo, true);
                hi = __builtin_amdgcn_cvt_pk_fp8_f32(bflo(w.z) * 16.f, bfhi(w.z) * 16.f, hi, false); hi = __builtin_amdgcn_cvt_pk_fp8_f32(bflo(w.w) * 16.f, bfhi(w.w) * 16.f, hi, true);
                wf8[nb][ks][2 * i] = lo; wf8[nb][ks][2 * i + 1] = hi; } }
    const bool kthr = tid >= 256; const int krow = (tid >> 3) & 31, kp = tid & 7;
    const f32x2 gpa = *(const f32x2*)(gk + 64 + 2 * kp), gpb = *(const f32x2*)(gk + 80 + 2 * kp);
    const f32x2 cd = *(const f32x2*)(rc + 32 * 16 + 2 * kp), sd = *(const f32x2*)(rs + 32 * 16 + 2 * kp);
    const int lrow = tid >> 6, lpc = tid & 63;
    f32x4 a0, a1, a2, a3; f32x2 aka = {0.f, 0.f}, akb = {0.f, 0.f};
#define SA_LOAD(jj, v0, v1, v2, v3, ka, kb) do { const int phys_ = __builtin_amdgcn_readfirstlane(PG[(jj) >> 2]); const size_t key0_ = (size_t)phys_ * PAGE + ((jj) & 3) * 32; \
        const float* src_ = cckv + (key0_ + lrow) * KVL + lpc * 4; v0 = __builtin_nontemporal_load((const f32x4*)src_); v1 = __builtin_nontemporal_load((const f32x4*)(src_ + 8 * KVL)); v2 = __builtin_nontemporal_load((const f32x4*)(src_ + 16 * KVL)); v3 = __builtin_nontemporal_load((const f32x4*)(src_ + 24 * KVL)); \
        if (kthr) { const float* ks_ = ckpe + (key0_ + krow) * ROPE + 2 * kp; ka = __builtin_nontemporal_load((const f32x2*)ks_); kb = __builtin_nontemporal_load((const f32x2*)(ks_ + 16)); } } while (0)
#define SA_CONV1(v, i_, cb, c8b) do { const int row_ = lrow + 8 * (i_); u32x2 w_; w_.x = pk2(v.x, v.y); w_.y = pk2(v.z, v.w); *(LAS u32x2*)(cb + row_ * CSW + lpc * 4) = w_; \
        int f8_ = 0; f8_ = __builtin_amdgcn_cvt_pk_fp8_f32(v.x, v.y, f8_, false); f8_ = __builtin_amdgcn_cvt_pk_fp8_f32(v.z, v.w, f8_, true); *(LAS int*)(c8b + row_ * 272 + lpc * 4) = f8_; } while (0)
#define SA_CONVERT(jj, cb3, v0, v1, v2, v3, ka, kb) do { LAS bf16* cb_ = Cs + (cb3) * (32 * CSW); LAS unsigned char* c8_ = C8 + ((jj) & 1) * 8704; \
        SA_CONV1(v0, 0, cb_, c8_); SA_CONV1(v1, 1, cb_, c8_); SA_CONV1(v2, 2, cb_, c8_); SA_CONV1(v3, 3, cb_, c8_); \
        if (kthr) { const float ss_ = row8_sum((ka.x * ka.x + ka.y * ka.y) + (kb.x * kb.x + kb.y * kb.y)); if (kp == 0) SSPE[((jj) & 1) * 32 + krow] = ss_; \
            const f32x2 ya_ = ka * gpa, yb_ = kb * gpb; const f32x2 r1_ = ya_ * rcur - yb_ * rsur, r2_ = yb_ * rcur + ya_ * rsur; \
            *(LAS unsigned*)(cb_ + krow * CSW + 256 + 2 * kp) = pk2(r1_.x, r1_.y); *(LAS unsigned*)(cb_ + krow * CSW + 272 + 2 * kp) = pk2(r2_.x, r2_.y); \
            const f32x2 nc_ = rcur * cd - rsur * sd, ns_ = rsur * cd + rcur * sd; rcur = nc_; rsur = ns_; } } while (0)
#define SA_PV(cb3) do { const LAS bf16* cb_ = Cs + (cb3) * (32 * CSW); const int q_ = (lane & 15) >> 2, p_ = lane & 3, blk_ = (lane >> 4) & 1; \
        _Pragma("unroll") for (int s4 = 0; s4 < 2; ++s4) { const LAS bf16* ap = cb_ + (16 * s4 + 8 * h2 + q_) * CSW + 32 * wave + 16 * blk_ + 4 * p_; \
            const s16x4 lo = __builtin_bit_cast(s16x4, __builtin_amdgcn_ds_read_tr16_b64_v4i16((LAS v4i16_t*)ap)), hi = __builtin_bit_cast(s16x4, __builtin_amdgcn_ds_read_tr16_b64_v4i16((LAS v4i16_t*)(ap + 4 * CSW))); \
            const bf16x8 af = __builtin_shufflevector(lo, hi, 0, 1, 2, 3, 4, 5, 6, 7); const bf16x8 bp = *(const LAS bf16x8*)(PT + r32 * 40 + 16 * s4 + 8 * h2); \
            accT = MFMA32(af, bp, accT); } } while (0)
    for (int it = vcu; it < 2 * DB; it += G) { const int bd = it >> 1, split = it & 1;
        __syncthreads();
        if (tid < 32) { PG[tid] = ptab[bd * NPAGES + split * 32 + tid]; LRED[tid] = 0.f; }
        bf16x8 qfr[9];
#pragma unroll
        for (int s9 = 0; s9 < 9; ++s9) qfr[s9] = *(const bf16x8*)(QS + ((size_t)bd * 32 + (wave & 1) * 16 + r16) * CSW + 32 * s9 + 8 * q4);
        f32x2 rcur = *(const f32x2*)(rc + (split * 4096 + krow) * 16 + 2 * kp), rsur = *(const f32x2*)(rs + (split * 4096 + krow) * 16 + 2 * kp);
        __syncthreads();
        SA_LOAD(0, a0, a1, a2, a3, aka, akb);
        SA_CONVERT(0, 0, a0, a1, a2, a3, aka, akb);
        SA_LOAD(1, a0, a1, a2, a3, aka, akb);
        __syncthreads();
        f32x16 accT = {}; float lsum = 0.f; int c3 = 0;
#pragma unroll 1
        for (int j = 0; j < 128; ++j) {
            const int c3n = (c3 == 2) ? 0 : c3 + 1, c3p = (c3 == 0) ? 2 : c3 - 1;
            if (j > 0) SA_PV(c3p);
            { const LAS unsigned char* c8b = C8 + (j & 1) * 8704; const LAS float* spe = SSPE + (j & 1) * 32;
#pragma unroll
                for (int kb = 0; kb < 2; ++kb) { f32x4 acc[4] = {};
#pragma unroll
                    for (int ks = 0; ks < 2; ++ks) { const LAS unsigned char* ap = c8b + (kb * 16 + r16) * 272 + 128 * ks + 32 * q4;
                        const u32x4 x0 = *(const LAS u32x4*)ap, x1 = *(const LAS u32x4*)(ap + 16);
                        const v8i_t af = {(int)x0.x, (int)x0.y, (int)x0.z, (int)x0.w, (int)x1.x, (int)x1.y, (int)x1.z, (int)x1.w};
#pragma unroll
                        for (int nb = 0; nb < 4; ++nb) acc[nb] = __builtin_amdgcn_mfma_scale_f32_16x16x128_f8f6f4(af, wf8[nb][ks], acc[nb], 0, 0, 0, 0x7F7F7F7F, 0, 0x7F7F7F7F); }
                    f32x4 sq = (acc[0] * acc[0] + acc[1] * acc[1] + acc[2] * acc[2] + acc[3] * acc[3]) * (1.f / 256.f);
                    sq.x = row16_sum(sq.x); sq.y = row16_sum(sq.y); sq.z = row16_sum(sq.z); sq.w = row16_sum(sq.w);
                    if (r16 == 0) { const f32x4 pe = *(const LAS f32x4*)(spe + kb * 16 + 4 * q4); f32x4 r;
                        r.x = __builtin_amdgcn_rsqf((sq.x + pe.x) * (1.f / 96.f) + EPS); r.y = __builtin_amdgcn_rsqf((sq.y + pe.y) * (1.f / 96.f) + EPS);
                        r.z = __builtin_amdgcn_rsqf((sq.z + pe.z) * (1.f / 96.f) + EPS); r.w = __builtin_amdgcn_rsqf((sq.w + pe.w) * (1.f / 96.f) + EPS);
                        *(LAS f32x4*)(RI + wave * 32 + kb * 16 + 4 * q4) = r; } } }
            f32x4 sa = {0.f, 0.f, 0.f, 0.f};
            if (wave < 4) { const int kb = wave >> 1, nb2 = wave & 1; const LAS bf16* cb = Cs + c3 * (32 * CSW);
#pragma unroll
                for (int s9 = 0; s9 < 9; ++s9) { const bf16x8 af = *(const LAS bf16x8*)(cb + (kb * 16 + r16) * CSW + 32 * s9 + 8 * q4);
                    sa = MFMA16(af, qfr[s9], sa); } (void)nb2; }
            if (j + 1 < 128) { SA_CONVERT(j + 1, c3n, a0, a1, a2, a3, aka, akb); if (j + 2 < 128) SA_LOAD(j + 2, a0, a1, a2, a3, aka, akb); }
            __syncthreads();
            if (wave < 4) { const int kb = wave >> 1, nb2 = wave & 1; const int row = nb2 * 16 + r16, hrow = row >> 2; const f32x4 ri = *(const LAS f32x4*)(RI + hrow * 32 + kb * 16 + 4 * q4);
                const float p0 = __builtin_amdgcn_exp2f(sa.x * ri.x - cB), p1 = __builtin_amdgcn_exp2f(sa.y * ri.y - cB), p2 = __builtin_amdgcn_exp2f(sa.z * ri.z - cB), p3 = __builtin_amdgcn_exp2f(sa.w * ri.w - cB);
                lsum += (p0 + p1) + (p2 + p3);
                u32x2 w; w.x = pk2(p0, p1); w.y = pk2(p2, p3); *(LAS u32x2*)(PT + row * 40 + kb * 16 + 4 * q4) = w; }
            __syncthreads();
            c3 = c3n;
        }
        SA_PV(((c3 == 0) ? 2 : c3 - 1));
        lsum += __shfl_xor(lsum, 16); lsum += __shfl_xor(lsum, 32);
        if (wave < 4 && q4 == 0) (void)__hip_atomic_fetch_add(LRED + (wave & 1) * 16 + r16, lsum, __ATOMIC_RELAXED, __HIP_MEMORY_SCOPE_WORKGROUP);
        __syncthreads();
        if (tid < 32) SL[(size_t)it * 32 + tid] = LRED[tid];
        float* sp = SPART + ((size_t)it * 32 + r32) * 256 + 32 * wave;
#pragma unroll
        for (int r = 0; r < 16; ++r) sp[crow(r, h2)] = accT[r];
    }
#undef SA_LOAD
#undef SA_CONV1
#undef SA_CONVERT
#undef SA_PV
}

DI void attn_sample_final(const Args& a, LAS unsigned char* lds, int vcu, int G, int tid, int lane, int wave) {
    LAS float* lat = (LAS float*)lds;
    LAS float* cn = lat + 1024;
    LAS float* kper = cn + 1024;
    LAS float* rinv = kper + 128;
    LAS float* pw = rinv + 4;
    LAS float* lt = pw + 16;
    LAS float* red = lt + 4;
    const float cB = score_bound(a, lane);
    const bf16* CKVB = (const bf16*)(a.ws + WS_CKVB); const bf16* Z = (const bf16*)(a.ws + WS_Z); const bf16* KV = (const bf16*)(a.ws + WS_KVRAW); const bf16* QS = (const bf16*)(a.ws + WS_QS);
    const float* SPART = (const float*)(a.ws + WS_SPART); const float* SL = (const float*)(a.ws + WS_SL); bf16* MIX = (bf16*)(a.ws + WS_MIX);
    const float* rc = (const float*)(a.ws + WS_ROPE); const float* rs = rc + 8200 * 16; const float* gk = (const float*)a.in[I_GKH]; const float* W = (const float*)a.in[I_WUKV];
    for (int it = vcu; it < DB * NH; it += G) { const int bd = it >> 3, h = it & 7; const size_t row0 = (size_t)MP + bd * 4;
        __syncthreads();
        for (int i = tid; i < 1024; i += NTHR) { const int t = i >> 8, c = i & 255; cn[i] = bf2f(CKVB[(row0 + t) * KVL + c]);
            lat[i] = SPART[(((size_t)bd * 2 + 0) * 32 + h * 4 + t) * 256 + c] + SPART[(((size_t)bd * 2 + 1) * 32 + h * 4 + t) * 256 + c]; }
        if (tid < 128) { const int t = tid >> 5, d = tid & 31; const float x = bf2f(Z[(row0 + t) * ZW + ZC_KPE + d]); const float y = x * gk[64 + d], yo = __shfl_xor(y, 16);
            const int pos = PAST + t; const float c = rc[pos * 16 + (d & 15)], s = rs[pos * 16 + (d & 15)];
            kper[tid] = (d < 16) ? (y * c - yo * s) : (y * c + yo * s);
            float ss = x * x;
            const float k0 = bf2f(KV[(row0 + t) * 1024 + h * 128 + d]), k1 = bf2f(KV[(row0 + t) * 1024 + h * 128 + 32 + d]); ss += k0 * k0 + k1 * k1;
#pragma unroll
            for (int o = 1; o < 32; o <<= 1) ss += __shfl_xor(ss, o);
            if (d == 0) rinv[t] = __builtin_amdgcn_rsqf(ss * (1.f / 96.f) + EPS); }
        __syncthreads();
#pragma unroll
        for (int e = 0; e < 2; ++e) { const int pr = wave * 2 + e, t = pr >> 2, tp = pr & 3; const bf16* q = QS + ((size_t)bd * 32 + h * 4 + t) * CSW;
            float s = 0.f;
#pragma unroll
            for (int j = 0; j < 4; ++j) s += bf2f(q[j * 64 + lane]) * cn[tp * 256 + j * 64 + lane];
            if (lane < 32) s += bf2f(q[256 + lane]) * kper[tp * 32 + lane];
            s = wave_sum(s);
            if (lane == 0) pw[pr] = (tp <= t) ? __builtin_amdgcn_exp2f(s * rinv[tp] - cB) : 0.f; }
        __syncthreads();
        for (int i = tid; i < 1024; i += NTHR) { const int t = i >> 8, c = i & 255; lat[i] += (pw[t * 4] * cn[c] + pw[t * 4 + 1] * cn[256 + c]) + (pw[t * 4 + 2] * cn[512 + c] + pw[t * 4 + 3] * cn[768 + c]); }
        if (tid < 4) lt[tid] = SL[((size_t)bd * 2 + 0) * 32 + h * 4 + tid] + SL[((size_t)bd * 2 + 1) * 32 + h * 4 + tid] + (pw[tid * 4] + pw[tid * 4 + 1]) + (pw[tid * 4 + 2] + pw[tid * 4 + 3]);
        __syncthreads();
        { const int half = tid >> 8, t = (tid >> 6) & 3, dv = tid & 63; float s = 0.f; const float* wp = W + (size_t)(half * 128) * 1024 + h * 128 + 64 + dv;
#pragma unroll 8
            for (int c = 0; c < 128; ++c) s += lat[t * 256 + half * 128 + c] * wp[(size_t)c * 1024];
            red[(half * 4 + t) * 64 + dv] = s; }
        __syncthreads();
        if (tid < 256) { const int t = tid >> 6, dv = tid & 63; const float o = (red[t * 64 + dv] + red[(4 + t) * 64 + dv]) / lt[t];
            MIX[(row0 + t) * DM + h * 64 + dv] = (bf16)f2bf(o); }
    }
}
DI float gelu_tanh(float x) { const float u = 1.5957691216057308f * (x + 0.044715f * x * x * x); return x * sigmoidf_(u); }
DI void s5_norm_phase(const Args& a, int vcu, int G, int lane, int wave) {
    const bf16* XB = (const bf16*)(a.ws + WS_XB1); const float* SS3 = (const float*)(a.ws + WS_CTL) + CW_SS + 3 * MT; bf16* U2 = (bf16*)(a.ws + WS_U2);
    const float* gn = (const float*)a.in[I_GNC];
    const int gw = vcu * NWAVES + wave, NGW = G * NWAVES;
    { f32x4 g0 = *(const f32x4*)(gn + lane * 16), g1 = *(const f32x4*)(gn + lane * 16 + 4), g2 = *(const f32x4*)(gn + lane * 16 + 8), g3 = *(const f32x4*)(gn + lane * 16 + 12);
        for (int m = gw; m < MP; m += NGW) { const float r = __builtin_amdgcn_rsqf(SS3[m] * (1.f / DM) + EPS);
            const u32x4 w0 = *(const u32x4*)(XB + (size_t)m * DM + lane * 16), w1 = *(const u32x4*)(XB + (size_t)m * DM + lane * 16 + 8);
            u32x4 o0, o1;
            o0.x = pk2(bflo(w0.x) * r * g0.x, bfhi(w0.x) * r * g0.y); o0.y = pk2(bflo(w0.y) * r * g0.z, bfhi(w0.y) * r * g0.w); o0.z = pk2(bflo(w0.z) * r * g1.x, bfhi(w0.z) * r * g1.y); o0.w = pk2(bflo(w0.w) * r * g1.z, bfhi(w0.w) * r * g1.w);
            o1.x = pk2(bflo(w1.x) * r * g2.x, bfhi(w1.x) * r * g2.y); o1.y = pk2(bflo(w1.y) * r * g2.z, bfhi(w1.y) * r * g2.w); o1.z = pk2(bflo(w1.z) * r * g3.x, bfhi(w1.z) * r * g3.y); o1.w = pk2(bflo(w1.w) * r * g3.z, bfhi(w1.w) * r * g3.w);
            bf16* dst = U2 + ((size_t)(m >> 4) * S5G + lane) * S5K + (m & 15) * 16;
            *(u32x4*)dst = o0; *(u32x4*)(dst + 8) = o1; } }
}
DI void s5_sample_phase(const Args& a, LAS unsigned char* lds, int gw, int NGW, int it_lo, int it_hi, int lane, int wave) {
    const bf16* XB = (const bf16*)(a.ws + WS_XB1); const float* SS3 = (const float*)(a.ws + WS_CTL) + CW_SS + 3 * MT; bf16* GG = (bf16*)(a.ws + WS_GG);
    const float* gn = (const float*)a.in[I_GNC];
    LAS float* us = (LAS float*)lds + wave * 2688;
    LAS float* xr = us + 64;
    LAS float* xi = xr + 256;
    LAS float* cs = xi + 256;
    const float* tab = (const float*)(a.ws + WS_S5TAB);
    const float* x0r = (const float*)a.in[I_S5RE]; const float* x0i = (const float*)a.in[I_S5IM]; const float* dd = (const float*)a.in[I_S5D];
    float lr = 0.f, li = 0.f; f32x4 bbv[8]; int gcur = -1;
#pragma unroll
    for (int q = 0; q < 8; ++q) bbv[q] = (f32x4){0.f, 0.f, 0.f, 0.f};
    for (int it = it_lo + gw; it < it_hi; it += NGW) { const int g = it & 63, bd = it >> 6; const size_t row0 = (size_t)MP + bd * 4;
        if (g != gcur) { gcur = g; lr = tab[((size_t)g * 64 + lane) * 2]; li = tab[((size_t)g * 64 + lane) * 2 + 1];
            const f32x4* bb = (const f32x4*)(tab + 16384 + ((size_t)g * 1024 + lane * 16) * 2);
#pragma unroll
            for (int q = 0; q < 8; ++q) bbv[q] = bb[q];
            LDS_WAIT(); asm volatile("" ::: "memory");
            const float* cre = (const float*)a.in[I_S5CRE] + (size_t)g * 1024; const float* cim = (const float*)a.in[I_S5CIM] + (size_t)g * 1024;
#pragma unroll 4
            for (int i = 0; i < 16; ++i) { cs[(i * 64 + lane) * 2] = cre[i * 64 + lane]; cs[(i * 64 + lane) * 2 + 1] = cim[i * 64 + lane]; } }
        { const int t = lane >> 4, c = lane & 15; const size_t row = row0 + t; const float r = __builtin_amdgcn_rsqf(SS3[row] * (1.f / DM) + EPS);
            us[lane] = bf2f(XB[row * DM + g * 16 + c]) * r * gn[g * 16 + c]; }
        LDS_WAIT(); asm volatile("" ::: "memory");
        { float sr = x0r[((size_t)bd * 64 + g) * 64 + lane], si = x0i[((size_t)bd * 64 + g) * 64 + lane];
#pragma unroll
            for (int t = 0; t < 4; ++t) { float br = 0.f, bi = 0.f;
#pragma unroll
                for (int q = 0; q < 4; ++q) { const f32x4 u4 = *(const LAS f32x4*)(us + t * 16 + 4 * q); const f32x4 b0 = bbv[2 * q], b1 = bbv[2 * q + 1];
                    br += (b0.x * u4.x + b0.z * u4.y) + (b1.x * u4.z + b1.z * u4.w); bi += (b0.y * u4.x + b0.w * u4.y) + (b1.y * u4.z + b1.w * u4.w); }
                const float nr = lr * sr - li * si + br, ni = lr * si + li * sr + bi; sr = nr; si = ni; xr[t * 64 + lane] = sr; xi[t * 64 + lane] = si; }
            a.out[O_S5RS + ((size_t)bd * 64 + g) * 64 + lane] = sr; a.out[O_S5IS + ((size_t)bd * 64 + g) * 64 + lane] = si; }
        LDS_WAIT(); asm volatile("" ::: "memory");
        { const int t = lane >> 4, co = lane & 15; const LAS f32x2* cp = (const LAS f32x2*)(cs + co * 128);
            float y = dd[g * 16 + co] * us[t * 16 + co];
#pragma unroll 8
            for (int p = 0; p < 64; ++p) { const f32x2 cc = cp[p]; y += cc.x * xr[t * 64 + p] - cc.y * xi[t * 64 + p]; }
            GG[(row0 + t) * DM + g * 16 + co] = (bf16)f2bf(gelu_tanh(y)); }
        LDS_WAIT(); asm volatile("" ::: "memory");
    }
}
struct EpiS5E {
    static constexpr bool PERM = false;
    float* E;
    DI void operator()(const f32x4 (&acc)[2][2][4][2], const pg8::Unit& u, int wr, int wc, int fr, int fq) const {
        const int j = (int)(u.aoff / (2 * S5K * 2)); const int row0 = u.pm * 256 + wr * 64 + fr, col0 = wc * 32 + 4 * fq;
#pragma unroll
        for (int ai = 0; ai < 2; ++ai)
#pragma unroll
            for (int m = 0; m < 4; ++m) { const int n = row0 + ai * 128 + m * 16;
#pragma unroll
                for (int bj = 0; bj < 2; ++bj)
#pragma unroll
                    for (int nn = 0; nn < 2; ++nn) *(f32x4*)(E + ((size_t)n * S5G + 2 * j + bj) * 128 + col0 + nn * 16) = acc[ai][bj][m][nn]; }
    }
};
DI void s5_scan_units(const Args& a, int bx, int G, int tid) {
    const float* E = (const float*)(a.ws + WS_S5E); bf16* U2 = (bf16*)(a.ws + WS_U2); const float* tab = (const float*)(a.ws + WS_S5TAB);
    for (int L = bx; L < 256; L += G) { const int g = L >> 2, pm = L & 3;
        if (tid < 128) { const int p = tid & 63, b = 2 * pm + (tid >> 6);
            const float lr = tab[8192 + ((size_t)g * 64 + p) * 2], li = tab[8192 + ((size_t)g * 64 + p) * 2 + 1];
            float sr = 0.f, si = 0.f;
#pragma unroll 4
            for (int c = 0; c < S5NC; ++c) { const size_t n = (size_t)b * S5NC + c; const float er = E[(n * S5G + g) * 128 + p], ei = E[(n * S5G + g) * 128 + 64 + p];
                bf16* up = U2 + (n * S5G + g) * S5K + 256; up[p] = (bf16)f2bf(sr); up[64 + p] = (bf16)f2bf(si);
                const float nr = lr * sr - li * si + er, ni = lr * si + li * sr + ei; sr = nr; si = ni; }
            const size_t i = ((size_t)b * 64 + g) * 64 + p; a.out[O_S5RP + i] = sr; a.out[O_S5IP + i] = si; } }
    asm volatile("s_waitcnt vmcnt(0)" ::: "memory");
    __syncthreads();
}
struct EpiS5Y {
    static constexpr bool PERM = false;
    const bf16* U2; const float* D; bf16* GG;
    DI void operator()(const f32x4 (&acc)[2][2][4][2], const pg8::Unit& u, int wr, int wc, int fr, int fq) const {
        const int g = (int)(u.aoff / (S5K * 2)); const int row0 = u.pm * 256 + wr * 64 + fr, col0 = wc * 32 + 4 * fq;
#pragma unroll
        for (int ai = 0; ai < 2; ++ai)
#pragma unroll
            for (int m = 0; m < 4; ++m) { const int n = row0 + ai * 128 + m * 16;
#pragma unroll
                for (int bj = 0; bj < 2; ++bj)
#pragma unroll
                    for (int nn = 0; nn < 2; ++nn) { const int col = col0 + bj * 128 + nn * 16, t = col >> 4, co = col & 15;
                        const u32x2 uw = *(const u32x2*)(U2 + ((size_t)n * S5G + g) * S5K + col); const f32x4 d4 = *(const f32x4*)(D + g * 16 + co); const f32x4 v = acc[ai][bj][m][nn];
                        const float y0 = gelu_tanh(v[0] + d4.x * bflo(uw.x)), y1 = gelu_tanh(v[1] + d4.y * bfhi(uw.x)), y2 = gelu_tanh(v[2] + d4.z * bflo(uw.y)), y3 = gelu_tanh(v[3] + d4.w * bfhi(uw.y));
                        u32x2 w; w.x = pk2(y0, y1); w.y = pk2(y2, y3); *(u32x2*)(GG + ((size_t)n * S5T + t) * DM + g * 16 + co) = w; }
                asm volatile("" ::: "memory"); }
    }
};
#ifndef MK_N_LAUNCHES
#define MK_N_LAUNCHES 1
#endif
constexpr int N_PHASES = 21;
__global__ void __launch_bounds__(NTHR, 2) mega_fwd(Args args) {
    extern __shared__ __attribute__((aligned(16))) unsigned char lds_raw[];
    LAS unsigned char* lds = (LAS unsigned char*)lds_raw;
    volatile LAS unsigned* MISC = (volatile LAS unsigned*)(lds + MISC_OFF);
    const int tid = threadIdx.x, lane = tid & 63, wave = __builtin_amdgcn_readfirstlane(tid >> 6);
    const int G = gridDim.x; const int bx = blockIdx.x; const int vcu = (G % 8 == 0) ? (bx % 8) * (G / 8) + bx / 8 : bx;
    unsigned char* ws = args.ws;
    unsigned* ctl = (unsigned*)(ws + WS_CTL);
    if (tid < 64) MISC[tid] = 0u;
    __syncthreads();
    const int lo = args.ph_lo, hi = args.ph_hi;
    XcdBarrier bar; bar.bar = ctl + CW_BAR; bar.x = 0; bar.st = nullptr;
    if (hi - lo > 1) bar = xcd_barrier_post(ctl + CW_BAR, MISC + 8);
#ifndef PHMASK
#define PHMASK 0xffffffffu
#endif
#define IN(k) (((PHMASK >> (k)) & 1u) && lo <= (k) && (k) < hi)
#define SEAM(k) do { if (IN(k) && IN((k) + 1)) xcd_barrier(bar); } while (0)
    const int rcu = G - 1 - bx;
    float* SS = (float*)(ctl + CW_SS);
    float* H = args.out + O_Y;
    bf16* XB0 = (bf16*)(ws + WS_XB0); bf16* XB1 = (bf16*)(ws + WS_XB1);
    const float* ss0 = (const float*)(ws + WS_SSQ) + MT;

    if (IN(0)) { _Pragma("unroll 1") for (int rep_ = 0; rep_ < REPS(0); ++rep_) { __syncthreads(); p0_prologue(args, lds, vcu, G, tid, lane, wave); } } SEAM(0);
    if (IN(1)) {
        pg8::Gemm g{XB0, (const bf16*)(ws + WS_WIN), DM, DM, DM}; pg8::GridOrder S; S.init(MP / 256, ZW / 256, G, bx);
        pg8::EpiZ E{(bf16*)(ws + WS_Z), ss0, SS + 6 * MT};
        pg8::gemm_phase<pg8::EpiZ, pg8::GridOrder, true>(lds, g, S, E);
        sk::skinny_gemm4(lds, XB0 + (size_t)MP * DM, DM, (const bf16*)(ws + WS_WIN), DM, DM, ZW / 128, sk::SkZ{(bf16*)(ws + WS_Z), ss0, SS + 6 * MT}, G == 256 ? (bx >= 192 ? bx - 192 : (1 << 20)) : rcu, G == 256 ? 64 : G, tid, lane, wave);
    } SEAM(1);
    if (IN(3)) { _Pragma("unroll 1") for (int rep_ = 0; rep_ < REPS(3); ++rep_) {
        { pg8::Gemm g{(const bf16*)(ws + WS_Z) + ZC_CQ, (const bf16*)(ws + WS_WUQ), ZW, QL, QL}; pg8::GridOrder S; S.init(MP / 256, 3, G, bx);
          pg8::EpiBf16<0> E{(bf16*)(ws + WS_QRAW), 768, SS + 6 * MT, 1.f / QL};
          pg8::gemm_phase<pg8::EpiBf16<0>, pg8::GridOrder, true>(lds, g, S, E); }
        sk::skinny_gemm(lds, (const bf16*)(ws + WS_Z) + (size_t)MP * ZW + ZC_CQ, ZW, (const bf16*)(ws + WS_WUQ), QL, QL, 24, sk::SkBf16<0>{(bf16*)(ws + WS_QRAW), 768, SS + 6 * MT, 1.f / QL}, sk::BMapLin(), G == 256 ? (bx >= 192 ? bx - 192 : (1 << 20)) : rcu, G == 256 ? 64 : G, tid, lane, wave);
        __syncthreads();
        { pg8::Gemm g{(const bf16*)(ws + WS_Z) + ZC_CKV, (const bf16*)(ws + WS_WUKVG), ZW, KVL, KVL}; pg8::GridOrder S; S.init(MP / 256, 4, G, bx);
          pg8::EpiBf16<0> E{(bf16*)(ws + WS_KVRAW), 1024, SS + 7 * MT, 1.f / KVL};
          pg8::gemm_phase<pg8::EpiBf16<0>, pg8::GridOrder, true>(lds, g, S, E); }
        sk::skinny_gemm(lds, (const bf16*)(ws + WS_Z) + (size_t)MP * ZW + ZC_CKV, ZW, (const bf16*)(ws + WS_WUKVG), KVL, KVL, 32, sk::SkBf16<0>{(bf16*)(ws + WS_KVRAW), 1024, SS + 7 * MT, 1.f / KVL}, sk::BMapLin(), rcu, G, tid, lane, wave);
        __syncthreads();
#pragma unroll 1
        for (int li = 0; li < 2; ++li) { pg8::Gemm g{(const bf16*)(ws + WS_PB) + (size_t)li * MT * PLE, (const bf16*)(ws + WS_WPROJ) + (size_t)li * DM * PLE, PLE, PLE, PLE}; pg8::GridOrder S; S.init(MP / 256, 4, G, bx);
          pg8::EpiBf16<0> E{(bf16*)(ws + WS_PP) + (size_t)li * MT * DM, DM, nullptr, 0.f};
          pg8::gemm_phase<pg8::EpiBf16<0>, pg8::GridOrder, true>(lds, g, S, E); }
#pragma unroll 1
        for (int li = 0; li < 2; ++li) sk::skinny_gemm(lds, (const bf16*)(ws + WS_PB) + ((size_t)li * MT + MP) * PLE, PLE, (const bf16*)(ws + WS_WPROJ) + (size_t)li * DM * PLE, PLE, PLE, 32, sk::SkBf16<0>{(bf16*)(ws + WS_PP) + (size_t)li * MT * DM, DM, nullptr, 0.f}, sk::BMapLin(), rcu, G, tid, lane, wave);
    }
    } if (IN(3) && IN(5)) xcd_barrier(bar);
    if (IN(5)) { p4_attn_prep(args, lds, vcu, G, tid, lane, wave); gla_a_phase(args, lds, vcu, G, tid, lane, wave); gla_sample_phase(args, lds, vcu, G, tid, lane, wave); } SEAM(5);
    if (IN(6)) { gla_b_phase(args, vcu, G, tid); p4b_sample_q(args, lds, vcu, G, tid, lane, wave); } SEAM(6);
    if (IN(7)) { _Pragma("unroll 1") for (int rep_ = 0; rep_ < REPS(70); ++rep_) { attn_prompt_phase(args, lds, vcu, G, tid, lane, wave); } _Pragma("unroll 1") for (int rep_ = 0; rep_ < REPS(71); ++rep_) { gla_c_phase(args, lds, vcu, G, tid, lane, wave); } _Pragma("unroll 1") for (int rep_ = 0; rep_ < REPS(72); ++rep_) { attn_sample_phase(args, lds, vcu, G, tid, lane, wave); } } SEAM(7);
    if (IN(8)) { _Pragma("unroll 1") for (int rep_ = 0; rep_ < REPS(8); ++rep_) { attn_sample_final(args, lds, vcu, G, tid, lane, wave); } } SEAM(8);
    if (IN(9)) {
        pg8::Gemm g{(const bf16*)(ws + WS_MIX), (const bf16*)(ws + WS_WOUT), DM, DM, DM}; pg8::GridOrder S; S.init(MP / 256, 4, G, bx);
        pg8::EpiRes<0> E{(const float*)args.in[I_XP], (const float*)args.in[I_XS], nullptr, nullptr, XB1, SS + 1 * MT, nullptr, nullptr};
        pg8::gemm_phase<pg8::EpiRes<0>, pg8::GridOrder, true>(lds, g, S, E);
        sk::skinny_gemm(lds, (const bf16*)(ws + WS_MIX) + (size_t)MP * DM, DM, (const bf16*)(ws + WS_WOUT), DM, DM, 32, sk::SkRes<0>{(const float*)args.in[I_XS], nullptr, nullptr, XB1, SS + 1 * MT, nullptr, nullptr}, sk::BMapLin(), rcu, G, tid, lane, wave);
    } SEAM(9);
#define LAYER_TAIL(li) do { \
        constexpr int pb = 10 + 8 * (li); \
        bf16* xin = (li) == 0 ? (bf16*)(args.ws + WS_XB1) : (bf16*)(args.ws + WS_XB0); bf16* xmid = (li) == 0 ? (bf16*)(args.ws + WS_XB0) : (bf16*)(args.ws + WS_XB1); \
        if (IN(pb)) { \
            pg8::Gemm g{xin, (const bf16*)(args.ws + WS_WUP) + (size_t)(li) * FF * DM, DM, DM, DM}; pg8::GridOrder S; S.init(MP / 256, FF / 256, G, bx); \
            pg8::EpiBf16<1> E{(bf16*)(args.ws + WS_A1), FF, (float*)((unsigned*)(args.ws + WS_CTL) + CW_SS) + ((li) == 0 ? 1 : 4) * MT, 1.f / DM}; \
            pg8::gemm_phase<pg8::EpiBf16<1>, pg8::GridOrder, true>(lds, g, S, E); \
            sk::skinny_gemm4(lds, xin + (size_t)MP * DM, DM, (const bf16*)(args.ws + WS_WUP) + (size_t)(li) * FF * DM, DM, DM, FF / 128, sk::SkBf16<1>{(bf16*)(args.ws + WS_A1), FF, (float*)((unsigned*)(args.ws + WS_CTL) + CW_SS) + ((li) == 0 ? 1 : 4) * MT, 1.f / DM}, rcu, G, tid, lane, wave); \
        } SEAM(pb); \
        if (IN(pb + 1)) { \
            float* Hh = args.out + O_Y; \
            pg8::Gemm g{(const bf16*)(args.ws + WS_A1), (const bf16*)(args.ws + WS_WDN) + (size_t)(li) * DM * FF, FF, FF, FF}; pg8::GridOrder S; S.init(MP / 256, 4, G, bx); \
            pg8::EpiRes<0> E{nullptr, nullptr, xin, nullptr, xmid, (float*)((unsigned*)(args.ws + WS_CTL) + CW_SS) + ((li) == 0 ? 2 : 5) * MT, nullptr, nullptr}; (void)Hh; \
            pg8::gemm_phase<pg8::EpiRes<0>, pg8::GridOrder, true>(lds, g, S, E); \
            sk::skinny_gemm(lds, (const bf16*)(args.ws + WS_A1) + (size_t)MP * FF, FF, (const bf16*)(args.ws + WS_WDN) + (size_t)(li) * DM * FF, FF, FF, 32, sk::SkRes<0>{nullptr, xin, nullptr, xmid, (float*)((unsigned*)(args.ws + WS_CTL) + CW_SS) + ((li) == 0 ? 2 : 5) * MT, nullptr, nullptr}, sk::BMapLin(), rcu, G, tid, lane, wave); \
        } SEAM(pb + 1); \
        if (IN(pb + 2)) { \
            float* Hh = args.out + O_Y; float* SSb = (float*)((unsigned*)(args.ws + WS_CTL) + CW_SS); \
            pg8::Gemm g{xmid, (const bf16*)(args.ws + WS_WGATE) + (size_t)(li) * DM * DM, DM, DM, DM}; pg8::GridOrder S; S.init(MP / 256, 4, G, bx); \
            pg8::EpiRes<1> E{nullptr, nullptr, xmid, (li) == 0 ? nullptr : Hh, (li) == 0 ? xin : nullptr, (li) == 0 ? SSb + 3 * MT : nullptr, SSb + ((li) == 0 ? 2 : 5) * MT, (const bf16*)(args.ws + WS_PP) + (size_t)(li) * MT * DM}; \
            pg8::gemm_phase<pg8::EpiRes<1>, pg8::GridOrder, true>(lds, g, S, E); \
            sk::skinny_gemm(lds, xmid + (size_t)MP * DM, DM, (const bf16*)(args.ws + WS_WGATE) + (size_t)(li) * DM * DM, DM, DM, 32, sk::SkRes<1>{nullptr, xmid, (li) == 0 ? nullptr : Hh, (li) == 0 ? xin : nullptr, (li) == 0 ? SSb + 3 * MT : nullptr, SSb + ((li) == 0 ? 2 : 5) * MT, (const bf16*)(args.ws + WS_PP) + (size_t)(li) * MT * DM}, sk::BMapLin(), rcu, G, tid, lane, wave); \
        } SEAM(pb + 2); } while (0)
    LAYER_TAIL(0);
    const int s5_split = (G > 128) ? (DB * S5G) / 2 : DB * S5G;
    if (IN(13)) { s5_norm_phase(args, vcu, G, lane, wave); s5_sample_phase(args, lds, vcu * NWAVES + wave, G * NWAVES, 0, s5_split, lane, wave); } SEAM(13);
    if (IN(14)) {
        pg8::Gemm g{(const bf16*)(args.ws + WS_U2), (const bf16*)(args.ws + WS_S5BD), S5G * S5K, 2 * S5K, 2 * S5K}; pg8::BatchOrder S; S.init(32, S5N / 256, 1, (size_t)2 * S5K * 2, (size_t)256 * 2 * S5K * 2, G, bx);
        EpiS5E E{(float*)(args.ws + WS_S5E)};
        pg8::gemm_phase<EpiS5E, pg8::BatchOrder, true, true>(lds, g, S, E);
        if (bx >= 128) s5_sample_phase(args, lds, (bx - 128) * NWAVES + wave, (G - 128) * NWAVES, s5_split, DB * S5G, lane, wave);
    } if (IN(14) && IN(16)) xcd_barrier(bar);
    if (IN(16)) {
        _Pragma("unroll 1") for (int rep_ = 0; rep_ < REPS(16); ++rep_) s5_scan_units(args, bx, G, tid);
        pg8::Gemm g{(const bf16*)(args.ws + WS_U2), (const bf16*)(args.ws + WS_S5TN), S5G * S5K, S5K, S5K}; pg8::BatchOrder S; S.init(64, S5N / 256, 1, (size_t)S5K * 2, (size_t)256 * S5K * 2, G, bx);
        EpiS5Y E{(const bf16*)(args.ws + WS_U2), (const float*)args.in[I_S5D], (bf16*)(args.ws + WS_GG)};
        pg8::gemm_phase<EpiS5Y, pg8::BatchOrder, true, true>(lds, g, S, E);
    } SEAM(16);
    if (IN(17)) {
        pg8::Gemm g{(const bf16*)(args.ws + WS_GG), (const bf16*)(args.ws + WS_WGLU), DM, DM, DM}; pg8::GridOrder S; S.init(MP / 256, 8, G, bx);
        pg8::EpiGlu E{(const bf16*)(args.ws + WS_XB1), (bf16*)(args.ws + WS_XB0), (float*)((unsigned*)(args.ws + WS_CTL) + CW_SS) + 4 * MT};
        pg8::gemm_phase<pg8::EpiGlu, pg8::GridOrder, true>(lds, g, S, E);
        sk::skinny_gemm(lds, (const bf16*)(args.ws + WS_GG) + (size_t)MP * DM, DM, (const bf16*)(args.ws + WS_WGLU), DM, DM, 64, sk::SkGlu{(const bf16*)(args.ws + WS_XB1), (bf16*)(args.ws + WS_XB0), (float*)((unsigned*)(args.ws + WS_CTL) + CW_SS) + 4 * MT}, sk::BMapGlu(), rcu, G, tid, lane, wave);
    } SEAM(17);
    LAYER_TAIL(1);
#undef LAYER_TAIL
#undef IN
#undef SEAM
}

extern "C" void kernel_launch(void* const* d_in, const int* in_sizes, int n_in, void* d_out, int out_size, void* d_ws, size_t ws_size, hipStream_t stream) {
    static int grid = 0;
    if (grid == 0) {
        if (n_in != 38 || out_size != (int)O_END || ws_size < WS_END) { fprintf(stderr, "kernel_launch: unexpected shapes (n_in %d, out %d, ws %zu); nothing launched\n", n_in, out_size, ws_size); grid = -1; return; }
        int dev = 0, cus = 0, per_cu = 0;
        if (hipGetDevice(&dev) != hipSuccess || hipDeviceGetAttribute(&cus, hipDeviceAttributeMultiprocessorCount, dev) != hipSuccess) { grid = -1; return; }
        if (hipFuncSetAttribute((const void*)mega_fwd, hipFuncAttributeMaxDynamicSharedMemorySize, LDS_BYTES) != hipSuccess) { fprintf(stderr, "kernel_launch: hipFuncSetAttribute failed\n"); grid = -1; return; }
        if (hipOccupancyMaxActiveBlocksPerMultiprocessor(&per_cu, (const void*)mega_fwd, NTHR, LDS_BYTES) != hipSuccess || per_cu < 1) { fprintf(stderr, "kernel_launch: occupancy query reports %d\n", per_cu); (void)hipGetLastError(); per_cu = 1; }
        grid = cus;
    }
    if (grid < 0) return;
    if (hipMemsetAsync((char*)d_ws + WS_CTL, 0, CTL_ZERO_BYTES, stream) != hipSuccess) return;
    Args a{};
    for (int i = 0; i < 38; ++i) a.in[i] = d_in[i];
    a.out = (float*)d_out; a.ws = (unsigned char*)d_ws;
#if MK_N_LAUNCHES == 1
    a.ph_lo = 0; a.ph_hi = N_PHASES;
    hipLaunchKernelGGL(mega_fwd, dim3(grid), dim3(NTHR), LDS_BYTES, stream, a);
#else
    for (int p = 0; p < N_PHASES; ++p) { a.ph_lo = p; a.ph_hi = p + 1; hipLaunchKernelGGL(mega_fwd, dim3(grid), dim3(NTHR), LDS_BYTES, stream, a); }
#endif
}
```
